# Optimizing an MI355X kernel written in HIP

```python
import jax, jax.numpy as jnp
from jax import lax
import numpy as np

D_MODEL = 1024
BATCH = 8
SEQ = 2048
DEPTH = 1

F32 = jnp.float32
EPS = 1e-6
MEM_LEN = 256
GRID_W = 64
CONV_W = 3
ML_HEADS = 4
ML_HEAD_DIM = 128
ML_WIDTH = ML_HEADS * ML_HEAD_DIM
ML_CHUNK = 64
NA_HEADS = 8
NA_HEAD_DIM = 64
NA_WIDTH = NA_HEADS * NA_HEAD_DIM
NA_WIN_ROWS_MAX = 8
NA_WIN_COLS = 16
XA_HEADS = 4
XA_HEAD_DIM = 128
XA_WIDTH = XA_HEADS * XA_HEAD_DIM
N_BRANCHES = 3
D_FF = 2816
IN_SPLITS = (ML_WIDTH, ML_WIDTH, ML_WIDTH, ML_WIDTH, 4 * ML_HEADS, 3 * NA_WIDTH, XA_WIDTH, N_BRANCHES * D_MODEL)
IN_WIDTH = sum(IN_SPLITS)
NEG_INIT = -1e30

kernel_name = "hybrid_mlstm_natten_memxattn_block"


def rms_norm(x, g):
    xf = x.astype(F32)
    y = xf * lax.rsqrt(jnp.mean(xf * xf, axis=-1, keepdims=True) + EPS)
    return (y * g.astype(F32)).astype(x.dtype)


def dwconv3(x, w, b):
    xp = jnp.pad(x, ((0, 0), (1, 1), (0, 0)))
    return xp[:, :-2] * w[0] + xp[:, 1:-1] * w[1] + xp[:, 2:] * w[2] + b


def mlstm_chunkwise(q, k, v, i_pre, f_pre):
    B, H, S, Dh = q.shape
    L = ML_CHUNK
    NC = S // L
    q = q.astype(F32).reshape(B, H, NC, L, Dh) * (Dh ** -0.5)
    k = k.astype(F32).reshape(B, H, NC, L, Dh)
    v = v.astype(F32).reshape(B, H, NC, L, Dh)
    log_f = jax.nn.log_sigmoid(f_pre.astype(F32)).reshape(B, H, NC, L)
    log_i = i_pre.astype(F32).reshape(B, H, NC, L)
    a = jnp.cumsum(log_f, axis=-1)
    g = a[..., -1]
    w_end = g[..., None] - a + log_i
    m_end = jnp.max(w_end, axis=-1)

    def step(carry, xs):
        C, n, m = carry
        k_c, v_c, w_c, mw_c, g_c = xs
        m_new = jnp.maximum(g_c + m, mw_c)
        decay = jnp.exp(g_c + m - m_new)
        wt = jnp.exp(w_c - m_new[..., None])
        C_new = decay[..., None, None] * C + jnp.einsum('bhl,bhld,bhle->bhde', wt, v_c, k_c)
        n_new = decay[..., None] * n + jnp.einsum('bhl,bhle->bhe', wt, k_c)
        return (C_new, n_new, m_new), (C, n, m)

    init = (jnp.zeros((B, H, Dh, Dh), F32), jnp.zeros((B, H, Dh), F32), jnp.full((B, H), NEG_INIT, F32))
    xs = (jnp.moveaxis(k, 2, 0), jnp.moveaxis(v, 2, 0), jnp.moveaxis(w_end, 2, 0),
          jnp.moveaxis(m_end, 2, 0), jnp.moveaxis(g, 2, 0))
    _, (C_prev, n_prev, m_prev) = lax.scan(step, init, xs)
    C_prev = jnp.moveaxis(C_prev, 0, 2)
    n_prev = jnp.moveaxis(n_prev, 0, 2)
    m_prev = jnp.moveaxis(m_prev, 0, 2)

    causal = jnp.tril(jnp.ones((L, L), dtype=bool))
    D = a[..., :, None] - a[..., None, :] + log_i[..., None, :]
    D = jnp.where(causal, D, -jnp.inf)
    inter_log = a + m_prev[..., None]
    m_j = jnp.maximum(inter_log, jnp.max(D, axis=-1))
    qk = jnp.einsum('bhcjd,bhcsd->bhcjs', q, k)
    P = jnp.exp(D - m_j[..., None]) * qk
    inter_w = jnp.exp(inter_log - m_j)
    num = jnp.einsum('bhcjs,bhcsd->bhcjd', P, v) + inter_w[..., None] * jnp.einsum('bhcde,bhcje->bhcjd', C_prev, q)
    den = jnp.sum(P, axis=-1) + inter_w * jnp.einsum('bhce,bhcje->bhcj', n_prev, q)
    h = num / jnp.maximum(jnp.abs(den), jnp.exp(-m_j))[..., None]
    return h.reshape(B, H, S, Dh)


def mlstm_branch(q_pre, k_pre, v, o_pre, gates, w_conv, b_conv, b_ig, b_fg, norm_g):
    B, S, _ = q_pre.shape
    qk = jax.nn.silu(dwconv3(jnp.concatenate([q_pre, k_pre], axis=-1), w_conv, b_conv))
    q, k = jnp.split(qk, 2, axis=-1)
    heads = lambda t: t.reshape(B, S, ML_HEADS, ML_HEAD_DIM).transpose(0, 2, 1, 3)
    qh, kh, vh = heads(q), heads(k), heads(v)
    gt = gates.astype(F32).reshape(B, S, 4, ML_HEADS).transpose(2, 0, 3, 1)
    b_ig = b_ig.astype(F32)
    b_fg = b_fg.astype(F32)
    i_fw = gt[0] + b_ig[0][None, :, None]
    f_fw = gt[1] + b_fg[0][None, :, None]
    i_bw = gt[2] + b_ig[1][None, :, None]
    f_bw = gt[3] + b_fg[1][None, :, None]
    h_fw = mlstm_chunkwise(qh, kh, vh, i_fw, f_fw)
    flip = lambda t: jnp.flip(t, axis=2)
    h_bw = flip(mlstm_chunkwise(flip(qh), flip(kh), flip(vh), flip(i_bw), flip(f_bw)))
    h = h_fw + h_bw
    h = h * lax.rsqrt(jnp.mean(h * h, axis=-1, keepdims=True) + EPS)
    h = h * norm_g.astype(F32).reshape(ML_HEADS, 1, ML_HEAD_DIM)
    h = h.transpose(0, 2, 1, 3).reshape(B, S, ML_WIDTH)
    return (jax.nn.sigmoid(o_pre.astype(F32)) * h).astype(q_pre.dtype)


def neighbourhood_attention(q, k, v, rpb):
    B, S, _ = q.shape
    rows = S // GRID_W
    kr = min(NA_WIN_ROWS_MAX, rows)
    grid = lambda t: t.reshape(B, rows, GRID_W, NA_HEADS, NA_HEAD_DIM).transpose(0, 3, 1, 2, 4)
    qg, kg, vg = grid(q).astype(F32), grid(k), grid(v)
    r = jnp.arange(rows)
    row_start = jnp.clip(r - kr // 2, 0, rows - kr)
    row_idx = row_start[:, None] + jnp.arange(kr)[None, :]
    k_band = kg[:, :, row_idx].astype(F32)
    v_band = vg[:, :, row_idx].astype(F32)
    c = jnp.arange(GRID_W)
    col_start = jnp.clip(c - NA_WIN_COLS // 2, 0, GRID_W - NA_WIN_COLS)
    col_ok = (c[None, :] >= col_start[:, None]) & (c[None, :] < col_start[:, None] + NA_WIN_COLS)
    dr = row_idx - r[:, None] + (NA_WIN_ROWS_MAX - 1)
    dc = jnp.clip(c[None, :] - c[:, None] + (NA_WIN_COLS - 1), 0, 2 * NA_WIN_COLS - 2)
    bias = rpb.astype(F32)[:, dr[:, None, :, None], dc[None, :, None, :]]
    s = jnp.einsum('bhrcd,bhrkjd->bhrckj', qg, k_band) * (NA_HEAD_DIM ** -0.5) + bias[None]
    s = jnp.where(col_ok[None, None, None, :, None, :], s, -jnp.inf)
    p = jax.nn.softmax(s.reshape(B, NA_HEADS, rows, GRID_W, kr * GRID_W), axis=-1).reshape(s.shape)
    o = jnp.einsum('bhrckj,bhrkjd->bhrcd', p, v_band)
    return o.transpose(0, 2, 3, 1, 4).reshape(B, S, NA_WIDTH).astype(q.dtype)


def memory_cross_attention(q, mem_k, mem_v):
    B, S, _ = q.shape
    M = mem_k.shape[1]
    qh = q.reshape(B, S, XA_HEADS, XA_HEAD_DIM).astype(F32)
    kh = mem_k.reshape(B, M, XA_HEADS, XA_HEAD_DIM).astype(F32)
    vh = mem_v.reshape(B, M, XA_HEADS, XA_HEAD_DIM).astype(F32)
    s = jnp.einsum('bshd,bmhd->bhsm', qh, kh) * (XA_HEAD_DIM ** -0.5)
    p = jax.nn.softmax(s, axis=-1)
    o = jnp.einsum('bhsm,bmhd->bshd', p, vh)
    return o.reshape(B, S, XA_WIDTH).astype(q.dtype)


def conv_glu_ffn(h, w_up, w_conv, b_conv, w_down):
    a, u = jnp.split(h @ w_up, 2, axis=-1)
    return (jax.nn.gelu(dwconv3(a, w_conv, b_conv)) * u) @ w_down


def setup_inputs(seed: int = 0) -> dict:
    key = jax.random.key(seed)
    ks = jax.random.split(key, 24)

    def dense(k, shape, fan_in):
        return jax.random.normal(k, shape, F32) * (fan_in ** -0.5)

    def gain(k, shape):
        return 1.0 + 0.05 * jax.random.normal(k, shape, F32)

    def small(k, shape, scale):
        return scale * jax.random.normal(k, shape, F32)

    L = DEPTH
    return {
        "x": jax.random.normal(ks[0], (BATCH, SEQ, D_MODEL), F32),
        "mem": jax.random.normal(ks[1], (BATCH, MEM_LEN, D_MODEL), F32),
        "mix_norm_g": gain(ks[2], (L, D_MODEL)),
        "w_in": dense(ks[3], (L, D_MODEL, IN_WIDTH), D_MODEL),
        "b_ml_igate": small(ks[4], (L, 2, ML_HEADS), 0.1),
        "b_ml_fgate": jnp.linspace(3.0, 6.0, ML_HEADS, dtype=F32) + small(ks[5], (L, 2, ML_HEADS), 0.1),
        "w_ml_conv": dense(ks[6], (L, CONV_W, 2 * ML_WIDTH), CONV_W),
        "b_ml_conv": small(ks[7], (L, 2 * ML_WIDTH), 0.02),
        "ml_norm_g": gain(ks[8], (L, ML_WIDTH)),
        "na_rpb": small(ks[9], (L, NA_HEADS, 2 * NA_WIN_ROWS_MAX - 1, 2 * NA_WIN_COLS - 1), 0.1),
        "mem_norm_g": gain(ks[10], (L, D_MODEL)),
        "w_mem_kv": dense(ks[11], (L, D_MODEL, 2 * XA_WIDTH), D_MODEL),
        "b_merge_gate": small(ks[12], (L, N_BRANCHES * D_MODEL), 0.02),
        "w_br_ml": dense(ks[13], (L, ML_WIDTH, D_MODEL), ML_WIDTH),
        "w_br_na": dense(ks[14], (L, NA_WIDTH, D_MODEL), NA_WIDTH),
        "w_br_xa": dense(ks[15], (L, XA_WIDTH, D_MODEL), XA_WIDTH),
        "w_out": dense(ks[16], (L, D_MODEL, D_MODEL), D_MODEL),
        "ffn_norm_g": gain(ks[17], (L, D_MODEL)),
        "w_ffn_up": dense(ks[18], (L, D_MODEL, 2 * D_FF), D_MODEL),
        "w_ffn_conv": dense(ks[19], (L, CONV_W, D_FF), CONV_W),
        "b_ffn_conv": small(ks[20], (L, D_FF), 0.02),
        "w_ffn_down": dense(ks[21], (L, D_FF, D_MODEL), D_FF),
        "final_norm_g": gain(ks[22], (D_MODEL,)),
    }


def reference(x, mem, mix_norm_g, w_in, b_ml_igate, b_ml_fgate, w_ml_conv, b_ml_conv, ml_norm_g,
              na_rpb, mem_norm_g, w_mem_kv, b_merge_gate, w_br_ml, w_br_na, w_br_xa, w_out,
              ffn_norm_g, w_ffn_up, w_ffn_conv, b_ffn_conv, w_ffn_down, final_norm_g):
    split_points = [int(p) for p in np.cumsum(IN_SPLITS)[:-1]]
    for l in range(DEPTH):
        h = rms_norm(x, mix_norm_g[l])
        proj = h @ w_in[l]
        ml_q, ml_k, ml_v, ml_o, ml_gates, na_qkv, xa_q, merge_pre = jnp.split(proj, split_points, axis=-1)
        y_ml = mlstm_branch(ml_q, ml_k, ml_v, ml_o, ml_gates, w_ml_conv[l], b_ml_conv[l],
                            b_ml_igate[l], b_ml_fgate[l], ml_norm_g[l])
        na_q, na_k, na_v = jnp.split(na_qkv, 3, axis=-1)
        y_na = neighbourhood_attention(na_q, na_k, na_v, na_rpb[l])
        mem_k, mem_v = jnp.split(rms_norm(mem, mem_norm_g[l]) @ w_mem_kv[l], 2, axis=-1)
        y_xa = memory_cross_attention(xa_q, mem_k, mem_v)
        gates = jax.nn.sigmoid((merge_pre + b_merge_gate[l]).astype(F32)).astype(x.dtype)
        g_ml, g_na, g_xa = jnp.split(gates, N_BRANCHES, axis=-1)
        merged = g_ml * (y_ml @ w_br_ml[l]) + g_na * (y_na @ w_br_na[l]) + g_xa * (y_xa @ w_br_xa[l])
        x = x + merged @ w_out[l]
        x = x + conv_glu_ffn(rms_norm(x, ffn_norm_g[l]), w_ffn_up[l], w_ffn_conv[l], b_ffn_conv[l], w_ffn_down[l])
    return rms_norm(x, final_norm_g)
```

```cpp
#include <hip/hip_runtime.h>
#include <hip/hip_cooperative_groups.h>
#include <cstdio>
#include <cstdint>
namespace cg = cooperative_groups;

#define LAS __attribute__((address_space(3)))
typedef unsigned short bf16_t;
typedef short bf16x8 __attribute__((ext_vector_type(8)));
typedef short s16x4 __attribute__((ext_vector_type(4)));
typedef float f32x4 __attribute__((ext_vector_type(4)));
typedef float f32x16 __attribute__((ext_vector_type(16)));
typedef unsigned u32x4 __attribute__((ext_vector_type(4)));
typedef unsigned u32x2 __attribute__((ext_vector_type(2)));

typedef float f32x2_t __attribute__((ext_vector_type(2))); typedef __bf16 bf16x2_t __attribute__((ext_vector_type(2)));
__device__ __forceinline__ unsigned cvt_pk_bf16(float lo, float hi) { f32x2_t v = {lo, hi}; bf16x2_t b = __builtin_convertvector(v, bf16x2_t); return __builtin_bit_cast(unsigned, b); }
__device__ __forceinline__ float bf_lo(unsigned w) { return __uint_as_float(w << 16); }
__device__ __forceinline__ float bf_hi(unsigned w) { return __uint_as_float(w & 0xffff0000u); }
__device__ __forceinline__ float fast_exp2(float x) { return __builtin_amdgcn_exp2f(x); }
__device__ __forceinline__ float fast_exp(float x) { return __builtin_amdgcn_exp2f(x * 1.4426950408889634f); }
__device__ __forceinline__ float fast_rcp(float x) { return __builtin_amdgcn_rcpf(x); }
__device__ __forceinline__ float sigmoidf_(float x) { return fast_rcp(1.0f + fast_exp(-x)); }
#define LDS_WAIT() asm volatile("s_waitcnt lgkmcnt(0)" ::: "memory")

namespace pg8 {
#define PG8_LAS __attribute__((address_space(3)))
constexpr int BM = 256, BK = 64, HALF = 128, HTB = HALF * BK * 2, STAGE_BYTES = 8 * HTB, NXCD = 8, WGM = 8;
__host__ __device__ __forceinline__ int lds_byte(int r, int c) { const int st = (r >> 4) * 2 + (c >> 5), rr = r & 15, cc = c & 31, ob = rr * 64 + cc * 2; return st * 1024 + (ob ^ (((ob >> 9) & 1) << 5)); }
__host__ __device__ __forceinline__ void stage_rc(int b, int& R, int& C) { const int st = b / 1024, sb = b % 1024, swz = sb ^ (((sb >> 9) & 1) << 5); R = (st >> 1) * 16 + swz / 64; C = (st & 1) * 32 + (swz % 64) / 2; }
__host__ __device__ __forceinline__ int perm32(int rho) { const int n = rho >> 4, i = rho & 15; return 8 * (i >> 2) + 4 * n + (i & 3); }
struct Unit { int pm, pn; };
struct Gemm { const bf16_t* A; const bf16_t* Bt; int M, N, K; };
struct StaticOrder {
    int nM, nN, nwg, G, c;
    __host__ __device__ void init(int M, int N, int G_, int c_) { nM = M / BM; nN = N / BM; nwg = nM * nN; G = G_; c = c_; }
    __host__ __device__ bool next(int i, Unit& u) const {
        const long L = (long)i * G + c; if (L >= nwg) return false;
        int wgid = (int)L; { const int q = nwg / NXCD, r = nwg % NXCD, xcd = wgid % NXCD, off = wgid / NXCD; wgid = (xcd < r ? xcd * (q + 1) : r * (q + 1) + (xcd - r) * q) + off; }
        const int nig = WGM * nN, gid = wgid / nig, fm = gid * WGM, gsz = (nM - fm) < WGM ? (nM - fm) : WGM;
        u.pm = fm + ((wgid % nig) % gsz); u.pn = (wgid % nig) / gsz; return true;
    }
    __device__ __forceinline__ void a_ready(const Unit&) const {}
    __device__ __forceinline__ void done(const Unit&) const {}
};
template <class Epi, class Sched, bool ALIGN_EPI = false, bool SP2 = false>
__device__ __forceinline__ void gemm_phase(PG8_LAS unsigned char* lds, const Gemm g, const Sched& S, const Epi& E) {
    int tid_ = threadIdx.x; asm volatile("" : "+v"(tid_));
    const int tid = tid_, wid = __builtin_amdgcn_readfirstlane(tid >> 6), lane = tid & 63, wr = wid >> 2, wc = wid & 3, fr = lane & 15, fq = lane >> 4;
    const int K = g.K, nt = K / BK;
    unsigned voffA[2], voffB[2];
#pragma unroll
    for (int i = 0; i < 2; ++i) { int R, C; stage_rc(tid * 16 + i * 8192, R, C); const int Rb = Epi::PERM ? ((R & ~31) + perm32(R & 31)) : R;
        voffA[i] = (unsigned)(R * K + C) * 2u; voffB[i] = (unsigned)(Rb * K + C) * 2u; }
    const size_t kstep = (size_t)(BK * 2);
    const size_t hstep = (size_t)HALF * K * 2;
    const size_t tstep = 2 * hstep;
    const unsigned ldsw = (unsigned)wid * 1024u;
    const int aoff = lds_byte(wr * 64 + fr, fq * 8), boff = lds_byte(wc * 32 + fr, fq * 8);
#define PG8_SA(b, h) (((b) * 2 + (h)) * HTB)
#define PG8_SB(b, h) ((4 + (b) * 2 + (h)) * HTB)
#define PG8_STAGE(bufoff, gbase, voff) do { _Pragma("unroll") for (int _i = 0; _i < 2; ++_i) \
        __builtin_amdgcn_global_load_lds((const unsigned*)((const char*)(gbase) + (voff)[_i]), (PG8_LAS unsigned*)(lds + (bufoff) + ldsw + _i * 8192), 16, 0, 0); } while (0)
#define PG8_LDA(dst, b, h) do { _Pragma("unroll") for (int m = 0; m < 4; ++m) _Pragma("unroll") for (int k = 0; k < 2; ++k) dst[m][k] = *(const PG8_LAS bf16x8*)(lds + PG8_SA(b, h) + aoff + m * 2048 + k * 1024); } while (0)
#define PG8_LDB(dst, b, h) do { _Pragma("unroll") for (int n = 0; n < 2; ++n) _Pragma("unroll") for (int k = 0; k < 2; ++k) dst[n][k] = *(const PG8_LAS bf16x8*)(lds + PG8_SB(b, h) + boff + n * 2048 + k * 1024); } while (0)
#define PG8_MMA(ai, bj, At, Bt) do { __builtin_amdgcn_s_setprio(1); _Pragma("unroll") for (int m = 0; m < 4; ++m) _Pragma("unroll") for (int n = 0; n < 2; ++n) _Pragma("unroll") for (int k = 0; k < 2; ++k) \
        acc[ai][bj][m][n] = __builtin_amdgcn_mfma_f32_16x16x32_bf16(Bt[n][k], At[m][k], acc[ai][bj][m][n], 0, 0, 0); __builtin_amdgcn_s_setprio(0); } while (0)
#define PG8_WAIT_V(n) asm volatile("s_waitcnt vmcnt(" #n ")" ::: "memory")
#define PG8_WAIT_L(n) asm volatile("s_waitcnt lgkmcnt(" #n ")" ::: "memory")
#define PG8_BAR __builtin_amdgcn_s_barrier()
#define PG8_SCHED __builtin_amdgcn_sched_barrier(0)
    Unit cur, nxt; int ui = 0;
    if (!S.next(0, cur)) return;
    f32x4 acc[2][2][4][2];
#pragma unroll
    for (int a = 0; a < 2; ++a)
#pragma unroll
        for (int b = 0; b < 2; ++b)
#pragma unroll
            for (int m = 0; m < 4; ++m)
#pragma unroll
                for (int n = 0; n < 2; ++n) acc[a][b][m][n] = (f32x4){0.f, 0.f, 0.f, 0.f};
    bf16x8 At[4][2], B0[2][2], B1[2][2];
    const char* cA = (const char*)g.A + (size_t)cur.pm * tstep; const char* cB = (const char*)g.Bt + (size_t)cur.pn * tstep;
    S.a_ready(cur);
    if constexpr (SP2) {
        PG8_STAGE(PG8_SB(0, 0), cB, voffB); PG8_STAGE(PG8_SB(0, 1), cB + hstep, voffB); PG8_STAGE(PG8_SA(0, 0), cA, voffA); PG8_STAGE(PG8_SA(0, 1), cA + hstep, voffA);
        if (wr == 1) PG8_BAR;
        PG8_WAIT_V(2); PG8_BAR;
        PG8_STAGE(PG8_SB(1, 0), cB + kstep, voffB); PG8_STAGE(PG8_SA(1, 0), cA + kstep, voffA); PG8_STAGE(PG8_SB(1, 1), cB + hstep + kstep, voffB);
        PG8_WAIT_V(6); PG8_BAR;
    } else {
        PG8_STAGE(PG8_SB(0, 0), cB, voffB); PG8_STAGE(PG8_SA(0, 0), cA, voffA); PG8_STAGE(PG8_SB(0, 1), cB + hstep, voffB); PG8_STAGE(PG8_SA(0, 1), cA + hstep, voffA);
        if (wr == 1) PG8_BAR;
        PG8_WAIT_V(4); PG8_BAR;
        PG8_STAGE(PG8_SB(1, 0), cB + kstep, voffB); PG8_STAGE(PG8_SA(1, 0), cA + kstep, voffA); PG8_STAGE(PG8_SB(1, 1), cB + hstep + kstep, voffB);
        PG8_WAIT_V(6); PG8_BAR;
    }
    for (;;) {
        const bool has_next = S.next(ui + 1, nxt);
        const char* nA = has_next ? (const char*)g.A + (size_t)nxt.pm * tstep : cA; const char* nB = has_next ? (const char*)g.Bt + (size_t)nxt.pn * tstep : cB;
        for (int t = 0; t < nt; t += 2) {
            const bool last = (t == nt - 2);
            const char* a1 = cA + (size_t)(t + 1) * kstep;
            const char* a2 = last ? nA : cA + (size_t)(t + 2) * kstep; const char* b2 = last ? nB : cB + (size_t)(t + 2) * kstep;
            const char* a3 = a2 + kstep; const char* b3 = b2 + kstep;
            if (last && has_next) S.a_ready(nxt);
            if constexpr (SP2) {
            PG8_LDB(B0, 0, 0); PG8_LDB(B1, 0, 1); PG8_SCHED; PG8_LDA(At, 0, 0); PG8_STAGE(PG8_SA(1, 1), a1 + hstep, voffA);
            PG8_WAIT_V(8); PG8_WAIT_L(0); PG8_BAR; PG8_MMA(0, 0, At, B0); PG8_MMA(0, 1, At, B1); PG8_BAR; PG8_SCHED;
            PG8_LDA(At, 0, 1); PG8_STAGE(PG8_SB(0, 0), b2, voffB); PG8_STAGE(PG8_SB(0, 1), b2 + hstep, voffB); PG8_STAGE(PG8_SA(0, 0), a2, voffA);
            PG8_WAIT_V(8); PG8_WAIT_L(0); PG8_BAR; PG8_MMA(1, 0, At, B0); PG8_MMA(1, 1, At, B1); PG8_BAR; PG8_SCHED;
            PG8_LDB(B0, 1, 0); PG8_LDB(B1, 1, 1); PG8_SCHED; PG8_LDA(At, 1, 0); PG8_STAGE(PG8_SA(0, 1), a2 + hstep, voffA);
            PG8_WAIT_V(8); PG8_WAIT_L(0); PG8_BAR; PG8_MMA(0, 0, At, B0); PG8_MMA(0, 1, At, B1); PG8_BAR; PG8_SCHED;
            PG8_LDA(At, 1, 1); PG8_STAGE(PG8_SB(1, 0), b3, voffB); PG8_STAGE(PG8_SB(1, 1), b3 + hstep, voffB); PG8_STAGE(PG8_SA(1, 0), a3, voffA);
            PG8_WAIT_V(8); PG8_WAIT_L(0); PG8_BAR; PG8_MMA(1, 0, At, B0); PG8_MMA(1, 1, At, B1); PG8_BAR; PG8_SCHED;
            } else {
            PG8_LDB(B0, 0, 0); PG8_SCHED; PG8_LDA(At, 0, 0); PG8_STAGE(PG8_SA(1, 1), a1 + hstep, voffA);
            PG8_WAIT_L(8); PG8_BAR; PG8_WAIT_L(0); PG8_MMA(0, 0, At, B0); PG8_BAR; PG8_SCHED;
            PG8_LDB(B1, 0, 1); PG8_STAGE(PG8_SB(0, 0), b2, voffB);
            PG8_BAR; PG8_WAIT_L(0); PG8_MMA(0, 1, At, B1); PG8_BAR;
            PG8_LDA(At, 0, 1); PG8_STAGE(PG8_SA(0, 0), a2, voffA);
            PG8_BAR; PG8_WAIT_L(0); PG8_MMA(1, 0, At, B0); PG8_BAR; PG8_SCHED;
            PG8_STAGE(PG8_SB(0, 1), b2 + hstep, voffB);
            PG8_WAIT_V(6); PG8_BAR; PG8_MMA(1, 1, At, B1); PG8_BAR;
            PG8_LDB(B0, 1, 0); PG8_SCHED; PG8_LDA(At, 1, 0); PG8_STAGE(PG8_SA(0, 1), a2 + hstep, voffA);
            PG8_WAIT_L(8); PG8_BAR; PG8_WAIT_L(0); PG8_MMA(0, 0, At, B0); PG8_BAR; PG8_SCHED;
            PG8_LDB(B1, 1, 1); PG8_STAGE(PG8_SB(1, 0), b3, voffB);
            PG8_BAR; PG8_WAIT_L(0); PG8_MMA(0, 1, At, B1); PG8_BAR;
            PG8_LDA(At, 1, 1); PG8_STAGE(PG8_SA(1, 0), a3, voffA);
            PG8_BAR; PG8_WAIT_L(0); PG8_MMA(1, 0, At, B0); PG8_BAR; PG8_SCHED;
            PG8_STAGE(PG8_SB(1, 1), b3 + hstep, voffB);
            PG8_WAIT_V(6); PG8_BAR; PG8_MMA(1, 1, At, B1); PG8_BAR;
            }
        }
        if constexpr (ALIGN_EPI) { if (wr == 0) PG8_BAR; }
        if constexpr (!Epi::AFTER_DRAIN) { E(acc, cur, wr, wc, fr, fq); S.done(cur); }
        if (!has_next) break;
#pragma unroll
        for (int a = 0; a < 2; ++a)
#pragma unroll
            for (int b = 0; b < 2; ++b)
#pragma unroll
                for (int m = 0; m < 4; ++m)
#pragma unroll
                    for (int n = 0; n < 2; ++n) acc[a][b][m][n] = (f32x4){0.f, 0.f, 0.f, 0.f};
        cur = nxt; cA = nA; cB = nB; ++ui;
        if constexpr (ALIGN_EPI) { if (wr == 1) PG8_BAR; }
    }
    PG8_WAIT_V(0);
    if constexpr (!ALIGN_EPI) { if (wr == 0) PG8_BAR; }
    PG8_BAR;
    if constexpr (Epi::AFTER_DRAIN) { E.fused(acc, cur, wr, wc, fr, fq, lds, wid, lane); S.done(cur); }
#undef PG8_SA
#undef PG8_SB
#undef PG8_STAGE
#undef PG8_LDA
#undef PG8_LDB
#undef PG8_MMA
#undef PG8_WAIT_V
#undef PG8_WAIT_L
#undef PG8_BAR
#undef PG8_SCHED
}
}

constexpr int NTOK = 16384, DM = 1024, SEQ = 2048, NBATCH = 8, MEMLEN = 256, NMEM = NBATCH * MEMLEN, DFF = 2816;
constexpr int INW = 7184, INW_P = 7168;
constexpr float EPS = 1e-6f;
constexpr float LOG2E = 1.4426950408889634f;
constexpr size_t MiB = 1u << 20;
constexpr size_t WS_MLQ = 0, WS_MLK = 16 * MiB, WS_MLV = 32 * MiB, WS_MLO = 48 * MiB, WS_NAQ = 64 * MiB, WS_XAQ = 80 * MiB, WS_NAK = 96 * MiB, WS_NAVT = 112 * MiB, WS_G = 128 * MiB;
constexpr size_t WS_WBR = 224 * MiB, WS_WOUT = 227 * MiB, WS_WUP = 229 * MiB, WS_WDOWN = 240 * MiB, WS_MEMK = 246 * MiB, WS_MEMVT = 248 * MiB, WS_GATES = 250 * MiB, WS_RSS1 = 251 * MiB;
constexpr size_t WS_NEED = 252 * MiB;
constexpr size_t WS_MERGED = WS_MLK, WS_X1B = WS_NAK, WS_UBUF = 0, WS_ABUF = WS_G;
constexpr size_t DO_H = 0, DO_WINT = 32 * MiB, DO_WMEMKVT = 46 * MiB, DO_MEMN = 48 * MiB, DO_HFW = 0, DO_HBW = 32 * MiB;
constexpr int LDS_BYTES = 155648;
constexpr int XA_K_PITCH = 272, XA_VT_PITCH = 528, XA_VT_OFF = 256 * XA_K_PITCH;
constexpr int NA_RPB_OFF = 140000;
constexpr int ML_QP = 272, ML_TP = 144;
constexpr int ML_QS = 0, ML_KS = ML_QS + 64 * ML_QP, ML_KT = ML_KS + 64 * ML_QP, ML_VT = ML_KT + 128 * ML_TP, ML_WVT = ML_VT + 128 * ML_TP, ML_PS = ML_WVT + 128 * ML_TP;
constexpr int ML_NV = ML_PS + 64 * ML_TP, ML_ROWSUM = ML_NV + 2 * 128 * 4, ML_DENI = ML_ROWSUM + 1024, ML_WTS = ML_DENI + 256, ML_CW = ML_WTS + 256, ML_END = ML_CW + 4 * 256 * 4;
static_assert(ML_END <= LDS_BYTES, "mlstm lds");

struct Params { const float* in[23]; float* out; unsigned char* ws; };

struct EpiProj {
    static constexpr bool PERM = true, AFTER_DRAIN = false;
    unsigned char* ws; const float* bmerge;
    __device__ __forceinline__ void operator()(const f32x4 (&acc)[2][2][4][2], const pg8::Unit& u, int wr, int wc, int fr, int fq) const {
        const int row0 = u.pm * 256 + wr * 64 + fr; const int pn = u.pn; const int cl = wc * 32 + 8 * fq;
        if (pn >= 16) {
            bf16_t* G = (bf16_t*)(ws + WS_G); const int cg0 = (pn - 16) * 256 + cl;
            f32x4 bv[2][2];
#pragma unroll
            for (int bj = 0; bj < 2; ++bj)
#pragma unroll
                for (int n = 0; n < 2; ++n) bv[bj][n] = *(const f32x4*)(bmerge + cg0 + bj * 128 + 4 * n);
#pragma unroll
            for (int ai = 0; ai < 2; ++ai)
#pragma unroll
                for (int m = 0; m < 4; ++m) { const size_t row = row0 + ai * 128 + m * 16;
#pragma unroll
                    for (int bj = 0; bj < 2; ++bj) { const f32x4 v0 = acc[ai][bj][m][0] + bv[bj][0], v1 = acc[ai][bj][m][1] + bv[bj][1];
                        u32x4 w; w.x = cvt_pk_bf16(sigmoidf_(v0[0]), sigmoidf_(v0[1])); w.y = cvt_pk_bf16(sigmoidf_(v0[2]), sigmoidf_(v0[3]));
                        w.z = cvt_pk_bf16(sigmoidf_(v1[0]), sigmoidf_(v1[1])); w.w = cvt_pk_bf16(sigmoidf_(v1[2]), sigmoidf_(v1[3]));
                        *(u32x4*)(G + row * 3072 + cg0 + bj * 128) = w; } }
        } else {
            const int bi = pn >> 1, coff = (pn & 1) * 256 + cl;
            if (bi == 6) {
                bf16_t* VT = (bf16_t*)(ws + WS_NAVT);
#pragma unroll
                for (int ai = 0; ai < 2; ++ai)
#pragma unroll
                    for (int m = 0; m < 4; ++m) { const int row = row0 + ai * 128 + m * 16; const int b = row >> 11, tok = row & 2047;
#pragma unroll
                        for (int bj = 0; bj < 2; ++bj)
#pragma unroll
                            for (int n = 0; n < 2; ++n)
#pragma unroll
                                for (int i = 0; i < 4; ++i) { const int col = coff + bj * 128 + 4 * n + i;
                                    VT[((size_t)(b * 512 + col)) * 2048 + tok] = (bf16_t)(cvt_pk_bf16(acc[ai][bj][m][n][i], 0.f) & 0xffffu); } }
            } else {
                const size_t boff = bi == 0 ? WS_MLQ : bi == 1 ? WS_MLK : bi == 2 ? WS_MLV : bi == 3 ? WS_MLO : bi == 4 ? WS_NAQ : bi == 5 ? WS_NAK : WS_XAQ;
                bf16_t* O = (bf16_t*)(ws + boff);
#pragma unroll
                for (int ai = 0; ai < 2; ++ai)
#pragma unroll
                    for (int m = 0; m < 4; ++m) { const size_t row = row0 + ai * 128 + m * 16;
#pragma unroll
                        for (int bj = 0; bj < 2; ++bj) { const f32x4 v0 = acc[ai][bj][m][0], v1 = acc[ai][bj][m][1];
                            u32x4 w; w.x = cvt_pk_bf16(v0[0], v0[1]); w.y = cvt_pk_bf16(v0[2], v0[3]); w.z = cvt_pk_bf16(v1[0], v1[1]); w.w = cvt_pk_bf16(v1[2], v1[3]);
                            *(u32x4*)(O + row * 512 + coff + bj * 128) = w; } }
            }
        }
    }
};
struct EpiMemKV {
    static constexpr bool PERM = true, AFTER_DRAIN = false;
    unsigned char* ws;
    __device__ __forceinline__ void operator()(const f32x4 (&acc)[2][2][4][2], const pg8::Unit& u, int wr, int wc, int fr, int fq) const {
        const int row0 = u.pm * 256 + wr * 64 + fr; const int pn = u.pn; const int coff = (pn & 1) * 256 + wc * 32 + 8 * fq;
        if (pn < 2) { bf16_t* O = (bf16_t*)(ws + WS_MEMK);
#pragma unroll
            for (int ai = 0; ai < 2; ++ai)
#pragma unroll
                for (int m = 0; m < 4; ++m) { const size_t row = row0 + ai * 128 + m * 16;
#pragma unroll
                    for (int bj = 0; bj < 2; ++bj) { const f32x4 v0 = acc[ai][bj][m][0], v1 = acc[ai][bj][m][1];
                        u32x4 w; w.x = cvt_pk_bf16(v0[0], v0[1]); w.y = cvt_pk_bf16(v0[2], v0[3]); w.z = cvt_pk_bf16(v1[0], v1[1]); w.w = cvt_pk_bf16(v1[2], v1[3]);
                        *(u32x4*)(O + row * 512 + coff + bj * 128) = w; } }
        } else { bf16_t* VT = (bf16_t*)(ws + WS_MEMVT);
#pragma unroll
            for (int ai = 0; ai < 2; ++ai)
#pragma unroll
                for (int m = 0; m < 4; ++m) { const int row = row0 + ai * 128 + m * 16; const int b = row >> 8, mm = row & 255;
#pragma unroll
                    for (int bj = 0; bj < 2; ++bj)
#pragma unroll
                        for (int n = 0; n < 2; ++n)
#pragma unroll
                            for (int i = 0; i < 4; ++i) { const int col = coff + bj * 128 + 4 * n + i;
                                VT[((size_t)(b * 512 + col)) * 256 + mm] = (bf16_t)(cvt_pk_bf16(acc[ai][bj][m][n][i], 0.f) & 0xffffu); } }
        }
    }
};
template <int MODE> struct EpiBranch {
    static constexpr bool PERM = true, AFTER_DRAIN = false;
    const bf16_t* G; float* tmp; bf16_t* merged; int br;
    __device__ __forceinline__ void operator()(const f32x4 (&acc)[2][2][4][2], const pg8::Unit& u, int wr, int wc, int fr, int fq) const {
        const int row0 = u.pm * 256 + wr * 64 + fr; const int col0 = u.pn * 256 + wc * 32 + 8 * fq;
#pragma unroll
        for (int ai = 0; ai < 2; ++ai)
#pragma unroll
            for (int m = 0; m < 4; ++m) { const size_t row = row0 + ai * 128 + m * 16;
#pragma unroll
                for (int bj = 0; bj < 2; ++bj) { const int col = col0 + bj * 128;
                    const u32x4 gw = *(const u32x4*)(G + row * 3072 + br * 1024 + col);
                    f32x4 v0 = acc[ai][bj][m][0], v1 = acc[ai][bj][m][1];
                    v0[0] *= bf_lo(gw.x); v0[1] *= bf_hi(gw.x); v0[2] *= bf_lo(gw.y); v0[3] *= bf_hi(gw.y);
                    v1[0] *= bf_lo(gw.z); v1[1] *= bf_hi(gw.z); v1[2] *= bf_lo(gw.w); v1[3] *= bf_hi(gw.w);
                    float* tp = tmp + row * 1024 + col;
                    if (MODE >= 1) { v0 += *(const f32x4*)tp; v1 += *(const f32x4*)(tp + 4); }
                    if (MODE <= 1) { *(f32x4*)tp = v0; *(f32x4*)(tp + 4) = v1; }
                    else { u32x4 w; w.x = cvt_pk_bf16(v0[0], v0[1]); w.y = cvt_pk_bf16(v0[2], v0[3]); w.z = cvt_pk_bf16(v1[0], v1[1]); w.w = cvt_pk_bf16(v1[2], v1[3]);
                        *(u32x4*)(merged + row * 1024 + col) = w; } } }
    }
};
struct EpiOut {
    static constexpr bool PERM = true, AFTER_DRAIN = false;
    const float* x; float* x1; bf16_t* x1b; float* rss;
    __device__ __forceinline__ void operator()(const f32x4 (&acc)[2][2][4][2], const pg8::Unit& u, int wr, int wc, int fr, int fq) const {
        const int row0 = u.pm * 256 + wr * 64 + fr; const int col0 = u.pn * 256 + wc * 32 + 8 * fq;
#pragma unroll
        for (int ai = 0; ai < 2; ++ai)
#pragma unroll
            for (int m = 0; m < 4; ++m) { const size_t row = row0 + ai * 128 + m * 16; float ss = 0.f;
#pragma unroll
                for (int bj = 0; bj < 2; ++bj) { const size_t off = row * 1024 + col0 + bj * 128;
                    const f32x4 v0 = acc[ai][bj][m][0] + *(const f32x4*)(x + off), v1 = acc[ai][bj][m][1] + *(const f32x4*)(x + off + 4);
                    *(f32x4*)(x1 + off) = v0; *(f32x4*)(x1 + off + 4) = v1;
                    u32x4 w; w.x = cvt_pk_bf16(v0[0], v0[1]); w.y = cvt_pk_bf16(v0[2], v0[3]); w.z = cvt_pk_bf16(v1[0], v1[1]); w.w = cvt_pk_bf16(v1[2], v1[3]);
                    *(u32x4*)(x1b + off) = w;
                    ss += (v0[0] * v0[0] + v0[1] * v0[1]) + (v0[2] * v0[2] + v0[3] * v0[3]) + (v1[0] * v1[0] + v1[1] * v1[1]) + (v1[2] * v1[2] + v1[3] * v1[3]); }
                ss += __shfl_xor(ss, 16); ss += __shfl_xor(ss, 32);
                if (fq == 0) atomicAdd(rss + row, ss); }
    }
};
struct EpiUp {
    static constexpr bool PERM = true, AFTER_DRAIN = false;
    const float* rss; bf16_t* A; bf16_t* U;
    __device__ __forceinline__ void operator()(const f32x4 (&acc)[2][2][4][2], const pg8::Unit& u, int wr, int wc, int fr, int fq) const {
        const int row0 = u.pm * 256 + wr * 64 + fr; const int pn = u.pn;
        bf16_t* O = pn < 11 ? A : U; const int col0 = (pn < 11 ? pn : pn - 11) * 256 + wc * 32 + 8 * fq;
#pragma unroll
        for (int ai = 0; ai < 2; ++ai)
#pragma unroll
            for (int m = 0; m < 4; ++m) { const size_t row = row0 + ai * 128 + m * 16; const float rstd = rsqrtf(rss[row] * (1.0f / 1024.0f) + EPS);
#pragma unroll
                for (int bj = 0; bj < 2; ++bj) { const f32x4 v0 = acc[ai][bj][m][0] * rstd, v1 = acc[ai][bj][m][1] * rstd;
                    u32x4 w; w.x = cvt_pk_bf16(v0[0], v0[1]); w.y = cvt_pk_bf16(v0[2], v0[3]); w.z = cvt_pk_bf16(v1[0], v1[1]); w.w = cvt_pk_bf16(v1[2], v1[3]);
                    *(u32x4*)(O + row * 2816 + col0 + bj * 128) = w; } }
    }
};
struct EpiDown {
    static constexpr bool PERM = true, AFTER_DRAIN = false;
    float* x1;
    __device__ __forceinline__ void operator()(const f32x4 (&acc)[2][2][4][2], const pg8::Unit& u, int wr, int wc, int fr, int fq) const {
        const int row0 = u.pm * 256 + wr * 64 + fr; const int col0 = u.pn * 256 + wc * 32 + 8 * fq;
#pragma unroll
        for (int ai = 0; ai < 2; ++ai)
#pragma unroll
            for (int m = 0; m < 4; ++m) { const size_t row = row0 + ai * 128 + m * 16;
#pragma unroll
                for (int bj = 0; bj < 2; ++bj) { float* p = x1 + row * 1024 + col0 + bj * 128;
                    const f32x4 v0 = acc[ai][bj][m][0] + *(const f32x4*)p, v1 = acc[ai][bj][m][1] + *(const f32x4*)(p + 4);
                    *(f32x4*)p = v0; *(f32x4*)(p + 4) = v1; } }
    }
};

__device__ __forceinline__ float wave_sum(float v) {
#pragma unroll
    for (int o = 1; o < 64; o <<= 1) v += __shfl_xor(v, o);
    return v;
}
__device__ __forceinline__ void transpose_item(const float* W, int ldw, int col0, int k0, bf16_t* WT, int K, int row_dst0, const float* kscale, LAS float* scr, int lane) {
#pragma unroll 8
    for (int i = 0; i < 32; ++i) { const int kk = 2 * i + (lane >> 5); float v = W[(size_t)(k0 + kk) * ldw + col0 + (lane & 31)]; if (kscale) v *= kscale[k0 + kk]; scr[kk * 33 + (lane & 31)] = v; }
    LDS_WAIT(); asm volatile("" ::: "memory");
    const int c = lane & 7;
#pragma unroll
    for (int j = 0; j < 4; ++j) { const int n = (lane >> 3) + 8 * j; const LAS float* s = scr + (8 * c) * 33 + n;
        u32x4 o; o.x = cvt_pk_bf16(s[0 * 33], s[1 * 33]); o.y = cvt_pk_bf16(s[2 * 33], s[3 * 33]); o.z = cvt_pk_bf16(s[4 * 33], s[5 * 33]); o.w = cvt_pk_bf16(s[6 * 33], s[7 * 33]);
        *(u32x4*)(WT + (size_t)(row_dst0 + n) * K + k0 + 8 * c) = o; }
    LDS_WAIT(); asm volatile("" ::: "memory");
}
__device__ __forceinline__ void p0_prologue(LAS unsigned char* lds, const Params& P, int G) {
    int tid_ = threadIdx.x; asm volatile("" : "+v"(tid_)); const int tid = tid_, lane = tid & 63, wave = tid >> 6;
    const int gw = blockIdx.x * 8 + wave, NGW = G * 8;
    unsigned char* ws = P.ws; unsigned char* dob = (unsigned char*)P.out;
    LAS float* scr = (LAS float*)(lds + wave * 8448);
    LAS float* tab = (LAS float*)(lds + 8 * 8448);
    { const float* win = P.in[3];
      for (int k = tid; k < 1024; k += 512) {
          const f32x4* src = (const f32x4*)(win + (size_t)k * INW + 2048);
#pragma unroll
          for (int q = 0; q < 4; ++q) { const f32x4 v = src[q]; tab[(4 * q + 0) * 1024 + k] = v[0]; tab[(4 * q + 1) * 1024 + k] = v[1]; tab[(4 * q + 2) * 1024 + k] = v[2]; tab[(4 * q + 3) * 1024 + k] = v[3]; } } }
    { float* rss = (float*)(ws + WS_RSS1); for (int i = blockIdx.x * 512 + tid; i < NTOK; i += G * 512) rss[i] = 0.f; }
    constexpr int I_IN = 16 * 224, I_MKV = 16 * 32, I_BR = 8 * 32, I_OUT = 16 * 32, I_UP = 16 * 176, I_DN = 44 * 32;
    constexpr int NITEMS = I_IN + I_MKV + 3 * I_BR + I_OUT + I_UP + I_DN;
    for (int it = gw; it < NITEMS; it += NGW) {
        int r = it;
        if (r < I_IN) { const int kb = r / 224, nb = r % 224, n0 = 32 * nb; transpose_item(P.in[3], INW, n0 + (n0 >= 2048 ? 16 : 0), 64 * kb, (bf16_t*)(dob + DO_WINT), 1024, n0, nullptr, scr, lane); continue; } r -= I_IN;
        if (r < I_MKV) { const int kb = r / 32, nb = r % 32; transpose_item(P.in[11], 1024, 32 * nb, 64 * kb, (bf16_t*)(dob + DO_WMEMKVT), 1024, 32 * nb, nullptr, scr, lane); continue; } r -= I_MKV;
        if (r < 3 * I_BR) { const int br = r / I_BR; r -= br * I_BR; const int kb = r / 32, nb = r % 32; transpose_item(P.in[13 + br], 1024, 32 * nb, 64 * kb, (bf16_t*)(ws + WS_WBR + br * MiB), 512, 32 * nb, nullptr, scr, lane); continue; } r -= 3 * I_BR;
        if (r < I_OUT) { const int kb = r / 32, nb = r % 32; transpose_item(P.in[16], 1024, 32 * nb, 64 * kb, (bf16_t*)(ws + WS_WOUT), 1024, 32 * nb, nullptr, scr, lane); continue; } r -= I_OUT;
        if (r < I_UP) { const int kb = r / 176, nb = r % 176; transpose_item(P.in[18], 5632, 32 * nb, 64 * kb, (bf16_t*)(ws + WS_WUP), 1024, 32 * nb, P.in[17], scr, lane); continue; } r -= I_UP;
        { const int kb = r / 32, nb = r % 32; transpose_item(P.in[21], 1024, 32 * nb, 64 * kb, (bf16_t*)(ws + WS_WDOWN), 2816, 32 * nb, nullptr, scr, lane); }
    }
    __syncthreads();
    for (int m = gw; m < NTOK + NMEM; m += NGW) {
        const bool is_x = m < NTOK;
        const float* xrow = is_x ? P.in[0] + (size_t)m * 1024 : P.in[1] + (size_t)(m - NTOK) * 1024;
        const float* gv = is_x ? P.in[2] : P.in[10];
        bf16_t* orow = is_x ? (bf16_t*)(dob + DO_H) + (size_t)m * 1024 : (bf16_t*)(dob + DO_MEMN) + (size_t)(m - NTOK) * 1024;
        f32x4 v[4]; float s = 0.f;
#pragma unroll
        for (int j = 0; j < 4; ++j) { v[j] = ((const f32x4*)xrow)[64 * j + lane]; s += (v[j][0] * v[j][0] + v[j][1] * v[j][1]) + (v[j][2] * v[j][2] + v[j][3] * v[j][3]); }
        const float rstd = rsqrtf(wave_sum(s) * (1.0f / 1024.0f) + EPS);
#pragma unroll
        for (int j = 0; j < 4; ++j) { const f32x4 g4 = ((const f32x4*)gv)[64 * j + lane]; v[j] = v[j] * rstd * g4;
            u32x2 w; w.x = cvt_pk_bf16(v[j][0], v[j][1]); w.y = cvt_pk_bf16(v[j][2], v[j][3]); ((u32x2*)orow)[64 * j + lane] = w; }
        if (is_x) {
            float myg = 0.f;
#pragma unroll
            for (int gi = 0; gi < 16; ++gi) { float a = 0.f;
#pragma unroll
                for (int j = 0; j < 4; ++j) { const f32x4 t = *(const LAS f32x4*)(tab + gi * 1024 + 256 * j + 4 * lane); a += (v[j][0] * t[0] + v[j][1] * t[1]) + (v[j][2] * t[2] + v[j][3] * t[3]); }
                a = wave_sum(a); if (lane == gi) myg = a; }
            if (lane < 16) ((float*)(ws + WS_GATES))[(size_t)m * 16 + lane] = myg;
        }
    }
}

__device__ __forceinline__ void xa_unit(LAS unsigned char* lds, unsigned char* ws, int unit) {
    const int b = unit >> 5, h = (unit >> 3) & 3, qb = unit & 7;
    int tid_ = threadIdx.x; asm volatile("" : "+v"(tid_)); const int tid = tid_, lane = tid & 63, wid = tid >> 6, r32 = lane & 31, hi = lane >> 5;
    const bf16_t* Kg = (const bf16_t*)(ws + WS_MEMK) + (size_t)(b * 256) * 512 + h * 128;
    const bf16_t* Vg = (const bf16_t*)(ws + WS_MEMVT) + (size_t)(b * 512 + h * 128) * 256;
#ifdef XA_TEST_OUT
    bf16_t* XA_OUT = (bf16_t*)(ws + WS_MLO);
#else
    bf16_t* XA_OUT = (bf16_t*)(ws + WS_XAQ);
#endif
    bf16_t* Q = (bf16_t*)(ws + WS_XAQ);
#pragma unroll
    for (int i = 0; i < 8; ++i) { const int idx = tid + 512 * i; const int row = idx >> 4, ch = idx & 15;
        const u32x4 v = *(const u32x4*)(Kg + (size_t)row * 512 + ch * 8); *(LAS u32x4*)(lds + row * XA_K_PITCH + ch * 16) = v; }
#pragma unroll
    for (int i = 0; i < 8; ++i) { const int idx = tid + 512 * i; const int d = idx >> 5, ch = idx & 31;
        const u32x4 v = *(const u32x4*)(Vg + (size_t)d * 256 + ch * 8); *(LAS u32x4*)(lds + XA_VT_OFF + d * XA_VT_PITCH + ch * 16) = v; }
    const size_t qrow = (size_t)b * 2048 + qb * 256 + wid * 32 + r32;
    bf16x8 qf[8];
#pragma unroll
    for (int s = 0; s < 8; ++s) qf[s] = *(const bf16x8*)(Q + qrow * 512 + h * 128 + 16 * s + 8 * hi);
    __syncthreads();
    const float sc = 0.08838834764831845f * LOG2E;
    f32x16 o[4];
#pragma unroll
    for (int d = 0; d < 4; ++d)
#pragma unroll
        for (int r = 0; r < 16; ++r) o[d][r] = 0.f;
    float mrun = -INFINITY, lsum = 0.f;
    for (int kt = 0; kt < 4; ++kt) {
        f32x16 p[2];
#pragma unroll
        for (int blk = 0; blk < 2; ++blk) {
#pragma unroll
            for (int r = 0; r < 16; ++r) p[blk][r] = 0.f;
            const LAS unsigned char* kp = lds + (64 * kt + 32 * blk + r32) * XA_K_PITCH + hi * 16;
#pragma unroll
            for (int s = 0; s < 8; ++s) { const bf16x8 kf = *(const LAS bf16x8*)(kp + s * 32); p[blk] = __builtin_amdgcn_mfma_f32_32x32x16_bf16(kf, qf[s], p[blk], 0, 0, 0); }
        }
        float tmax = p[0][0];
#pragma unroll
        for (int r = 0; r < 16; ++r) { tmax = fmaxf(tmax, p[0][r]); tmax = fmaxf(tmax, p[1][r]); }
        tmax = fmaxf(tmax, __shfl_xor(tmax, 32));
        const float mnew = fmaxf(mrun, tmax * sc);
        const float alpha = fast_exp2(mrun - mnew);
        mrun = mnew;
        float ps = 0.f;
#pragma unroll
        for (int blk = 0; blk < 2; ++blk)
#pragma unroll
            for (int r = 0; r < 16; ++r) { const float e = fast_exp2(p[blk][r] * sc - mnew); p[blk][r] = e; ps += e; }
        lsum = lsum * alpha + ps;
#pragma unroll
        for (int d = 0; d < 4; ++d)
#pragma unroll
            for (int r = 0; r < 16; ++r) o[d][r] *= alpha;
#pragma unroll
        for (int blk = 0; blk < 2; ++blk)
#pragma unroll
            for (int st = 0; st < 2; ++st) {
                union { bf16x8 v; unsigned u[4]; } pb;
#pragma unroll
                for (int q = 0; q < 4; ++q) pb.u[q] = cvt_pk_bf16(p[blk][8 * st + 2 * q], p[blk][8 * st + 2 * q + 1]);
                const int kbase = 64 * kt + 32 * blk + 16 * st;
#pragma unroll
                for (int d = 0; d < 4; ++d) {
                    const LAS unsigned char* vp = lds + XA_VT_OFF + (32 * d + r32) * XA_VT_PITCH + (kbase + 4 * hi) * 2;
                    union { bf16x8 v; s16x4 h[2]; } va; va.h[0] = *(const LAS s16x4*)vp; va.h[1] = *(const LAS s16x4*)(vp + 16);
                    o[d] = __builtin_amdgcn_mfma_f32_32x32x16_bf16(va.v, pb.v, o[d], 0, 0, 0);
                }
            }
    }
    lsum += __shfl_xor(lsum, 32);
    const float inv = 1.0f / lsum;
#ifdef XA_COPY
    {
#pragma unroll
    for (int d = 0; d < 4; ++d)
#pragma unroll
        for (int g = 0; g < 4; ++g) { u32x2 w;
            if (XA_COPY == 1) { union { bf16x8 v; unsigned u[4]; } t; t.v = qf[(d * 4 + g) >> 1]; w.x = t.u[((d * 4 + g) & 1) * 2]; w.y = t.u[((d * 4 + g) & 1) * 2 + 1]; }
            else if (XA_COPY == 2) { w = *(const LAS u32x2*)(lds + (wid * 32 + r32) * XA_K_PITCH + hi * 128 + (d * 4 + g) * 8); }
            else { const int L = wid * 64 + lane; w = *(const LAS u32x2*)(lds + XA_VT_OFF + (L >> 2) * XA_VT_PITCH + (L & 3) * 128 + (d * 4 + g) * 8); }
            *(u32x2*)(XA_OUT + qrow * 512 + h * 128 + 32 * d + 8 * g + 4 * hi) = w; }
    __syncthreads(); return;
    }
#endif
#pragma unroll
    for (int d = 0; d < 4; ++d)
#pragma unroll
        for (int g = 0; g < 4; ++g) { u32x2 w; w.x = cvt_pk_bf16(o[d][4 * g] * inv, o[d][4 * g + 1] * inv); w.y = cvt_pk_bf16(o[d][4 * g + 2] * inv, o[d][4 * g + 3] * inv);
            *(u32x2*)(XA_OUT + qrow * 512 + h * 128 + 32 * d + 8 * g + 4 * hi) = w; }
    __syncthreads();
}

__device__ __forceinline__ void na_unit(LAS unsigned char* lds, unsigned char* ws, int unit) {
    const int b = unit >> 5, r = unit & 31;
    int tid_ = threadIdx.x; asm volatile("" : "+v"(tid_)); const int tid = tid_, lane = tid & 63, h = tid >> 6, l15 = lane & 15, quad = lane >> 4;
    bf16_t* Q = (bf16_t*)(ws + WS_NAQ); const bf16_t* K = (const bf16_t*)(ws + WS_NAK); const bf16_t* VT = (const bf16_t*)(ws + WS_NAVT);
    const LAS float* rpb = (const LAS float*)(lds + NA_RPB_OFF) + h * 465;
    const int rs = min(max(r - 4, 0), 24);
    for (int j = 0; j < 4; ++j) {
        const int c = 16 * j + l15, kc0 = min(max(16 * j - 8, 0), 32), cs = min(max(c - 8, 0), 48);
        const size_t qrow = (size_t)b * 2048 + r * 64 + c;
        bf16x8 qf[2];
        qf[0] = *(const bf16x8*)(Q + qrow * 512 + h * 64 + 8 * quad); qf[1] = *(const bf16x8*)(Q + qrow * 512 + h * 64 + 32 + 8 * quad);
        f32x4 s[8][2];
#pragma unroll
        for (int kr = 0; kr < 8; ++kr)
#pragma unroll
            for (int hf = 0; hf < 2; ++hf) {
                const size_t ktok = (size_t)b * 2048 + (rs + kr) * 64 + kc0 + 16 * hf + l15;
                const bf16x8 k0 = *(const bf16x8*)(K + ktok * 512 + h * 64 + 8 * quad), k1 = *(const bf16x8*)(K + ktok * 512 + h * 64 + 32 + 8 * quad);
                f32x4 a = {0.f, 0.f, 0.f, 0.f};
                a = __builtin_amdgcn_mfma_f32_16x16x32_bf16(k0, qf[0], a, 0, 0, 0);
                a = __builtin_amdgcn_mfma_f32_16x16x32_bf16(k1, qf[1], a, 0, 0, 0);
                s[kr][hf] = a;
            }
        float mx = -INFINITY;
#pragma unroll
        for (int kr = 0; kr < 8; ++kr)
#pragma unroll
            for (int hf = 0; hf < 2; ++hf)
#pragma unroll
                for (int i = 0; i < 4; ++i) { const int kc = kc0 + 16 * hf + 4 * quad + i; const bool valid = (kc >= cs) && (kc < cs + 16);
                    const int bidx = valid ? ((rs + kr - r + 7) * 31 + (kc - c + 15)) : 0;
                    const float t = valid ? (s[kr][hf][i] * 0.125f + rpb[bidx]) * LOG2E : -INFINITY;
                    s[kr][hf][i] = t; mx = fmaxf(mx, t); }
        mx = fmaxf(mx, __shfl_xor(mx, 16)); mx = fmaxf(mx, __shfl_xor(mx, 32));
        float sum = 0.f;
#pragma unroll
        for (int kr = 0; kr < 8; ++kr)
#pragma unroll
            for (int hf = 0; hf < 2; ++hf)
#pragma unroll
                for (int i = 0; i < 4; ++i) { const float e = fast_exp2(s[kr][hf][i] - mx); s[kr][hf][i] = e; sum += e; }
        sum += __shfl_xor(sum, 16); sum += __shfl_xor(sum, 32);
        const float inv = 1.0f / sum;
        f32x4 o[4];
#pragma unroll
        for (int db = 0; db < 4; ++db) o[db] = (f32x4){0.f, 0.f, 0.f, 0.f};
#pragma unroll
        for (int kr = 0; kr < 8; ++kr) {
            union { bf16x8 v; unsigned u[4]; } pb;
            pb.u[0] = cvt_pk_bf16(s[kr][0][0], s[kr][0][1]); pb.u[1] = cvt_pk_bf16(s[kr][0][2], s[kr][0][3]);
            pb.u[2] = cvt_pk_bf16(s[kr][1][0], s[kr][1][1]); pb.u[3] = cvt_pk_bf16(s[kr][1][2], s[kr][1][3]);
#pragma unroll
            for (int db = 0; db < 4; ++db) {
                const bf16_t* vp = VT + ((size_t)(b * 512 + h * 64 + 16 * db + l15)) * 2048 + (rs + kr) * 64 + kc0 + 4 * quad;
                union { bf16x8 v; s16x4 hh[2]; } va; va.hh[0] = *(const s16x4*)vp; va.hh[1] = *(const s16x4*)(vp + 16);
                o[db] = __builtin_amdgcn_mfma_f32_16x16x32_bf16(va.v, pb.v, o[db], 0, 0, 0);
            }
        }
#pragma unroll
        for (int db = 0; db < 4; ++db) { u32x2 w; w.x = cvt_pk_bf16(o[db][0] * inv, o[db][1] * inv); w.y = cvt_pk_bf16(o[db][2] * inv, o[db][3] * inv);
            *(u32x2*)(Q + qrow * 512 + h * 64 + 16 * db + 4 * quad) = w; }
    }
}

__device__ __forceinline__ unsigned pack2(float a, float b) { return cvt_pk_bf16(a, b); }
__device__ __forceinline__ void ml_chain(LAS unsigned char* lds, const Params& P, int chain) {
    const int b = chain >> 3, h = (chain >> 1) & 3, dir = chain & 1;
    int tid_ = threadIdx.x; asm volatile("" : "+v"(tid_)); const int tid = tid_, lane = tid & 63, w = __builtin_amdgcn_readfirstlane(tid >> 6), l15 = lane & 15, quad = lane >> 4;
    unsigned char* ws = P.ws;
    const bf16_t* MLQ = (const bf16_t*)(ws + WS_MLQ); const bf16_t* MLK = (const bf16_t*)(ws + WS_MLK); const bf16_t* MLV = (const bf16_t*)(ws + WS_MLV);
    const float* GATES = (const float*)(ws + WS_GATES);
    float* HDIR = (float*)((unsigned char*)P.out + (dir ? DO_HBW : DO_HFW));
    LAS float* CW = (LAS float*)(lds + ML_CW); LAS float* NV = (LAS float*)(lds + ML_NV); LAS float* ROWSUM = (LAS float*)(lds + ML_ROWSUM);
    LAS float* DENI = (LAS float*)(lds + ML_DENI); LAS float* WTS = (LAS float*)(lds + ML_WTS);
    if (tid < 256) { const int ch = tid; const int gch = ch < 128 ? h * 128 + ch : 512 + h * 128 + (ch - 128);
        CW[ch] = P.in[6][gch]; CW[256 + ch] = P.in[6][1024 + gch]; CW[512 + ch] = P.in[6][2048 + gch]; CW[768 + ch] = P.in[7][gch]; NV[tid] = 0.f; }
    f32x4 C[8];
#pragma unroll
    for (int e = 0; e < 8; ++e) C[e] = (f32x4){0.f, 0.f, 0.f, 0.f};
    float m_run = -1e30f;
    const float big = P.in[4][dir * 4 + h], bfg = P.in[5][dir * 4 + h];
    const int cgp = tid & 31, rg = tid >> 5; const bool isk = cgp >= 16; const int c8 = (cgp & 15) * 8;
    const bf16_t* qksrc = (isk ? MLK : MLQ) + h * 128 + c8;
    const int vcg = tid & 15, vrg = tid >> 4;
    const size_t brow = (size_t)b * 2048;
    u32x4 raw[6], vraw[2]; float gi_raw, gf_raw;
#define ML_ISSUE(cc) do { const int tb_ = dir ? 2048 - 64 * ((cc) + 1) : 64 * (cc); \
        _Pragma("unroll") for (int i_ = 0; i_ < 6; ++i_) { const int t_ = tb_ + 4 * rg - 1 + i_; raw[i_] = (t_ >= 0 && t_ < 2048) ? *(const u32x4*)(qksrc + (brow + t_) * 512) : (u32x4){0u, 0u, 0u, 0u}; } \
        _Pragma("unroll") for (int i_ = 0; i_ < 2; ++i_) { const int t_ = tb_ + 2 * vrg + i_; vraw[i_] = *(const u32x4*)(MLV + (brow + t_) * 512 + h * 128 + vcg * 8); } \
        { const int t_ = dir ? tb_ + 63 - lane : tb_ + lane; gi_raw = GATES[(brow + t_) * 16 + (dir * 2) * 4 + h]; gf_raw = GATES[(brow + t_) * 16 + (dir * 2 + 1) * 4 + h]; } } while (0)
    ML_ISSUE(0);
    __syncthreads();
    for (int c = 0; c < 32; ++c) {
        const int tb = dir ? 2048 - 64 * (c + 1) : 64 * c; const int par = c & 1;
        const float gi = gi_raw + big, gf = gf_raw + bfg;
        const float lf = fminf(gf, 0.f) - __logf(1.0f + fast_exp(-fabsf(gf)));
        float a = lf;
#pragma unroll
        for (int o = 1; o < 64; o <<= 1) { const float t = __shfl_up(a, o); if (lane >= o) a += t; }
        const float g = __shfl(a, 63);
        const float u = gi - a; float pm = u;
#pragma unroll
        for (int o = 1; o < 64; o <<= 1) { const float t = __shfl_up(pm, o); if (lane >= o) pm = fmaxf(pm, t); }
        const float mj = a + fmaxf(m_run, pm);
        const float inter_w = fast_exp(a + m_run - mj);
        const float pm63 = __shfl(pm, 63); const float m_new = fmaxf(g + m_run, g + pm63);
        const float decay = fast_exp(g + m_run - m_new);
        const float wt = fast_exp(g + u - m_new);
        const float emj = fast_exp(-mj);
        if (w == 0) { WTS[lane] = wt; }
        {
            const int cb = (isk ? 128 : 0) + c8;
            const float qs = isk ? 1.0f : 0.08838834764831845f;
            unsigned yp[4][4];
#pragma unroll
            for (int cp = 0; cp < 4; ++cp) {
                const float w0a = CW[cb + 2 * cp], w0b = CW[cb + 2 * cp + 1], w1a = CW[256 + cb + 2 * cp], w1b = CW[256 + cb + 2 * cp + 1];
                const float w2a = CW[512 + cb + 2 * cp], w2b = CW[512 + cb + 2 * cp + 1], ba = CW[768 + cb + 2 * cp], bbv = CW[768 + cb + 2 * cp + 1];
                float xa[6], xb[6];
#pragma unroll
                for (int i = 0; i < 6; ++i) { const unsigned wv = cp == 0 ? raw[i].x : cp == 1 ? raw[i].y : cp == 2 ? raw[i].z : raw[i].w; xa[i] = bf_lo(wv); xb[i] = bf_hi(wv); }
#pragma unroll
                for (int i = 0; i < 4; ++i) { const float va = w0a * xa[i] + w1a * xa[i + 1] + w2a * xa[i + 2] + ba, vb = w0b * xb[i] + w1b * xb[i + 1] + w2b * xb[i + 2] + bbv;
                    yp[i][cp] = pack2(va * sigmoidf_(va) * qs, vb * sigmoidf_(vb) * qs); }
            }
            LAS unsigned char* rm = lds + (isk ? ML_KS : ML_QS);
#pragma unroll
            for (int i = 0; i < 4; ++i) { const int p = dir ? 63 - (4 * rg + i) : 4 * rg + i;
                u32x4 wv; wv.x = yp[i][0]; wv.y = yp[i][1]; wv.z = yp[i][2]; wv.w = yp[i][3];
                *(LAS u32x4*)(rm + p * ML_QP + c8 * 2) = wv; }
            if (isk) {
#pragma unroll
                for (int cp = 0; cp < 4; ++cp) {
                    const unsigned t0 = yp[0][cp], t1 = yp[1][cp], t2 = yp[2][cp], t3 = yp[3][cp];
                    u32x2 lo, hi;
                    if (dir) { lo.x = (t3 & 0xffffu) | (t2 << 16); lo.y = (t1 & 0xffffu) | (t0 << 16); hi.x = (t3 >> 16) | (t2 & 0xffff0000u); hi.y = (t1 >> 16) | (t0 & 0xffff0000u); }
                    else { lo.x = (t0 & 0xffffu) | (t1 << 16); lo.y = (t2 & 0xffffu) | (t3 << 16); hi.x = (t0 >> 16) | (t1 & 0xffff0000u); hi.y = (t2 >> 16) | (t3 & 0xffff0000u); }
                    const int pofs = (dir ? 60 - 4 * rg : 4 * rg) * 2;
                    *(LAS u32x2*)(lds + ML_KT + (c8 + 2 * cp) * ML_TP + pofs) = lo; *(LAS u32x2*)(lds + ML_KT + (c8 + 2 * cp + 1) * ML_TP + pofs) = hi; }
            }
        }
        {
            const int p0 = dir ? 63 - 2 * vrg : 2 * vrg, p1 = dir ? 62 - 2 * vrg : 2 * vrg + 1;
            const float wt0 = __shfl(wt, p0), wt1 = __shfl(wt, p1);
            float v0[8], v1[8];
            v0[0] = bf_lo(vraw[0].x); v0[1] = bf_hi(vraw[0].x); v0[2] = bf_lo(vraw[0].y); v0[3] = bf_hi(vraw[0].y); v0[4] = bf_lo(vraw[0].z); v0[5] = bf_hi(vraw[0].z); v0[6] = bf_lo(vraw[0].w); v0[7] = bf_hi(vraw[0].w);
            v1[0] = bf_lo(vraw[1].x); v1[1] = bf_hi(vraw[1].x); v1[2] = bf_lo(vraw[1].y); v1[3] = bf_hi(vraw[1].y); v1[4] = bf_lo(vraw[1].z); v1[5] = bf_hi(vraw[1].z); v1[6] = bf_lo(vraw[1].w); v1[7] = bf_hi(vraw[1].w);
            const int pw = dir ? p1 : p0;
#pragma unroll
            for (int ch = 0; ch < 8; ++ch) { const int d = vcg * 8 + ch;
                const unsigned a_ = dir ? pack2(v1[ch], v0[ch]) : pack2(v0[ch], v1[ch]);
                const unsigned b_ = dir ? pack2(v1[ch] * wt1, v0[ch] * wt0) : pack2(v0[ch] * wt0, v1[ch] * wt1);
                *(LAS unsigned*)(lds + ML_VT + d * ML_TP + pw * 2) = a_; *(LAS unsigned*)(lds + ML_WVT + d * ML_TP + pw * 2) = b_; }
        }
        if (c + 1 < 32) ML_ISSUE(c + 1);
        __syncthreads();
#pragma unroll
        for (int bb2 = 0; bb2 < 2; ++bb2) {
            const int id = 2 * w + bb2, jb = id >> 2, sb = id & 3; const int j = 16 * jb + l15;
            if (sb <= jb) {
                f32x4 sacc = {0.f, 0.f, 0.f, 0.f};
#pragma unroll
                for (int st = 0; st < 4; ++st) { const bf16x8 kf = *(const LAS bf16x8*)(lds + ML_KS + (16 * sb + l15) * ML_QP + (32 * st + 8 * quad) * 2);
                    const bf16x8 qf = *(const LAS bf16x8*)(lds + ML_QS + j * ML_QP + (32 * st + 8 * quad) * 2);
                    sacc = __builtin_amdgcn_mfma_f32_16x16x32_bf16(kf, qf, sacc, 0, 0, 0); }
                const float aj = __shfl(a, j), mjj = __shfl(mj, j);
                float pv[4]; float rsum = 0.f;
#pragma unroll
                for (int i = 0; i < 4; ++i) { const int sidx = 16 * sb + 4 * quad + i; const float us = __shfl(u, sidx);
                    const float e = fast_exp(fminf(aj + us - mjj, 0.f)) * sacc[i]; pv[i] = (sidx <= j) ? e : 0.f; rsum += pv[i]; }
                rsum += __shfl_xor(rsum, 16); rsum += __shfl_xor(rsum, 32);
                if (quad == 0) ROWSUM[sb * 64 + j] = rsum;
                u32x2 wv; wv.x = pack2(pv[0], pv[1]); wv.y = pack2(pv[2], pv[3]);
                *(LAS u32x2*)(lds + ML_PS + j * ML_TP + (16 * sb + 4 * quad) * 2) = wv;
            } else {
                *(LAS u32x2*)(lds + ML_PS + j * ML_TP + (16 * sb + 4 * quad) * 2) = (u32x2){0u, 0u}; if (quad == 0) ROWSUM[sb * 64 + j] = 0.f;
            }
        }
        {
            const int j = tid >> 3, eo = (tid & 7) * 16;
            const u32x4 q0 = *(const LAS u32x4*)(lds + ML_QS + j * ML_QP + eo * 2), q1 = *(const LAS u32x4*)(lds + ML_QS + j * ML_QP + eo * 2 + 16);
            const LAS float* nv = NV + par * 128 + eo;
            const f32x4 n0 = *(const LAS f32x4*)(nv), n1 = *(const LAS f32x4*)(nv + 4), n2 = *(const LAS f32x4*)(nv + 8), n3 = *(const LAS f32x4*)(nv + 12);
            float s = bf_lo(q0.x) * n0[0] + bf_hi(q0.x) * n0[1] + bf_lo(q0.y) * n0[2] + bf_hi(q0.y) * n0[3] + bf_lo(q0.z) * n1[0] + bf_hi(q0.z) * n1[1] + bf_lo(q0.w) * n1[2] + bf_hi(q0.w) * n1[3]
                    + bf_lo(q1.x) * n2[0] + bf_hi(q1.x) * n2[1] + bf_lo(q1.y) * n2[2] + bf_hi(q1.y) * n2[3] + bf_lo(q1.z) * n3[0] + bf_hi(q1.z) * n3[1] + bf_lo(q1.w) * n3[2] + bf_hi(q1.w) * n3[3];
            s += __shfl_xor(s, 1); s += __shfl_xor(s, 2); s += __shfl_xor(s, 4);
            if ((tid & 7) == 0) DENI[j] = s;
        }
        f32x4 acc[4];
#pragma unroll
        for (int t4 = 0; t4 < 4; ++t4) acc[t4] = (f32x4){0.f, 0.f, 0.f, 0.f};
#pragma unroll
        for (int st = 0; st < 4; ++st) {
            union { bf16x8 v; unsigned uu[4]; } ca;
            ca.uu[0] = pack2(C[2 * st][0], C[2 * st][1]); ca.uu[1] = pack2(C[2 * st][2], C[2 * st][3]); ca.uu[2] = pack2(C[2 * st + 1][0], C[2 * st + 1][1]); ca.uu[3] = pack2(C[2 * st + 1][2], C[2 * st + 1][3]);
#pragma unroll
            for (int t4 = 0; t4 < 4; ++t4) { const LAS unsigned char* qp = lds + ML_QS + (16 * t4 + l15) * ML_QP + (32 * st + 4 * quad) * 2;
                union { bf16x8 v; s16x4 hh[2]; } qb; qb.hh[0] = *(const LAS s16x4*)qp; qb.hh[1] = *(const LAS s16x4*)(qp + 32);
                acc[t4] = __builtin_amdgcn_mfma_f32_16x16x32_bf16(ca.v, qb.v, acc[t4], 0, 0, 0); }
        }
        if (tid < 128) { const int e = tid; float s = 0.f;
#pragma unroll
            for (int q = 0; q < 8; ++q) { const u32x4 kv = *(const LAS u32x4*)(lds + ML_KT + e * ML_TP + q * 16); const f32x4 wa = *(const LAS f32x4*)(WTS + 8 * q), wb = *(const LAS f32x4*)(WTS + 8 * q + 4);
                s += bf_lo(kv.x) * wa[0] + bf_hi(kv.x) * wa[1] + bf_lo(kv.y) * wa[2] + bf_hi(kv.y) * wa[3] + bf_lo(kv.z) * wb[0] + bf_hi(kv.z) * wb[1] + bf_lo(kv.w) * wb[2] + bf_hi(kv.w) * wb[3]; }
            NV[(par ^ 1) * 128 + e] = decay * NV[par * 128 + e] + s; }
#pragma unroll
        for (int eb = 0; eb < 8; ++eb) { C[eb] = C[eb] * decay;
#pragma unroll
            for (int ks = 0; ks < 2; ++ks) { const bf16x8 ka = *(const LAS bf16x8*)(lds + ML_KT + (16 * eb + l15) * ML_TP + (32 * ks + 8 * quad) * 2);
                const bf16x8 vb = *(const LAS bf16x8*)(lds + ML_WVT + (16 * w + l15) * ML_TP + (32 * ks + 8 * quad) * 2);
                C[eb] = __builtin_amdgcn_mfma_f32_16x16x32_bf16(ka, vb, C[eb], 0, 0, 0); } }
        __syncthreads();
#pragma unroll
        for (int t4 = 0; t4 < 4; ++t4) { const int tp = 16 * t4 + l15; const float iw = __shfl(inter_w, tp); const float em = __shfl(emj, tp);
            f32x4 r = acc[t4] * iw;
#pragma unroll
            for (int ks = 0; ks < 2; ++ks) { const bf16x8 va = *(const LAS bf16x8*)(lds + ML_VT + (16 * w + l15) * ML_TP + (32 * ks + 8 * quad) * 2);
                const bf16x8 pb = *(const LAS bf16x8*)(lds + ML_PS + tp * ML_TP + (32 * ks + 8 * quad) * 2);
                r = __builtin_amdgcn_mfma_f32_16x16x32_bf16(va, pb, r, 0, 0, 0); }
            const float den = ((ROWSUM[tp] + ROWSUM[64 + tp]) + (ROWSUM[128 + tp] + ROWSUM[192 + tp])) + iw * DENI[tp]; const float inv = 1.0f / fmaxf(fabsf(den), em);
            const int t = dir ? tb + 63 - tp : tb + tp;
            *(f32x4*)(HDIR + (brow + t) * 512 + h * 128 + 16 * w + 4 * quad) = r * inv; }
        m_run = m_new;
        __syncthreads();
    }
#undef ML_ISSUE
}

__device__ __forceinline__ void p2b_combine(const Params& P, int G) {
    int tid_ = threadIdx.x; asm volatile("" : "+v"(tid_)); const int tid = tid_, lane = tid & 63, wave = tid >> 6; const int gw = blockIdx.x * 8 + wave, NGW = G * 8;
    const float* HF = (const float*)((unsigned char*)P.out + DO_HFW); const float* HB = (const float*)((unsigned char*)P.out + DO_HBW);
    bf16_t* O = (bf16_t*)(P.ws + WS_MLO); const float* ng = P.in[8];
    const f32x4 g0 = *(const f32x4*)(ng + 8 * lane), g1 = *(const f32x4*)(ng + 8 * lane + 4);
    for (int row = gw; row < NTOK; row += NGW) {
        const size_t off = (size_t)row * 512 + 8 * lane;
        f32x4 a0 = *(const f32x4*)(HF + off) + *(const f32x4*)(HB + off), a1 = *(const f32x4*)(HF + off + 4) + *(const f32x4*)(HB + off + 4);
        float ss = (a0[0] * a0[0] + a0[1] * a0[1]) + (a0[2] * a0[2] + a0[3] * a0[3]) + (a1[0] * a1[0] + a1[1] * a1[1]) + (a1[2] * a1[2] + a1[3] * a1[3]);
        ss += __shfl_xor(ss, 1); ss += __shfl_xor(ss, 2); ss += __shfl_xor(ss, 4); ss += __shfl_xor(ss, 8);
        const float rstd = rsqrtf(ss * (1.0f / 128.0f) + EPS);
        const u32x4 ow = *(const u32x4*)(O + off);
        a0 = a0 * rstd * g0; a1 = a1 * rstd * g1;
        u32x4 wv; wv.x = pack2(a0[0] * sigmoidf_(bf_lo(ow.x)), a0[1] * sigmoidf_(bf_hi(ow.x))); wv.y = pack2(a0[2] * sigmoidf_(bf_lo(ow.y)), a0[3] * sigmoidf_(bf_hi(ow.y)));
        wv.z = pack2(a1[0] * sigmoidf_(bf_lo(ow.z)), a1[1] * sigmoidf_(bf_hi(ow.z))); wv.w = pack2(a1[2] * sigmoidf_(bf_lo(ow.w)), a1[3] * sigmoidf_(bf_hi(ow.w)));
        *(u32x4*)(O + off) = wv;
    }
}
__device__ __forceinline__ void unpack8(const u32x4 v, float* f) { f[0] = bf_lo(v.x); f[1] = bf_hi(v.x); f[2] = bf_lo(v.y); f[3] = bf_hi(v.y); f[4] = bf_lo(v.z); f[5] = bf_hi(v.z); f[6] = bf_lo(v.w); f[7] = bf_hi(v.w); }
__device__ __forceinline__ void p5b_glu(const Params& P, int G) {
    const bf16_t* A = (const bf16_t*)(P.ws + WS_ABUF); bf16_t* U = (bf16_t*)(P.ws + WS_UBUF);
    const float* cw = P.in[19]; const float* cb = P.in[20];
    const int nth = G * 512;
    for (int task = blockIdx.x * 512 + threadIdx.x; task < 2048 * 352; task += nth) {
        const int rgid = task / 352, cgid = task - rgid * 352; const int row0 = 8 * rgid, ch0 = 8 * cgid; const int sp0 = row0 & 2047;
        float w0[8], w1[8], w2[8], bb[8];
#pragma unroll
        for (int q = 0; q < 2; ++q) { const f32x4 t0 = *(const f32x4*)(cw + ch0 + 4 * q), t1 = *(const f32x4*)(cw + 2816 + ch0 + 4 * q), t2 = *(const f32x4*)(cw + 5632 + ch0 + 4 * q), t3 = *(const f32x4*)(cb + ch0 + 4 * q);
#pragma unroll
            for (int i = 0; i < 4; ++i) { w0[4 * q + i] = t0[i]; w1[4 * q + i] = t1[i]; w2[4 * q + i] = t2[i]; bb[4 * q + i] = t3[i]; } }
        const bf16_t* ap = A + (size_t)row0 * 2816 + ch0; bf16_t* up = U + (size_t)row0 * 2816 + ch0;
        float prev[8], cur[8], nxt[8];
        if (sp0 > 0) unpack8(*(const u32x4*)(ap - 2816), prev); else {
#pragma unroll
            for (int i = 0; i < 8; ++i) prev[i] = 0.f; }
        unpack8(*(const u32x4*)ap, cur);
#pragma unroll
        for (int i = 0; i < 8; ++i) {
            if (sp0 + i + 1 < 2048) unpack8(*(const u32x4*)(ap + (size_t)(i + 1) * 2816), nxt); else {
#pragma unroll
                for (int q = 0; q < 8; ++q) nxt[q] = 0.f; }
            float uu[8]; unpack8(*(const u32x4*)(up + (size_t)i * 2816), uu);
            float o[8];
#pragma unroll
            for (int q = 0; q < 8; ++q) { const float y = w0[q] * prev[q] + w1[q] * cur[q] + w2[q] * nxt[q] + bb[q];
                const float z = 1.5957691216057308f * (y + 0.044715f * y * y * y);
                o[q] = y * sigmoidf_(z) * uu[q]; prev[q] = cur[q]; cur[q] = nxt[q]; }
            u32x4 wv; wv.x = pack2(o[0], o[1]); wv.y = pack2(o[2], o[3]); wv.z = pack2(o[4], o[5]); wv.w = pack2(o[6], o[7]);
            *(u32x4*)(up + (size_t)i * 2816) = wv;
        }
    }
}
__device__ __forceinline__ void p7_final(const Params& P, int G) {
    int tid_ = threadIdx.x; asm volatile("" : "+v"(tid_)); const int tid = tid_, lane = tid & 63, wave = tid >> 6; const int gw = blockIdx.x * 8 + wave, NGW = G * 8;
    const float* gv = P.in[22];
    for (int m = gw; m < NTOK; m += NGW) {
        f32x4* row = (f32x4*)(P.out + (size_t)m * 1024);
        f32x4 v[4]; float s = 0.f;
#pragma unroll
        for (int j = 0; j < 4; ++j) { v[j] = row[64 * j + lane]; s += (v[j][0] * v[j][0] + v[j][1] * v[j][1]) + (v[j][2] * v[j][2] + v[j][3] * v[j][3]); }
        const float rstd = rsqrtf(wave_sum(s) * (1.0f / 1024.0f) + EPS);
#pragma unroll
        for (int j = 0; j < 4; ++j) { const f32x4 g4 = ((const f32x4*)gv)[64 * j + lane]; row[64 * j + lane] = v[j] * rstd * g4; }
    }
}


#ifndef DBG_CUT
#define DBG_CUT 0
#endif
#ifndef DBG_NOOUT
#define DBG_NOOUT 0
#endif
__device__ __forceinline__ void dbg_dump(const Params& P, int G) {
    const unsigned short* w16 = (const unsigned short*)P.ws; unsigned* o = (unsigned*)P.out;
    for (size_t i = (size_t)blockIdx.x * 512 + threadIdx.x; i < (size_t)NTOK * 1024; i += (size_t)G * 512) {
        const unsigned ob = (DBG_CUT >= 2 && !DBG_NOOUT) ? o[i] : 0u; float s = (float)(ob & 0xffffu) + (float)(ob >> 16);
        for (int k = 0; k < 8; ++k) s += (float)w16[i + (size_t)k * NTOK * 1024];
        P.out[i] = s; }
}
#define GRID_SYNC() do { asm volatile("s_waitcnt vmcnt(0)" ::: "memory"); __syncthreads(); \
    if (threadIdx.x == 0) { asm volatile("buffer_wbl2 sc1\n\ts_waitcnt vmcnt(0)" ::: "memory"); } \
    grid.sync(); __builtin_amdgcn_fence(__ATOMIC_ACQUIRE, "agent"); asm volatile("s_waitcnt vmcnt(0)" ::: "memory"); } while (0)
#define CUT(n) if (DBG_CUT == (n)) { GRID_SYNC(); dbg_dump(P, G); return; }
#ifndef PH_LAST
#define PH_LAST 99
#endif
__global__ void __launch_bounds__(512, 2) mega(Params P) {
    extern __shared__ __attribute__((aligned(16))) unsigned char smem[];
    LAS unsigned char* lds = (LAS unsigned char*)smem;
    cg::grid_group grid = cg::this_grid();
    const int G = gridDim.x, bid = blockIdx.x;
    unsigned char* ws = P.ws; unsigned char* dob = (unsigned char*)P.out;
#ifndef PHMASK
#define PHMASK 0xFFFF
#endif
#define PH(n) if ((PHMASK >> (n)) & 1)
    PH(0) p0_prologue(lds, P, G);
    GRID_SYNC();
    PH(1) { pg8::Gemm g{(const bf16_t*)(dob + DO_H), (const bf16_t*)(dob + DO_WINT), NTOK, INW_P, 1024}; pg8::StaticOrder S; S.init(NTOK, INW_P, G, bid);
      EpiProj E{ws, P.in[12]}; pg8::gemm_phase<EpiProj, pg8::StaticOrder, true, true>(lds, g, S, E); }
    PH(2) { pg8::Gemm g{(const bf16_t*)(dob + DO_MEMN), (const bf16_t*)(dob + DO_WMEMKVT), NMEM, 1024, 1024}; pg8::StaticOrder S; S.init(NMEM, 1024, G, bid);
      EpiMemKV E{ws}; pg8::gemm_phase<EpiMemKV, pg8::StaticOrder, true, true>(lds, g, S, E); }
    GRID_SYNC();
    CUT(1)
    { for (int i = threadIdx.x; i < 3720; i += 512) ((LAS float*)(lds + NA_RPB_OFF))[i] = P.in[9][i];
      __syncthreads();
      if (G >= 128) {
          if (bid < 64) { PH(3) ml_chain(lds, P, bid); }
          else for (int u = bid - 64; u < 512; u += G - 64) { if (u < 256) { PH(4) na_unit(lds, ws, u); } else { PH(5) xa_unit(lds, ws, u - 256); } }
      } else {
          for (int u = bid; u < 576; u += G) { if (u < 64) { PH(3) ml_chain(lds, P, u); } else if (u < 320) { PH(4) na_unit(lds, ws, u - 64); } else { PH(5) xa_unit(lds, ws, u - 320); } }
      } }
    GRID_SYNC();
    PH(6) p2b_combine(P, G);
    GRID_SYNC();
    CUT(2)
    PH(7) { const bf16_t* Gt = (const bf16_t*)(ws + WS_G); float* tmp = P.out; bf16_t* merged = (bf16_t*)(ws + WS_MERGED);
      pg8::StaticOrder S; S.init(NTOK, 1024, G, bid);
      { pg8::Gemm g{(const bf16_t*)(ws + WS_MLO), (const bf16_t*)(ws + WS_WBR), NTOK, 1024, 512}; EpiBranch<0> E{Gt, tmp, merged, 0}; pg8::gemm_phase<EpiBranch<0>, pg8::StaticOrder, true, true>(lds, g, S, E); }
      { pg8::Gemm g{(const bf16_t*)(ws + WS_NAQ), (const bf16_t*)(ws + WS_WBR + MiB), NTOK, 1024, 512}; EpiBranch<1> E{Gt, tmp, merged, 1}; pg8::gemm_phase<EpiBranch<1>, pg8::StaticOrder, true, true>(lds, g, S, E); }
      { pg8::Gemm g{(const bf16_t*)(ws + WS_XAQ), (const bf16_t*)(ws + WS_WBR + 2 * MiB), NTOK, 1024, 512}; EpiBranch<2> E{Gt, tmp, merged, 2}; pg8::gemm_phase<EpiBranch<2>, pg8::StaticOrder, true, true>(lds, g, S, E); } }
    GRID_SYNC();
    CUT(3)
    PH(8) { pg8::Gemm g{(const bf16_t*)(ws + WS_MERGED), (const bf16_t*)(ws + WS_WOUT), NTOK, 1024, 1024}; pg8::StaticOrder S; S.init(NTOK, 1024, G, bid);
      EpiOut E{P.in[0], P.out, (bf16_t*)(ws + WS_X1B), (float*)(ws + WS_RSS1)}; pg8::gemm_phase<EpiOut, pg8::StaticOrder, true, true>(lds, g, S, E); }
    GRID_SYNC();
    CUT(4)
    PH(9) { pg8::Gemm g{(const bf16_t*)(ws + WS_X1B), (const bf16_t*)(ws + WS_WUP), NTOK, 2 * DFF, 1024}; pg8::StaticOrder S; S.init(NTOK, 2 * DFF, G, bid);
      EpiUp E{(const float*)(ws + WS_RSS1), (bf16_t*)(ws + WS_ABUF), (bf16_t*)(ws + WS_UBUF)}; pg8::gemm_phase<EpiUp, pg8::StaticOrder, true, true>(lds, g, S, E); }
    GRID_SYNC();
    CUT(5)
    PH(10) p5b_glu(P, G);
    GRID_SYNC();
    CUT(6)
    PH(11) { pg8::Gemm g{(const bf16_t*)(ws + WS_UBUF), (const bf16_t*)(ws + WS_WDOWN), NTOK, 1024, DFF}; pg8::StaticOrder S; S.init(NTOK, 1024, G, bid);
      EpiDown E{P.out}; pg8::gemm_phase<EpiDown, pg8::StaticOrder, true, true>(lds, g, S, E); }
    GRID_SYNC();
    PH(12) p7_final(P, G);
}

extern "C" void kernel_launch(void* const* d_in, const int* in_sizes, int n_in, void* d_out, int out_size, void* d_ws, size_t ws_size, hipStream_t stream) {
    static int grid = 0;
    if (grid == 0) {
        if (n_in != 23 || out_size != NTOK * DM || ws_size < WS_NEED) { fprintf(stderr, "kernel_launch: unexpected shapes (n_in %d out %d ws %zu)\n", n_in, out_size, ws_size); grid = -1; return; }
        int dev = 0, cus = 0, per_cu = 0;
        hipGetDevice(&dev); hipDeviceGetAttribute(&cus, hipDeviceAttributeMultiprocessorCount, dev);
        hipFuncSetAttribute((const void*)mega, hipFuncAttributeMaxDynamicSharedMemorySize, LDS_BYTES);
        hipOccupancyMaxActiveBlocksPerMultiprocessor(&per_cu, (const void*)mega, 512, LDS_BYTES);
        if (per_cu < 1) { fprintf(stderr, "kernel_launch: occupancy query says %d blocks per CU\n", per_cu); per_cu = 1; }
        grid = cus * 1;
        (void)hipGetLastError();
    }
    if (grid < 0) return;
    Params p{};
    for (int i = 0; i < 23; ++i) p.in[i] = (const float*)d_in[i];
    p.out = (float*)d_out; p.ws = (unsigned char*)d_ws;
    void* args[] = {&p};
    hipError_t e = hipLaunchCooperativeKernel((const void*)mega, dim3(grid), dim3(512), args, LDS_BYTES, stream);
    if (e != hipSuccess) fprintf(stderr, "cooperative launch failed: %s (grid %d)\n", hipGetErrorString(e), grid);
}
```

```cpp
#include <hip/hip_runtime.h>
#include <hip/hip_cooperative_groups.h>
#include <cstdio>
#include <cstdint>
namespace cg = cooperative_groups;

#define LAS __attribute__((address_space(3)))
typedef unsigned short bf16_t;
typedef short bf16x8 __attribute__((ext_vector_type(8)));
typedef short s16x4 __attribute__((ext_vector_type(4)));
typedef float f32x4 __attribute__((ext_vector_type(4)));
typedef float f32x16 __attribute__((ext_vector_type(16)));
typedef unsigned u32x4 __attribute__((ext_vector_type(4)));
typedef unsigned u32x2 __attribute__((ext_vector_type(2)));

typedef float f32x2_t __attribute__((ext_vector_type(2))); typedef __bf16 bf16x2_t __attribute__((ext_vector_type(2)));
__device__ __forceinline__ unsigned cvt_pk_bf16(float lo, float hi) { f32x2_t v = {lo, hi}; bf16x2_t b = __builtin_convertvector(v, bf16x2_t); return __builtin_bit_cast(unsigned, b); }
__device__ __forceinline__ float bf_lo(unsigned w) { return __uint_as_float(w << 16); }
__device__ __forceinline__ float bf_hi(unsigned w) { return __uint_as_float(w & 0xffff0000u); }
__device__ __forceinline__ float fast_exp2(float x) { return __builtin_amdgcn_exp2f(x); }
__device__ __forceinline__ float fast_exp(float x) { return __builtin_amdgcn_exp2f(x * 1.4426950408889634f); }
__device__ __forceinline__ float fast_rcp(float x) { return __builtin_amdgcn_rcpf(x); }
__device__ __forceinline__ float sigmoidf_(float x) { return fast_rcp(1.0f + fast_exp(-x)); }
#define LDS_WAIT() asm volatile("s_waitcnt lgkmcnt(0)" ::: "memory")

namespace pg8 {
#define PG8_LAS __attribute__((address_space(3)))
constexpr int BM = 256, BK = 64, HALF = 128, HTB = HALF * BK * 2, STAGE_BYTES = 8 * HTB, NXCD = 8, WGM = 8;
__host__ __device__ __forceinline__ int lds_byte(int r, int c) { const int st = (r >> 4) * 2 + (c >> 5), rr = r & 15, cc = c & 31, ob = rr * 64 + cc * 2; return st * 1024 + (ob ^ (((ob >> 9) & 1) << 5)); }
__host__ __device__ __forceinline__ void stage_rc(int b, int& R, int& C) { const int st = b / 1024, sb = b % 1024, swz = sb ^ (((sb >> 9) & 1) << 5); R = (st >> 1) * 16 + swz / 64; C = (st & 1) * 32 + (swz % 64) / 2; }
__host__ __device__ __forceinline__ int perm32(int rho) { const int n = rho >> 4, i = rho & 15; return 8 * (i >> 2) + 4 * n + (i & 3); }
struct Unit { int pm, pn; };
struct Gemm { const bf16_t* A; const bf16_t* Bt; int M, N, K; };
struct StaticOrder {
    int nM, nN, nwg, G, c;
    __host__ __device__ void init(int M, int N, int G_, int c_) { nM = M / BM; nN = N / BM; nwg = nM * nN; G = G_; c = c_; }
    __host__ __device__ bool next(int i, Unit& u) const {
        const long L = (long)i * G + c; if (L >= nwg) return false;
        int wgid = (int)L; { const int q = nwg / NXCD, r = nwg % NXCD, xcd = wgid % NXCD, off = wgid / NXCD; wgid = (xcd < r ? xcd * (q + 1) : r * (q + 1) + (xcd - r) * q) + off; }
        const int nig = WGM * nN, gid = wgid / nig, fm = gid * WGM, gsz = (nM - fm) < WGM ? (nM - fm) : WGM;
        u.pm = fm + ((wgid % nig) % gsz); u.pn = (wgid % nig) / gsz; return true;
    }
    __device__ __forceinline__ void a_ready(const Unit&) const {}
    __device__ __forceinline__ void done(const Unit&) const {}
};
template <class Epi, class Sched, bool ALIGN_EPI = false, bool SP2 = false>
__device__ __forceinline__ void gemm_phase(PG8_LAS unsigned char* lds, const Gemm g, const Sched& S, const Epi& E) {
    int tid_ = threadIdx.x; asm volatile("" : "+v"(tid_));
    const int tid = tid_, wid = __builtin_amdgcn_readfirstlane(tid >> 6), lane = tid & 63, wr = wid >> 2, wc = wid & 3, fr = lane & 15, fq = lane >> 4;
    const int K = g.K, nt = K / BK;
    unsigned voffA[2], voffB[2];
#pragma unroll
    for (int i = 0; i < 2; ++i) { int R, C; stage_rc(tid * 16 + i * 8192, R, C); const int Rb = Epi::PERM ? ((R & ~31) + perm32(R & 31)) : R;
        voffA[i] = (unsigned)(R * K + C) * 2u; voffB[i] = (unsigned)(Rb * K + C) * 2u; }
    const size_t kstep = (size_t)(BK * 2);
    const size_t hstep = (size_t)HALF * K * 2;
    const size_t tstep = 2 * hstep;
    const unsigned ldsw = (unsigned)wid * 1024u;
    const int aoff = lds_byte(wr * 64 + fr, fq * 8), boff = lds_byte(wc * 32 + fr, fq * 8);
#define PG8_SA(b, h) (((b) * 2 + (h)) * HTB)
#define PG8_SB(b, h) ((4 + (b) * 2 + (h)) * HTB)
#define PG8_STAGE(bufoff, gbase, voff) do { _Pragma("unroll") for (int _i = 0; _i < 2; ++_i) \
        __builtin_amdgcn_global_load_lds((const unsigned*)((const char*)(gbase) + (voff)[_i]), (PG8_LAS unsigned*)(lds + (bufoff) + ldsw + _i * 8192), 16, 0, 0); } while (0)
#define PG8_LDA(dst, b, h) do { _Pragma("unroll") for (int m = 0; m < 4; ++m) _Pragma("unroll") for (int k = 0; k < 2; ++k) dst[m][k] = *(const PG8_LAS bf16x8*)(lds + PG8_SA(b, h) + aoff + m * 2048 + k * 1024); } while (0)
#define PG8_LDB(dst, b, h) do { _Pragma("unroll") for (int n = 0; n < 2; ++n) _Pragma("unroll") for (int k = 0; k < 2; ++k) dst[n][k] = *(const PG8_LAS bf16x8*)(lds + PG8_SB(b, h) + boff + n * 2048 + k * 1024); } while (0)
#define PG8_MMA(ai, bj, At, Bt) do { __builtin_amdgcn_s_setprio(1); _Pragma("unroll") for (int m = 0; m < 4; ++m) _Pragma("unroll") for (int n = 0; n < 2; ++n) _Pragma("unroll") for (int k = 0; k < 2; ++k) \
        acc[ai][bj][m][n] = __builtin_amdgcn_mfma_f32_16x16x32_bf16(Bt[n][k], At[m][k], acc[ai][bj][m][n], 0, 0, 0); __builtin_amdgcn_s_setprio(0); } while (0)
#define PG8_WAIT_V(n) asm volatile("s_waitcnt vmcnt(" #n ")" ::: "memory")
#define PG8_WAIT_L(n) asm volatile("s_waitcnt lgkmcnt(" #n ")" ::: "memory")
#define PG8_BAR __builtin_amdgcn_s_barrier()
#define PG8_SCHED __builtin_amdgcn_sched_barrier(0)
    Unit cur, nxt; int ui = 0;
    if (!S.next(0, cur)) return;
    f32x4 acc[2][2][4][2];
#pragma unroll
    for (int a = 0; a < 2; ++a)
#pragma unroll
        for (int b = 0; b < 2; ++b)
#pragma unroll
            for (int m = 0; m < 4; ++m)
#pragma unroll
                for (int n = 0; n < 2; ++n) acc[a][b][m][n] = (f32x4){0.f, 0.f, 0.f, 0.f};
    bf16x8 At[4][2], B0[2][2], B1[2][2];
    const char* cA = (const char*)g.A + (size_t)cur.pm * tstep; const char* cB = (const char*)g.Bt + (size_t)cur.pn * tstep;
    S.a_ready(cur);
    if constexpr (SP2) {
        PG8_STAGE(PG8_SB(0, 0), cB, voffB); PG8_STAGE(PG8_SB(0, 1), cB + hstep, voffB); PG8_STAGE(PG8_SA(0, 0), cA, voffA); PG8_STAGE(PG8_SA(0, 1), cA + hstep, voffA);
        if (wr == 1) PG8_BAR;
        PG8_WAIT_V(2); PG8_BAR;
        PG8_STAGE(PG8_SB(1, 0), cB + kstep, voffB); PG8_STAGE(PG8_SA(1, 0), cA + kstep, voffA); PG8_STAGE(PG8_SB(1, 1), cB + hstep + kstep, voffB);
        PG8_WAIT_V(6); PG8_BAR;
    } else {
        PG8_STAGE(PG8_SB(0, 0), cB, voffB); PG8_STAGE(PG8_SA(0, 0), cA, voffA); PG8_STAGE(PG8_SB(0, 1), cB + hstep, voffB); PG8_STAGE(PG8_SA(0, 1), cA + hstep, voffA);
        if (wr == 1) PG8_BAR;
        PG8_WAIT_V(4); PG8_BAR;
        PG8_STAGE(PG8_SB(1, 0), cB + kstep, voffB); PG8_STAGE(PG8_SA(1, 0), cA + kstep, voffA); PG8_STAGE(PG8_SB(1, 1), cB + hstep + kstep, voffB);
        PG8_WAIT_V(6); PG8_BAR;
    }
    for (;;) {
        const bool has_next = S.next(ui + 1, nxt);
        const char* nA = has_next ? (const char*)g.A + (size_t)nxt.pm * tstep : cA; const char* nB = has_next ? (const char*)g.Bt + (size_t)nxt.pn * tstep : cB;
        for (int t = 0; t < nt; t += 2) {
            const bool last = (t == nt - 2);
            const char* a1 = cA + (size_t)(t + 1) * kstep;
            const char* a2 = last ? nA : cA + (size_t)(t + 2) * kstep; const char* b2 = last ? nB : cB + (size_t)(t + 2) * kstep;
            const char* a3 = a2 + kstep; const char* b3 = b2 + kstep;
            if (last && has_next) S.a_ready(nxt);
            if constexpr (SP2) {
            PG8_LDB(B0, 0, 0); PG8_LDB(B1, 0, 1); PG8_SCHED; PG8_LDA(At, 0, 0); PG8_STAGE(PG8_SA(1, 1), a1 + hstep, voffA);
            PG8_WAIT_V(8); PG8_WAIT_L(0); PG8_BAR; PG8_MMA(0, 0, At, B0); PG8_MMA(0, 1, At, B1); PG8_BAR; PG8_SCHED;
            PG8_LDA(At, 0, 1); PG8_STAGE(PG8_SB(0, 0), b2, voffB); PG8_STAGE(PG8_SB(0, 1), b2 + hstep, voffB); PG8_STAGE(PG8_SA(0, 0), a2, voffA);
            PG8_WAIT_V(8); PG8_WAIT_L(0); PG8_BAR; PG8_MMA(1, 0, At, B0); PG8_MMA(1, 1, At, B1); PG8_BAR; PG8_SCHED;
            PG8_LDB(B0, 1, 0); PG8_LDB(B1, 1, 1); PG8_SCHED; PG8_LDA(At, 1, 0); PG8_STAGE(PG8_SA(0, 1), a2 + hstep, voffA);
            PG8_WAIT_V(8); PG8_WAIT_L(0); PG8_BAR; PG8_MMA(0, 0, At, B0); PG8_MMA(0, 1, At, B1); PG8_BAR; PG8_SCHED;
            PG8_LDA(At, 1, 1); PG8_STAGE(PG8_SB(1, 0), b3, voffB); PG8_STAGE(PG8_SB(1, 1), b3 + hstep, voffB); PG8_STAGE(PG8_SA(1, 0), a3, voffA);
            PG8_WAIT_V(8); PG8_WAIT_L(0); PG8_BAR; PG8_MMA(1, 0, At, B0); PG8_MMA(1, 1, At, B1); PG8_BAR; PG8_SCHED;
            } else {
            PG8_LDB(B0, 0, 0); PG8_SCHED; PG8_LDA(At, 0, 0); PG8_STAGE(PG8_SA(1, 1), a1 + hstep, voffA);
            PG8_WAIT_L(8); PG8_BAR; PG8_WAIT_L(0); PG8_MMA(0, 0, At, B0); PG8_BAR; PG8_SCHED;
            PG8_LDB(B1, 0, 1); PG8_STAGE(PG8_SB(0, 0), b2, voffB);
            PG8_BAR; PG8_WAIT_L(0); PG8_MMA(0, 1, At, B1); PG8_BAR;
            PG8_LDA(At, 0, 1); PG8_STAGE(PG8_SA(0, 0), a2, voffA);
            PG8_BAR; PG8_WAIT_L(0); PG8_MMA(1, 0, At, B0); PG8_BAR; PG8_SCHED;
            PG8_STAGE(PG8_SB(0, 1), b2 + hstep, voffB);
            PG8_WAIT_V(6); PG8_BAR; PG8_MMA(1, 1, At, B1); PG8_BAR;
            PG8_LDB(B0, 1, 0); PG8_SCHED; PG8_LDA(At, 1, 0); PG8_STAGE(PG8_SA(0, 1), a2 + hstep, voffA);
            PG8_WAIT_L(8); PG8_BAR; PG8_WAIT_L(0); PG8_MMA(0, 0, At, B0); PG8_BAR; PG8_SCHED;
            PG8_LDB(B1, 1, 1); PG8_STAGE(PG8_SB(1, 0), b3, voffB);
            PG8_BAR; PG8_WAIT_L(0); PG8_MMA(0, 1, At, B1); PG8_BAR;
            PG8_LDA(At, 1, 1); PG8_STAGE(PG8_SA(1, 0), a3, voffA);
            PG8_BAR; PG8_WAIT_L(0); PG8_MMA(1, 0, At, B0); PG8_BAR; PG8_SCHED;
            PG8_STAGE(PG8_SB(1, 1), b3 + hstep, voffB);
            PG8_WAIT_V(6); PG8_BAR; PG8_MMA(1, 1, At, B1); PG8_BAR;
            }
        }
        if constexpr (ALIGN_EPI) { if (wr == 0) PG8_BAR; }
        if constexpr (!Epi::AFTER_DRAIN) { E(acc, cur, wr, wc, fr, fq); S.done(cur); }
        if (!has_next) break;
#pragma unroll
        for (int a = 0; a < 2; ++a)
#pragma unroll
            for (int b = 0; b < 2; ++b)
#pragma unroll
                for (int m = 0; m < 4; ++m)
#pragma unroll
                    for (int n = 0; n < 2; ++n) acc[a][b][m][n] = (f32x4){0.f, 0.f, 0.f, 0.f};
        cur = nxt; cA = nA; cB = nB; ++ui;
        if constexpr (ALIGN_EPI) { if (wr == 1) PG8_BAR; }
    }
    PG8_WAIT_V(0);
    if constexpr (!ALIGN_EPI) { if (wr == 0) PG8_BAR; }
    PG8_BAR;
    if constexpr (Epi::AFTER_DRAIN) { E.fused(acc, cur, wr, wc, fr, fq, lds, wid, lane); S.done(cur); }
#undef PG8_SA
#undef PG8_SB
#undef PG8_STAGE
#undef PG8_LDA
#undef PG8_LDB
#undef PG8_MMA
#undef PG8_WAIT_V
#undef PG8_WAIT_L
#undef PG8_BAR
#undef PG8_SCHED
}
}

constexpr int NTOK = 16384, DM = 1024, SEQ = 2048, NBATCH = 8, MEMLEN = 256, NMEM = NBATCH * MEMLEN, DFF = 2816;
constexpr int INW = 7184, INW_P = 7168;
constexpr float EPS = 1e-6f;
constexpr float LOG2E = 1.4426950408889634f;
constexpr size_t MiB = 1u << 20;
constexpr size_t WS_MLQ = 0, WS_MLK = 16 * MiB, WS_MLV = 32 * MiB, WS_MLO = 48 * MiB, WS_NAQ = 64 * MiB, WS_XAQ = 80 * MiB, WS_NAK = 96 * MiB, WS_NAVT = 112 * MiB, WS_G = 128 * MiB;
constexpr size_t WS_WBR = 224 * MiB, WS_WOUT = 227 * MiB, WS_WUP = 229 * MiB, WS_WDOWN = 240 * MiB, WS_MEMK = 246 * MiB, WS_MEMVT = 248 * MiB, WS_GATES = 250 * MiB, WS_RSS1 = 251 * MiB;
constexpr size_t WS_XBAR = 251 * MiB + 131072;
constexpr size_t WS_PCNT = WS_XBAR + 16384, WS_SUBCNT = WS_XBAR + 32768, WS_CTLBYTES = 32768 + 1024, WS_SLOTS = 251 * MiB + 262144;
constexpr size_t WS_NEED = 252 * MiB;
constexpr size_t WS_TMP = 0, WS_MERGED = WS_NAK, WS_X1B = 0, WS_UBUF = 32 * MiB, WS_ABUF = WS_G;
constexpr size_t DO_H = 0, DO_WINT = 32 * MiB, DO_WMEMKVT = 46 * MiB, DO_MEMN = 48 * MiB, DO_QC = 0, DO_KC = 16 * MiB, DO_HFW = 32 * MiB, DO_HBW = 48 * MiB;
constexpr int LDS_BYTES = 155648;
constexpr int XA_K_PITCH = 272, XA_VT_PITCH = 528, XA_VT_OFF = 256 * XA_K_PITCH;
constexpr int NA_RPB_OFF = 140000;
constexpr int LDS_XB_OFF = 155136;
constexpr int ML_QP = 272, ML_TP = 144;
constexpr int ML_QS = 0, ML_KS = ML_QS + 64 * ML_QP, ML_KT = ML_KS + 64 * ML_QP, ML_VT = ML_KT + 128 * ML_TP, ML_WVT = ML_VT + 128 * ML_TP, ML_PS = ML_WVT + 128 * ML_TP;
constexpr int ML_NV = ML_PS + 64 * ML_TP, ML_ROWSUM = ML_NV + 2 * 128 * 4, ML_DENI = ML_ROWSUM + 1024, ML_WTS = ML_DENI + 256, ML_CW = ML_WTS + 256, ML_END = ML_CW + 4 * 256 * 4;
static_assert(ML_END <= LDS_BYTES, "mlstm lds");

struct Params { const float* in[23]; float* out; unsigned char* ws; };

constexpr int TR_LDS_OFF = 131072, TR_PITCH = 48, TR_WAVE_BYTES = 32 * TR_PITCH;
__device__ __forceinline__ u32x4 tr16x32(PG8_LAS unsigned char* patch, int fr, int fq, int lane, const f32x4 v0, const f32x4 v1) {
    const unsigned w0 = cvt_pk_bf16(v0[0], v0[1]), w1 = cvt_pk_bf16(v0[2], v0[3]), w2 = cvt_pk_bf16(v1[0], v1[1]), w3 = cvt_pk_bf16(v1[2], v1[3]);
    PG8_LAS unsigned short* p = (PG8_LAS unsigned short*)(patch + (8 * fq) * TR_PITCH + fr * 2);
    p[0 * (TR_PITCH / 2)] = (unsigned short)w0; p[1 * (TR_PITCH / 2)] = (unsigned short)(w0 >> 16); p[2 * (TR_PITCH / 2)] = (unsigned short)w1; p[3 * (TR_PITCH / 2)] = (unsigned short)(w1 >> 16);
    p[4 * (TR_PITCH / 2)] = (unsigned short)w2; p[5 * (TR_PITCH / 2)] = (unsigned short)(w2 >> 16); p[6 * (TR_PITCH / 2)] = (unsigned short)w3; p[7 * (TR_PITCH / 2)] = (unsigned short)(w3 >> 16);
    asm volatile("s_waitcnt lgkmcnt(0)" ::: "memory");
    const u32x4 r = *(const PG8_LAS u32x4*)(patch + (lane >> 1) * TR_PITCH + (lane & 1) * 16);
    asm volatile("s_waitcnt lgkmcnt(0)" ::: "memory");
    return r;
}

struct EpiProj {
    static constexpr bool PERM = true, AFTER_DRAIN = false;
    unsigned char* ws; const float* bmerge; PG8_LAS unsigned char* lds;
    __device__ __forceinline__ void operator()(const f32x4 (&acc)[2][2][4][2], const pg8::Unit& u, int wr, int wc, int fr, int fq) const {
        const int row0 = u.pm * 256 + wr * 64 + fr; const int pn = u.pn; const int cl = wc * 32 + 8 * fq;
        if (pn >= 16) {
            bf16_t* G = (bf16_t*)(ws + WS_G); const int cg0 = (pn - 16) * 256 + cl;
            f32x4 bv[2][2];
#pragma unroll
            for (int bj = 0; bj < 2; ++bj)
#pragma unroll
                for (int n = 0; n < 2; ++n) bv[bj][n] = *(const f32x4*)(bmerge + cg0 + bj * 128 + 4 * n);
#pragma unroll
            for (int ai = 0; ai < 2; ++ai)
#pragma unroll
                for (int m = 0; m < 4; ++m) { const size_t row = row0 + ai * 128 + m * 16;
#pragma unroll
                    for (int bj = 0; bj < 2; ++bj) { const f32x4 v0 = acc[ai][bj][m][0] + bv[bj][0], v1 = acc[ai][bj][m][1] + bv[bj][1];
                        u32x4 w; w.x = cvt_pk_bf16(v0[0], v0[1]); w.y = cvt_pk_bf16(v0[2], v0[3]);
                        w.z = cvt_pk_bf16(v1[0], v1[1]); w.w = cvt_pk_bf16(v1[2], v1[3]);
                        *(u32x4*)(G + row * 3072 + cg0 + bj * 128) = w; } }
        } else {
            const int bi = pn >> 1, coff = (pn & 1) * 256 + cl;
            if (bi == 6) {
                bf16_t* VT = (bf16_t*)(ws + WS_NAVT);
                const int lane = fq * 16 + fr; PG8_LAS unsigned char* patch = lds + TR_LDS_OFF + (wr * 4 + wc) * TR_WAVE_BYTES;
#pragma unroll
                for (int ai = 0; ai < 2; ++ai)
#pragma unroll
                    for (int m = 0; m < 4; ++m) { const int rowb = u.pm * 256 + wr * 64 + ai * 128 + m * 16; const int b = rowb >> 11, tok0 = rowb & 2047;
#pragma unroll
                        for (int bj = 0; bj < 2; ++bj) { const u32x4 r = tr16x32(patch, fr, fq, lane, acc[ai][bj][m][0], acc[ai][bj][m][1]);
                            const int col = (pn & 1) * 256 + bj * 128 + wc * 32 + (lane >> 1);
                            *(u32x4*)(VT + ((size_t)(b * 512 + col)) * 2048 + tok0 + (lane & 1) * 8) = r; } }
            } else {
                const size_t boff = bi == 0 ? WS_MLQ : bi == 1 ? WS_MLK : bi == 2 ? WS_MLV : bi == 3 ? WS_MLO : bi == 4 ? WS_NAQ : bi == 5 ? WS_NAK : WS_XAQ;
                bf16_t* O = (bf16_t*)(ws + boff);
#pragma unroll
                for (int ai = 0; ai < 2; ++ai)
#pragma unroll
                    for (int m = 0; m < 4; ++m) { const size_t row = row0 + ai * 128 + m * 16;
#pragma unroll
                        for (int bj = 0; bj < 2; ++bj) { const f32x4 v0 = acc[ai][bj][m][0], v1 = acc[ai][bj][m][1];
                            u32x4 w; w.x = cvt_pk_bf16(v0[0], v0[1]); w.y = cvt_pk_bf16(v0[2], v0[3]); w.z = cvt_pk_bf16(v1[0], v1[1]); w.w = cvt_pk_bf16(v1[2], v1[3]);
                            *(u32x4*)(O + row * 512 + coff + bj * 128) = w; } }
            }
        }
    }
};
struct EpiMemKV {
    static constexpr bool PERM = true, AFTER_DRAIN = false;
    unsigned char* ws; PG8_LAS unsigned char* lds;
    __device__ __forceinline__ void operator()(const f32x4 (&acc)[2][2][4][2], const pg8::Unit& u, int wr, int wc, int fr, int fq) const {
        const int row0 = u.pm * 256 + wr * 64 + fr; const int pn = u.pn; const int coff = (pn & 1) * 256 + wc * 32 + 8 * fq;
        if (pn < 2) { bf16_t* O = (bf16_t*)(ws + WS_MEMK);
#pragma unroll
            for (int ai = 0; ai < 2; ++ai)
#pragma unroll
                for (int m = 0; m < 4; ++m) { const size_t row = row0 + ai * 128 + m * 16;
#pragma unroll
                    for (int bj = 0; bj < 2; ++bj) { const f32x4 v0 = acc[ai][bj][m][0], v1 = acc[ai][bj][m][1];
                        u32x4 w; w.x = cvt_pk_bf16(v0[0], v0[1]); w.y = cvt_pk_bf16(v0[2], v0[3]); w.z = cvt_pk_bf16(v1[0], v1[1]); w.w = cvt_pk_bf16(v1[2], v1[3]);
                        *(u32x4*)(O + row * 512 + coff + bj * 128) = w; } }
        } else { bf16_t* VT = (bf16_t*)(ws + WS_MEMVT);
            const int lane = fq * 16 + fr; PG8_LAS unsigned char* patch = lds + TR_LDS_OFF + (wr * 4 + wc) * TR_WAVE_BYTES;
#pragma unroll
            for (int ai = 0; ai < 2; ++ai)
#pragma unroll
                for (int m = 0; m < 4; ++m) { const int rowb = u.pm * 256 + wr * 64 + ai * 128 + m * 16; const int b = rowb >> 8, mm0 = rowb & 255;
#pragma unroll
                    for (int bj = 0; bj < 2; ++bj) { const u32x4 r = tr16x32(patch, fr, fq, lane, acc[ai][bj][m][0], acc[ai][bj][m][1]);
                        const int col = (pn & 1) * 256 + bj * 128 + wc * 32 + (lane >> 1);
                        *(u32x4*)(VT + ((size_t)(b * 512 + col)) * 256 + mm0 + (lane & 1) * 8) = r; } }
        }
    }
};
template <int MODE> struct EpiBranch {
    static constexpr bool PERM = true, AFTER_DRAIN = false;
    const bf16_t* G; float* tmp; bf16_t* merged; int br;
    __device__ __forceinline__ void operator()(const f32x4 (&acc)[2][2][4][2], const pg8::Unit& u, int wr, int wc, int fr, int fq) const {
        const int row0 = u.pm * 256 + wr * 64 + fr; const int col0 = u.pn * 256 + wc * 32 + 8 * fq;
#pragma unroll
        for (int ai = 0; ai < 2; ++ai)
#pragma unroll
            for (int m = 0; m < 4; ++m) { const size_t row = row0 + ai * 128 + m * 16;
#pragma unroll
                for (int bj = 0; bj < 2; ++bj) { const int col = col0 + bj * 128;
                    const u32x4 gw = *(const u32x4*)(G + row * 3072 + br * 1024 + col);
                    f32x4 v0 = acc[ai][bj][m][0], v1 = acc[ai][bj][m][1];
                    v0[0] *= bf_lo(gw.x); v0[1] *= bf_hi(gw.x); v0[2] *= bf_lo(gw.y); v0[3] *= bf_hi(gw.y);
                    v1[0] *= bf_lo(gw.z); v1[1] *= bf_hi(gw.z); v1[2] *= bf_lo(gw.w); v1[3] *= bf_hi(gw.w);
                    float* tp = tmp + row * 1024 + col;
                    if (MODE >= 1) { v0 += *(const f32x4*)tp; v1 += *(const f32x4*)(tp + 4); }
                    if (MODE <= 1) { *(f32x4*)tp = v0; *(f32x4*)(tp + 4) = v1; }
                    else { u32x4 w; w.x = cvt_pk_bf16(v0[0], v0[1]); w.y = cvt_pk_bf16(v0[2], v0[3]); w.z = cvt_pk_bf16(v1[0], v1[1]); w.w = cvt_pk_bf16(v1[2], v1[3]);
                        *(u32x4*)(merged + row * 1024 + col) = w; } } }
    }
};
struct BranchOrder {
    int G, c, mode, nblk, x;
    __host__ __device__ void init(int G_, int c_, int mode_, int nblk_, int x_) { G = G_; c = c_; mode = mode_; nblk = nblk_; x = x_; }
    __host__ __device__ bool next(int i, pg8::Unit& u) const {
        pg8::StaticOrder base; pg8::Unit t; int br;
        if (mode == 2) { const int q = x + i * nblk; if (q >= 512) return false; br = 1 + (q & 1); base.init(NTOK, 1024, 256, q >> 1); if (!base.next(0, t)) return false; }
        else { if (i >= (mode == 0 ? 1 : 3)) return false; br = mode == 0 ? 0 : (i == 2 ? 0 : i + 1); base.init(NTOK, 1024, G, c); if (!base.next(0, t)) return false; }
        u.pm = br * 64 + t.pm; u.pn = br * 4 + t.pn; return true;
    }
    __device__ __forceinline__ void a_ready(const pg8::Unit&) const {}
    __device__ __forceinline__ void done(const pg8::Unit&) const {}
};
struct EpiBranchAcc {
    static constexpr bool PERM = true, AFTER_DRAIN = false;
    bf16_t* G; bf16_t* merged;
    __device__ __forceinline__ void operator()(const f32x4 (&acc)[2][2][4][2], const pg8::Unit& u, int wr, int wc, int fr, int fq) const {
        const int br = u.pm >> 6, pm = u.pm & 63, pn = u.pn & 3;
        const int row0 = pm * 256 + wr * 64 + fr; const int col0 = pn * 256 + wc * 32 + 8 * fq;
#pragma unroll
        for (int ai = 0; ai < 2; ++ai)
#pragma unroll
            for (int m = 0; m < 4; ++m) { const size_t row = row0 + ai * 128 + m * 16;
#pragma unroll
                for (int bj = 0; bj < 2; ++bj) { const int col = col0 + bj * 128;
                    bf16_t* gp = G + row * 3072 + br * 1024 + col;
                    const u32x4 gw = *(const u32x4*)gp;
                    f32x4 v0 = acc[ai][bj][m][0], v1 = acc[ai][bj][m][1];
                    v0[0] *= sigmoidf_(bf_lo(gw.x)); v0[1] *= sigmoidf_(bf_hi(gw.x)); v0[2] *= sigmoidf_(bf_lo(gw.y)); v0[3] *= sigmoidf_(bf_hi(gw.y));
                    v1[0] *= sigmoidf_(bf_lo(gw.z)); v1[1] *= sigmoidf_(bf_hi(gw.z)); v1[2] *= sigmoidf_(bf_lo(gw.w)); v1[3] *= sigmoidf_(bf_hi(gw.w));
                    if (br != 0) { u32x4 w; w.x = cvt_pk_bf16(v0[0], v0[1]); w.y = cvt_pk_bf16(v0[2], v0[3]); w.z = cvt_pk_bf16(v1[0], v1[1]); w.w = cvt_pk_bf16(v1[2], v1[3]); *(u32x4*)gp = w; }
                    else {
                        const u32x4 p1 = *(const u32x4*)(gp + 1024), p2 = *(const u32x4*)(gp + 2048);
                        v0[0] += bf_lo(p1.x) + bf_lo(p2.x); v0[1] += bf_hi(p1.x) + bf_hi(p2.x); v0[2] += bf_lo(p1.y) + bf_lo(p2.y); v0[3] += bf_hi(p1.y) + bf_hi(p2.y);
                        v1[0] += bf_lo(p1.z) + bf_lo(p2.z); v1[1] += bf_hi(p1.z) + bf_hi(p2.z); v1[2] += bf_lo(p1.w) + bf_lo(p2.w); v1[3] += bf_hi(p1.w) + bf_hi(p2.w);
                        u32x4 w; w.x = cvt_pk_bf16(v0[0], v0[1]); w.y = cvt_pk_bf16(v0[2], v0[3]); w.z = cvt_pk_bf16(v1[0], v1[1]); w.w = cvt_pk_bf16(v1[2], v1[3]);
                        *(u32x4*)(merged + row * 1024 + col) = w; } } }
    }
};
struct EpiOut {
    static constexpr bool PERM = true, AFTER_DRAIN = false;
    const float* x; float* x1; bf16_t* x1b; float* rss;
    __device__ __forceinline__ void operator()(const f32x4 (&acc)[2][2][4][2], const pg8::Unit& u, int wr, int wc, int fr, int fq) const {
        const int row0 = u.pm * 256 + wr * 64 + fr; const int col0 = u.pn * 256 + wc * 32 + 8 * fq;
#pragma unroll
        for (int ai = 0; ai < 2; ++ai)
#pragma unroll
            for (int m = 0; m < 4; ++m) { const size_t row = row0 + ai * 128 + m * 16; float ss = 0.f;
#pragma unroll
                for (int bj = 0; bj < 2; ++bj) { const size_t off = row * 1024 + col0 + bj * 128;
                    const f32x4 v0 = acc[ai][bj][m][0] + *(const f32x4*)(x + off), v1 = acc[ai][bj][m][1] + *(const f32x4*)(x + off + 4);
                    u32x4 w; w.x = cvt_pk_bf16(v0[0], v0[1]); w.y = cvt_pk_bf16(v0[2], v0[3]); w.z = cvt_pk_bf16(v1[0], v1[1]); w.w = cvt_pk_bf16(v1[2], v1[3]);
                    *(u32x4*)(x1b + off) = w;
                    ss += (v0[0] * v0[0] + v0[1] * v0[1]) + (v0[2] * v0[2] + v0[3] * v0[3]) + (v1[0] * v1[0] + v1[1] * v1[1]) + (v1[2] * v1[2] + v1[3] * v1[3]); }
                ss += __shfl_xor(ss, 16); ss += __shfl_xor(ss, 32);
                if (fq == 0) atomicAdd(rss + row, ss); }
    }
};
struct EpiUp {
    static constexpr bool PERM = true, AFTER_DRAIN = false;
    const float* rss; bf16_t* A; bf16_t* U;
    __device__ __forceinline__ void operator()(const f32x4 (&acc)[2][2][4][2], const pg8::Unit& u, int wr, int wc, int fr, int fq) const {
        const int row0 = u.pm * 256 + wr * 64 + fr; const int pn = u.pn;
        bf16_t* O = pn < 11 ? A : U; const int col0 = (pn < 11 ? pn : pn - 11) * 256 + wc * 32 + 8 * fq;
#pragma unroll
        for (int ai = 0; ai < 2; ++ai)
#pragma unroll
            for (int m = 0; m < 4; ++m) { const size_t row = row0 + ai * 128 + m * 16; const float rstd = rsqrtf(rss[row] * (1.0f / 1024.0f) + EPS);
#pragma unroll
                for (int bj = 0; bj < 2; ++bj) { const f32x4 v0 = acc[ai][bj][m][0] * rstd, v1 = acc[ai][bj][m][1] * rstd;
                    u32x4 w; w.x = cvt_pk_bf16(v0[0], v0[1]); w.y = cvt_pk_bf16(v0[2], v0[3]); w.z = cvt_pk_bf16(v1[0], v1[1]); w.w = cvt_pk_bf16(v1[2], v1[3]);
                    *(u32x4*)(O + row * 2816 + col0 + bj * 128) = w; } }
    }
};
struct EpiUpGlu {
    static constexpr bool PERM = true, AFTER_DRAIN = false;
    const float* rss; const bf16_t* A; bf16_t* Gout; const float* cw; const float* cb;
    __device__ __forceinline__ void operator()(const f32x4 (&acc)[2][2][4][2], const pg8::Unit& u, int wr, int wc, int fr, int fq) const {
        const int row0 = u.pm * 256 + wr * 64 + fr;
#pragma unroll
        for (int bj = 0; bj < 2; ++bj) {
            const int ch0 = u.pn * 256 + bj * 128 + wc * 32 + 8 * fq;
            float w0[8], w1[8], w2[8], bb[8];
#pragma unroll
            for (int q = 0; q < 2; ++q) { const f32x4 t0 = *(const f32x4*)(cw + ch0 + 4 * q), t1 = *(const f32x4*)(cw + 2816 + ch0 + 4 * q), t2 = *(const f32x4*)(cw + 5632 + ch0 + 4 * q), t3 = *(const f32x4*)(cb + ch0 + 4 * q);
#pragma unroll
                for (int i = 0; i < 4; ++i) { w0[4 * q + i] = t0[i]; w1[4 * q + i] = t1[i]; w2[4 * q + i] = t2[i]; bb[4 * q + i] = t3[i]; } }
#pragma unroll
            for (int ai = 0; ai < 2; ++ai)
#pragma unroll
                for (int m = 0; m < 4; ++m) { const size_t row = row0 + ai * 128 + m * 16; const int sp = (int)(row & 2047);
                    const float rstd = rsqrtf(rss[row] * (1.0f / 1024.0f) + EPS);
                    const bf16_t* ap = A + row * 2816 + ch0;
                    const u32x4 zc = {0u, 0u, 0u, 0u};
                    const u32x4 ac = *(const u32x4*)ap, am = sp > 0 ? *(const u32x4*)(ap - 2816) : zc, an = sp < 2047 ? *(const u32x4*)(ap + 2816) : zc;
                    const float pv[8] = {bf_lo(am.x), bf_hi(am.x), bf_lo(am.y), bf_hi(am.y), bf_lo(am.z), bf_hi(am.z), bf_lo(am.w), bf_hi(am.w)};
                    const float cv[8] = {bf_lo(ac.x), bf_hi(ac.x), bf_lo(ac.y), bf_hi(ac.y), bf_lo(ac.z), bf_hi(ac.z), bf_lo(ac.w), bf_hi(ac.w)};
                    const float nv[8] = {bf_lo(an.x), bf_hi(an.x), bf_lo(an.y), bf_hi(an.y), bf_lo(an.z), bf_hi(an.z), bf_lo(an.w), bf_hi(an.w)};
                    const f32x4 u0 = acc[ai][bj][m][0] * rstd, u1 = acc[ai][bj][m][1] * rstd;
                    float o[8];
#pragma unroll
                    for (int q = 0; q < 8; ++q) { const float y = w0[q] * pv[q] + w1[q] * cv[q] + w2[q] * nv[q] + bb[q];
                        const float z = 1.5957691216057308f * (y + 0.044715f * y * y * y);
                        o[q] = y * sigmoidf_(z) * (q < 4 ? u0[q] : u1[q - 4]); }
                    u32x4 w; w.x = cvt_pk_bf16(o[0], o[1]); w.y = cvt_pk_bf16(o[2], o[3]); w.z = cvt_pk_bf16(o[4], o[5]); w.w = cvt_pk_bf16(o[6], o[7]);
                    *(u32x4*)(Gout + row * 2816 + ch0) = w; }
        }
    }
};
struct EpiDown {
    static constexpr bool PERM = true, AFTER_DRAIN = false;
    const bf16_t* x1; float* outp;
    __device__ __forceinline__ void operator()(const f32x4 (&acc)[2][2][4][2], const pg8::Unit& u, int wr, int wc, int fr, int fq) const {
        const int row0 = u.pm * 256 + wr * 64 + fr; const int col0 = u.pn * 256 + wc * 32 + 8 * fq;
#pragma unroll
        for (int ai = 0; ai < 2; ++ai)
#pragma unroll
            for (int m = 0; m < 4; ++m) { const size_t row = row0 + ai * 128 + m * 16;
#pragma unroll
                for (int bj = 0; bj < 2; ++bj) { const size_t off = row * 1024 + col0 + bj * 128; const u32x4 xw = *(const u32x4*)(x1 + off); float* p = outp + off;
                    const f32x4 v0 = acc[ai][bj][m][0] + (f32x4){bf_lo(xw.x), bf_hi(xw.x), bf_lo(xw.y), bf_hi(xw.y)}, v1 = acc[ai][bj][m][1] + (f32x4){bf_lo(xw.z), bf_hi(xw.z), bf_lo(xw.w), bf_hi(xw.w)};
                    *(f32x4*)p = v0; *(f32x4*)(p + 4) = v1; } }
    }
};

struct EpiDownNorm {
    static constexpr bool PERM = true, AFTER_DRAIN = true;
    const bf16_t* x1; const float* gfin; float* slots; unsigned* cnt; float* outp;
    __device__ __forceinline__ void operator()(const f32x4 (&)[2][2][4][2], const pg8::Unit&, int, int, int, int) const {}
    __device__ __forceinline__ void fused(f32x4 (&acc)[2][2][4][2], const pg8::Unit& u, int wr, int wc, int fr, int fq, PG8_LAS unsigned char* lds, int wid, int lane) const {
        PG8_LAS float* Pt = (PG8_LAS float*)lds;
        PG8_LAS float* St = (PG8_LAS float*)(lds + 4096);
        const int row0 = u.pm * 256 + wr * 64 + fr; const int col0 = u.pn * 256 + wc * 32 + 8 * fq;
#pragma unroll
        for (int ai = 0; ai < 2; ++ai)
#pragma unroll
            for (int m = 0; m < 4; ++m) { const size_t row = row0 + ai * 128 + m * 16; float ss = 0.f;
#pragma unroll
                for (int bj = 0; bj < 2; ++bj) { const u32x4 xw = *(const u32x4*)(x1 + row * 1024 + col0 + bj * 128);
                    const f32x4 v0 = acc[ai][bj][m][0] + (f32x4){bf_lo(xw.x), bf_hi(xw.x), bf_lo(xw.y), bf_hi(xw.y)}, v1 = acc[ai][bj][m][1] + (f32x4){bf_lo(xw.z), bf_hi(xw.z), bf_lo(xw.w), bf_hi(xw.w)};
                    acc[ai][bj][m][0] = v0; acc[ai][bj][m][1] = v1;
                    ss += (v0[0] * v0[0] + v0[1] * v0[1]) + (v0[2] * v0[2] + v0[3] * v0[3]) + (v1[0] * v1[0] + v1[1] * v1[1]) + (v1[2] * v1[2] + v1[3] * v1[3]); }
                ss += __shfl_xor(ss, 16); ss += __shfl_xor(ss, 32);
                if (fq == 0) Pt[(ai * 128 + wr * 64 + m * 16 + fr) * 4 + wc] = ss; }
        asm volatile("s_waitcnt lgkmcnt(0)" ::: "memory"); __builtin_amdgcn_s_barrier(); asm volatile("" ::: "memory");
        const int t = wid * 64 + lane;
        if (t < 256) { const float tot = (Pt[t * 4] + Pt[t * 4 + 1]) + (Pt[t * 4 + 2] + Pt[t * 4 + 3]);
            __hip_atomic_store(slots + ((size_t)(u.pm * 256 + t) * 4 + u.pn), tot, __ATOMIC_RELAXED, __HIP_MEMORY_SCOPE_AGENT); }
        asm volatile("s_waitcnt vmcnt(0)" ::: "memory"); __builtin_amdgcn_s_barrier(); asm volatile("" ::: "memory");
        if (t == 0) { __hip_atomic_fetch_add(cnt + 64 * u.pm, 1u, __ATOMIC_RELAXED, __HIP_MEMORY_SCOPE_AGENT);
            unsigned sp = 0; while (__hip_atomic_load(cnt + 64 * u.pm, __ATOMIC_RELAXED, __HIP_MEMORY_SCOPE_AGENT) < 4u) { __builtin_amdgcn_s_sleep(2); if (++sp > (1u << 22)) break; }
            __builtin_amdgcn_fence(__ATOMIC_ACQUIRE, "agent"); asm volatile("s_waitcnt vmcnt(0)" ::: "memory"); }
        __builtin_amdgcn_s_barrier(); asm volatile("" ::: "memory");
        if (t < 256) { const float* sl = slots + (size_t)(u.pm * 256 + t) * 4;
            const float tot = (__hip_atomic_load(sl, __ATOMIC_RELAXED, __HIP_MEMORY_SCOPE_AGENT) + __hip_atomic_load(sl + 1, __ATOMIC_RELAXED, __HIP_MEMORY_SCOPE_AGENT))
                            + (__hip_atomic_load(sl + 2, __ATOMIC_RELAXED, __HIP_MEMORY_SCOPE_AGENT) + __hip_atomic_load(sl + 3, __ATOMIC_RELAXED, __HIP_MEMORY_SCOPE_AGENT));
            St[t] = rsqrtf(tot * (1.0f / 1024.0f) + EPS); }
        asm volatile("s_waitcnt lgkmcnt(0)" ::: "memory"); __builtin_amdgcn_s_barrier(); asm volatile("" ::: "memory");
        f32x4 gv[2][2];
#pragma unroll
        for (int bj = 0; bj < 2; ++bj) { gv[bj][0] = *(const f32x4*)(gfin + col0 + bj * 128); gv[bj][1] = *(const f32x4*)(gfin + col0 + bj * 128 + 4); }
#pragma unroll
        for (int ai = 0; ai < 2; ++ai)
#pragma unroll
            for (int m = 0; m < 4; ++m) { const int rl = ai * 128 + wr * 64 + m * 16 + fr; const float rstd = St[rl]; const size_t row = (size_t)u.pm * 256 + rl;
#pragma unroll
                for (int bj = 0; bj < 2; ++bj) { float* p = outp + row * 1024 + col0 + bj * 128;
                    *(f32x4*)p = acc[ai][bj][m][0] * rstd * gv[bj][0]; *(f32x4*)(p + 4) = acc[ai][bj][m][1] * rstd * gv[bj][1]; } }
    }
};

__device__ __forceinline__ float wave_sum(float v) {
#pragma unroll
    for (int o = 1; o < 64; o <<= 1) v += __shfl_xor(v, o);
    return v;
}
__device__ __forceinline__ void transpose_item(const float* W, int ldw, int col0, int k0, bf16_t* WT, int K, int row_dst0, const float* kscale, LAS float* scr, int lane) {
    f32x4 v[8];
#pragma unroll
    for (int i = 0; i < 8; ++i) { const int kk = 8 * i + (lane >> 3); v[i] = *(const f32x4*)(W + (size_t)(k0 + kk) * ldw + col0 + (lane & 7) * 4); }
#pragma unroll
    for (int i = 0; i < 8; ++i) { const int kk = 8 * i + (lane >> 3); f32x4 t = v[i]; if (kscale) t = t * kscale[k0 + kk];
        LAS float* d = scr + kk * 33 + (lane & 7) * 4; d[0] = t[0]; d[1] = t[1]; d[2] = t[2]; d[3] = t[3]; }
    LDS_WAIT(); asm volatile("" ::: "memory");
    const int c = lane & 7;
#pragma unroll
    for (int j = 0; j < 4; ++j) { const int n = (lane >> 3) + 8 * j; const LAS float* s = scr + (8 * c) * 33 + n;
        u32x4 o; o.x = cvt_pk_bf16(s[0 * 33], s[1 * 33]); o.y = cvt_pk_bf16(s[2 * 33], s[3 * 33]); o.z = cvt_pk_bf16(s[4 * 33], s[5 * 33]); o.w = cvt_pk_bf16(s[6 * 33], s[7 * 33]);
        *(u32x4*)(WT + (size_t)(row_dst0 + n) * K + k0 + 8 * c) = o; }
    LDS_WAIT(); asm volatile("" ::: "memory");
}
constexpr int WI_IN = 16 * 224, WI_MKV = 16 * 32, WI_BR = 8 * 32, WI_OUT = 16 * 32, WI_UP = 16 * 176, WI_DN = 44 * 32;
constexpr int WI_EARLY = WI_IN + WI_MKV, WI_ALL = WI_IN + WI_MKV + 3 * WI_BR + WI_OUT + WI_UP + WI_DN;
__device__ __forceinline__ void weight_items(LAS unsigned char* lds, const Params& P, int it_begin, int it_end, int gw, int NGW, int wave, int lane) {
    unsigned char* ws = P.ws; unsigned char* dob = (unsigned char*)P.out;
    LAS float* scr = (LAS float*)(lds + wave * 8448);
    constexpr int I_IN = WI_IN, I_MKV = WI_MKV, I_BR = WI_BR, I_OUT = WI_OUT, I_UP = WI_UP;
    for (int it = it_begin + gw; it < it_end; it += NGW) {
        int r = it;
        if (r < I_IN) { const int kb = r / 224, nb = r % 224, n0 = 32 * nb; transpose_item(P.in[3], INW, n0 + (n0 >= 2048 ? 16 : 0), 64 * kb, (bf16_t*)(dob + DO_WINT), 1024, n0, nullptr, scr, lane); continue; } r -= I_IN;
        if (r < I_MKV) { const int kb = r / 32, nb = r % 32; transpose_item(P.in[11], 1024, 32 * nb, 64 * kb, (bf16_t*)(dob + DO_WMEMKVT), 1024, 32 * nb, nullptr, scr, lane); continue; } r -= I_MKV;
        if (r < 3 * I_BR) { const int br = r / I_BR; r -= br * I_BR; const int kb = r / 32, nb = r % 32; transpose_item(P.in[13 + br], 1024, 32 * nb, 64 * kb, (bf16_t*)(ws + WS_WBR + br * MiB), 512, 32 * nb, nullptr, scr, lane); continue; } r -= 3 * I_BR;
        if (r < I_OUT) { const int kb = r / 32, nb = r % 32; transpose_item(P.in[16], 1024, 32 * nb, 64 * kb, (bf16_t*)(ws + WS_WOUT), 1024, 32 * nb, nullptr, scr, lane); continue; } r -= I_OUT;
        if (r < I_UP) { const int kb = r / 176, nb = r % 176; transpose_item(P.in[18], 5632, 32 * nb, 64 * kb, (bf16_t*)(ws + WS_WUP), 1024, 32 * nb, P.in[17], scr, lane); continue; } r -= I_UP;
        { const int kb = r / 32, nb = r % 32; transpose_item(P.in[21], 1024, 32 * nb, 64 * kb, (bf16_t*)(ws + WS_WDOWN), 2816, 32 * nb, nullptr, scr, lane); }
    }
}
__device__ __forceinline__ void p0_prologue(LAS unsigned char* lds, const Params& P, int G) {
    int tid_ = threadIdx.x; asm volatile("" : "+v"(tid_)); const int tid = tid_, lane = tid & 63, wave = tid >> 6;
    const int gw = blockIdx.x * 8 + wave, NGW = G * 8;
    unsigned char* ws = P.ws; unsigned char* dob = (unsigned char*)P.out;
    LAS float* scr = (LAS float*)(lds + wave * 8448);
    LAS float* tab = (LAS float*)(lds + 8 * 8448);
    { const float* win = P.in[3];
      for (int k = tid; k < 1024; k += 512) {
          const f32x4* src = (const f32x4*)(win + (size_t)k * INW + 2048);
#pragma unroll
          for (int q = 0; q < 4; ++q) { const f32x4 v = src[q]; tab[(4 * q + 0) * 1024 + k] = v[0]; tab[(4 * q + 1) * 1024 + k] = v[1]; tab[(4 * q + 2) * 1024 + k] = v[2]; tab[(4 * q + 3) * 1024 + k] = v[3]; } } }
    { float* rss = (float*)(ws + WS_RSS1); for (int i = blockIdx.x * 512 + tid; i < NTOK; i += G * 512) rss[i] = 0.f; }
    weight_items(lds, P, 0, G >= 128 ? WI_EARLY : WI_ALL, gw, NGW, wave, lane);
    __syncthreads();
    {
        const int NR = NTOK + NMEM;
        f32x4 gx[4], gm[4];
#pragma unroll
        for (int j = 0; j < 4; ++j) { gx[j] = ((const f32x4*)P.in[2])[64 * j + lane]; gm[j] = ((const f32x4*)P.in[10])[64 * j + lane]; }
        for (int m0 = gw; m0 < NR; m0 += 2 * NGW) {
            const int m1 = m0 + NGW; const bool has1 = m1 < NR;
            f32x4 va[4], vb[4];
            { const float* xr = m0 < NTOK ? P.in[0] + (size_t)m0 * 1024 : P.in[1] + (size_t)(m0 - NTOK) * 1024;
#pragma unroll
              for (int j = 0; j < 4; ++j) va[j] = ((const f32x4*)xr)[64 * j + lane]; }
            { const int mm = has1 ? m1 : m0; const float* xr = mm < NTOK ? P.in[0] + (size_t)mm * 1024 : P.in[1] + (size_t)(mm - NTOK) * 1024;
#pragma unroll
              for (int j = 0; j < 4; ++j) vb[j] = ((const f32x4*)xr)[64 * j + lane]; }
#pragma unroll
            for (int rr = 0; rr < 2; ++rr) {
                if (rr == 1 && !has1) break;
                const int m = rr ? m1 : m0; const bool is_x = m < NTOK;
                f32x4 v[4];
#pragma unroll
                for (int j = 0; j < 4; ++j) v[j] = rr ? vb[j] : va[j];
                bf16_t* orow = is_x ? (bf16_t*)(dob + DO_H) + (size_t)m * 1024 : (bf16_t*)(dob + DO_MEMN) + (size_t)(m - NTOK) * 1024;
                float s = 0.f;
#pragma unroll
                for (int j = 0; j < 4; ++j) s += (v[j][0] * v[j][0] + v[j][1] * v[j][1]) + (v[j][2] * v[j][2] + v[j][3] * v[j][3]);
                const float rstd = rsqrtf(wave_sum(s) * (1.0f / 1024.0f) + EPS);
#pragma unroll
                for (int j = 0; j < 4; ++j) { v[j] = v[j] * rstd * (is_x ? gx[j] : gm[j]);
                    u32x2 w; w.x = cvt_pk_bf16(v[j][0], v[j][1]); w.y = cvt_pk_bf16(v[j][2], v[j][3]); ((u32x2*)orow)[64 * j + lane] = w; }
                if (is_x) {
                    float a[16];
#pragma unroll
                    for (int gi = 0; gi < 16; ++gi) { float acc = 0.f;
#pragma unroll
                        for (int j = 0; j < 4; ++j) { const f32x4 t = *(const LAS f32x4*)(tab + gi * 1024 + 256 * j + 4 * lane); acc += (v[j][0] * t[0] + v[j][1] * t[1]) + (v[j][2] * t[2] + v[j][3] * t[3]); }
                        a[gi] = acc; }
                    const bool u32_ = (lane & 32) != 0, u16_ = (lane & 16) != 0, u8_ = (lane & 8) != 0, u4_ = (lane & 4) != 0;
                    float b8[8], c4[4], d2[2];
#pragma unroll
                    for (int i = 0; i < 8; ++i) { const float mine = u32_ ? a[i + 8] : a[i], oth = u32_ ? a[i] : a[i + 8]; b8[i] = mine + __shfl_xor(oth, 32); }
#pragma unroll
                    for (int i = 0; i < 4; ++i) { const float mine = u16_ ? b8[i + 4] : b8[i], oth = u16_ ? b8[i] : b8[i + 4]; c4[i] = mine + __shfl_xor(oth, 16); }
#pragma unroll
                    for (int i = 0; i < 2; ++i) { const float mine = u8_ ? c4[i + 2] : c4[i], oth = u8_ ? c4[i] : c4[i + 2]; d2[i] = mine + __shfl_xor(oth, 8); }
                    float e = (u4_ ? d2[1] : d2[0]) + __shfl_xor(u4_ ? d2[0] : d2[1], 4);
                    e += __shfl_xor(e, 2); e += __shfl_xor(e, 1);
                    if ((lane & 3) == 0) ((float*)(ws + WS_GATES))[(size_t)m * 16 + (lane >> 2)] = e;
                }
            }
        }
    }
}

__device__ __forceinline__ void xa_unit(LAS unsigned char* lds, unsigned char* ws, int unit) {
    const int b = unit >> 5, h = (unit >> 3) & 3, qb = unit & 7;
    int tid_ = threadIdx.x; asm volatile("" : "+v"(tid_)); const int tid = tid_, lane = tid & 63, wid = tid >> 6, r32 = lane & 31, hi = lane >> 5;
    const bf16_t* Kg = (const bf16_t*)(ws + WS_MEMK) + (size_t)(b * 256) * 512 + h * 128;
    const bf16_t* Vg = (const bf16_t*)(ws + WS_MEMVT) + (size_t)(b * 512 + h * 128) * 256;
#ifdef XA_TEST_OUT
    bf16_t* XA_OUT = (bf16_t*)(ws + WS_MLO);
#else
    bf16_t* XA_OUT = (bf16_t*)(ws + WS_XAQ);
#endif
    bf16_t* Q = (bf16_t*)(ws + WS_XAQ);
#pragma unroll
    for (int i = 0; i < 8; ++i) { const int idx = tid + 512 * i; const int row = idx >> 4, ch = idx & 15;
        const u32x4 v = *(const u32x4*)(Kg + (size_t)row * 512 + ch * 8); *(LAS u32x4*)(lds + row * XA_K_PITCH + ch * 16) = v; }
#pragma unroll
    for (int i = 0; i < 8; ++i) { const int idx = tid + 512 * i; const int d = idx >> 5, ch = idx & 31;
        const u32x4 v = *(const u32x4*)(Vg + (size_t)d * 256 + ch * 8); *(LAS u32x4*)(lds + XA_VT_OFF + d * XA_VT_PITCH + ch * 16) = v; }
    const size_t qrow = (size_t)b * 2048 + qb * 256 + wid * 32 + r32;
    bf16x8 qf[8];
#pragma unroll
    for (int s = 0; s < 8; ++s) qf[s] = *(const bf16x8*)(Q + qrow * 512 + h * 128 + 16 * s + 8 * hi);
    __syncthreads();
    const float sc = 0.08838834764831845f * LOG2E;
    f32x16 o[4];
#pragma unroll
    for (int d = 0; d < 4; ++d)
#pragma unroll
        for (int r = 0; r < 16; ++r) o[d][r] = 0.f;
    float mrun = -INFINITY, lsum = 0.f;
    for (int kt = 0; kt < 4; ++kt) {
        f32x16 p[2];
#pragma unroll
        for (int blk = 0; blk < 2; ++blk) {
#pragma unroll
            for (int r = 0; r < 16; ++r) p[blk][r] = 0.f;
            const LAS unsigned char* kp = lds + (64 * kt + 32 * blk + r32) * XA_K_PITCH + hi * 16;
#pragma unroll
            for (int s = 0; s < 8; ++s) { const bf16x8 kf = *(const LAS bf16x8*)(kp + s * 32); p[blk] = __builtin_amdgcn_mfma_f32_32x32x16_bf16(kf, qf[s], p[blk], 0, 0, 0); }
        }
        float tmax = p[0][0];
#pragma unroll
        for (int r = 0; r < 16; ++r) { tmax = fmaxf(tmax, p[0][r]); tmax = fmaxf(tmax, p[1][r]); }
        tmax = fmaxf(tmax, __shfl_xor(tmax, 32));
        const float mnew = fmaxf(mrun, tmax * sc);
        const float alpha = fast_exp2(mrun - mnew);
        mrun = mnew;
        float ps = 0.f;
#pragma unroll
        for (int blk = 0; blk < 2; ++blk)
#pragma unroll
            for (int r = 0; r < 16; ++r) { const float e = fast_exp2(p[blk][r] * sc - mnew); p[blk][r] = e; ps += e; }
        lsum = lsum * alpha + ps;
#pragma unroll
        for (int d = 0; d < 4; ++d)
#pragma unroll
            for (int r = 0; r < 16; ++r) o[d][r] *= alpha;
#pragma unroll
        for (int blk = 0; blk < 2; ++blk)
#pragma unroll
            for (int st = 0; st < 2; ++st) {
                union { bf16x8 v; unsigned u[4]; } pb;
#pragma unroll
                for (int q = 0; q < 4; ++q) pb.u[q] = cvt_pk_bf16(p[blk][8 * st + 2 * q], p[blk][8 * st + 2 * q + 1]);
                const int kbase = 64 * kt + 32 * blk + 16 * st;
#pragma unroll
                for (int d = 0; d < 4; ++d) {
                    const LAS unsigned char* vp = lds + XA_VT_OFF + (32 * d + r32) * XA_VT_PITCH + (kbase + 4 * hi) * 2;
                    union { bf16x8 v; s16x4 h[2]; } va; va.h[0] = *(const LAS s16x4*)vp; va.h[1] = *(const LAS s16x4*)(vp + 16);
                    o[d] = __builtin_amdgcn_mfma_f32_32x32x16_bf16(va.v, pb.v, o[d], 0, 0, 0);
                }
            }
    }
    lsum += __shfl_xor(lsum, 32);
    const float inv = 1.0f / lsum;
#ifdef XA_COPY
    {
#pragma unroll
    for (int d = 0; d < 4; ++d)
#pragma unroll
        for (int g = 0; g < 4; ++g) { u32x2 w;
            if (XA_COPY == 1) { union { bf16x8 v; unsigned u[4]; } t; t.v = qf[(d * 4 + g) >> 1]; w.x = t.u[((d * 4 + g) & 1) * 2]; w.y = t.u[((d * 4 + g) & 1) * 2 + 1]; }
            else if (XA_COPY == 2) { w = *(const LAS u32x2*)(lds + (wid * 32 + r32) * XA_K_PITCH + hi * 128 + (d * 4 + g) * 8); }
            else { const int L = wid * 64 + lane; w = *(const LAS u32x2*)(lds + XA_VT_OFF + (L >> 2) * XA_VT_PITCH + (L & 3) * 128 + (d * 4 + g) * 8); }
            *(u32x2*)(XA_OUT + qrow * 512 + h * 128 + 32 * d + 8 * g + 4 * hi) = w; }
    __syncthreads(); return;
    }
#endif
#pragma unroll
    for (int d = 0; d < 4; ++d)
#pragma unroll
        for (int g = 0; g < 4; ++g) { u32x2 w; w.x = cvt_pk_bf16(o[d][4 * g] * inv, o[d][4 * g + 1] * inv); w.y = cvt_pk_bf16(o[d][4 * g + 2] * inv, o[d][4 * g + 3] * inv);
            *(u32x2*)(XA_OUT + qrow * 512 + h * 128 + 32 * d + 8 * g + 4 * hi) = w; }
    __syncthreads();
}

#define LDS_BARRIER() asm volatile("s_waitcnt lgkmcnt(0)\n\ts_barrier" ::: "memory")
constexpr int NA_VT_OFF = 576 * 128, NA_VT_PITCH = 1168, NA2_RPB_OFF = NA_VT_OFF + 64 * NA_VT_PITCH;
__device__ __forceinline__ void na_unit(LAS unsigned char* lds, unsigned char* ws, const float* rpb_g, int unit) {
    const int b = unit >> 7, h = (unit >> 4) & 7, rp = unit & 15;
    int tid_ = threadIdx.x; asm volatile("" : "+v"(tid_)); const int tid = tid_, lane = tid & 63, wid = tid >> 6, l15 = lane & 15, quad = lane >> 4;
    bf16_t* Q = (bf16_t*)(ws + WS_NAQ); const bf16_t* K = (const bf16_t*)(ws + WS_NAK); const bf16_t* VT = (const bf16_t*)(ws + WS_NAVT);
    const int r0 = 2 * rp, rsA = min(max(r0 - 4, 0), 24);
    const int r = r0 + (wid >> 2), j = wid & 3;
    const int c = 16 * j + l15, kc0 = min(max(16 * j - 8, 0), 32), cs = min(max(c - 8, 0), 48);
    const int rs = min(max(r - 4, 0), 24), dr = rs - rsA;
    const size_t qrow = (size_t)b * 2048 + r * 64 + c;
    bf16x8 qf[2];
    qf[0] = *(const bf16x8*)(Q + qrow * 512 + h * 64 + 8 * quad); qf[1] = *(const bf16x8*)(Q + qrow * 512 + h * 64 + 32 + 8 * quad);
#pragma unroll
    for (int i = 0; i < 9; ++i) { const int p = tid + 512 * i; const int tl = p >> 3, ch = p & 7; const int row = min(rsA + (tl >> 6), 31);
        const u32x4 v = *(const u32x4*)(K + ((size_t)b * 2048 + row * 64 + (tl & 63)) * 512 + h * 64 + ch * 8);
        *(LAS u32x4*)(lds + tl * 128 + ((ch ^ (tl & 7)) << 4)) = v; }
#pragma unroll
    for (int i = 0; i < 9; ++i) { const int p = tid + 512 * i; const int d = p / 72, ch = p - d * 72;
        const u32x4 v = *(const u32x4*)(VT + ((size_t)(b * 512 + h * 64 + d)) * 2048 + rsA * 64 + ch * 8);
        *(LAS u32x4*)(lds + NA_VT_OFF + d * NA_VT_PITCH + ch * 16) = v; }
    if (tid < 465) ((LAS float*)(lds + NA2_RPB_OFF))[tid] = rpb_g[h * 465 + tid];
    LDS_BARRIER();
    const LAS float* rpb = (const LAS float*)(lds + NA2_RPB_OFF);
    f32x4 s[8][2];
#pragma unroll
    for (int kr = 0; kr < 8; ++kr)
#pragma unroll
        for (int hf = 0; hf < 2; ++hf) {
            const int tl = (dr + kr) * 64 + kc0 + 16 * hf + l15;
            const bf16x8 k0 = *(const LAS bf16x8*)(lds + tl * 128 + ((quad ^ (tl & 7)) << 4)), k1 = *(const LAS bf16x8*)(lds + tl * 128 + (((4 + quad) ^ (tl & 7)) << 4));
            f32x4 a = {0.f, 0.f, 0.f, 0.f};
            a = __builtin_amdgcn_mfma_f32_16x16x32_bf16(k0, qf[0], a, 0, 0, 0);
            a = __builtin_amdgcn_mfma_f32_16x16x32_bf16(k1, qf[1], a, 0, 0, 0);
            s[kr][hf] = a;
        }
    float mx = -INFINITY;
#pragma unroll
    for (int kr = 0; kr < 8; ++kr)
#pragma unroll
        for (int hf = 0; hf < 2; ++hf)
#pragma unroll
            for (int i = 0; i < 4; ++i) { const int kc = kc0 + 16 * hf + 4 * quad + i; const bool valid = (kc >= cs) && (kc < cs + 16);
                const int bidx = valid ? ((rs + kr - r + 7) * 31 + (kc - c + 15)) : 0;
                const float t = valid ? (s[kr][hf][i] * 0.125f + rpb[bidx]) * LOG2E : -INFINITY;
                s[kr][hf][i] = t; mx = fmaxf(mx, t); }
    mx = fmaxf(mx, __shfl_xor(mx, 16)); mx = fmaxf(mx, __shfl_xor(mx, 32));
    float sum = 0.f;
#pragma unroll
    for (int kr = 0; kr < 8; ++kr)
#pragma unroll
        for (int hf = 0; hf < 2; ++hf)
#pragma unroll
            for (int i = 0; i < 4; ++i) { const float e = fast_exp2(s[kr][hf][i] - mx); s[kr][hf][i] = e; sum += e; }
    sum += __shfl_xor(sum, 16); sum += __shfl_xor(sum, 32);
    const float inv = 1.0f / sum;
    f32x4 o[4];
#pragma unroll
    for (int db = 0; db < 4; ++db) o[db] = (f32x4){0.f, 0.f, 0.f, 0.f};
#pragma unroll
    for (int kr = 0; kr < 8; ++kr) {
        union { bf16x8 v; unsigned u[4]; } pb;
        pb.u[0] = cvt_pk_bf16(s[kr][0][0], s[kr][0][1]); pb.u[1] = cvt_pk_bf16(s[kr][0][2], s[kr][0][3]);
        pb.u[2] = cvt_pk_bf16(s[kr][1][0], s[kr][1][1]); pb.u[3] = cvt_pk_bf16(s[kr][1][2], s[kr][1][3]);
#pragma unroll
        for (int db = 0; db < 4; ++db) {
            const LAS unsigned char* vp = lds + NA_VT_OFF + (16 * db + l15) * NA_VT_PITCH + ((dr + kr) * 64 + kc0 + 4 * quad) * 2;
            union { bf16x8 v; s16x4 hh[2]; } va; va.hh[0] = *(const LAS s16x4*)vp; va.hh[1] = *(const LAS s16x4*)(vp + 32);
            o[db] = __builtin_amdgcn_mfma_f32_16x16x32_bf16(va.v, pb.v, o[db], 0, 0, 0);
        }
    }
#pragma unroll
    for (int db = 0; db < 4; ++db) { u32x2 w; w.x = cvt_pk_bf16(o[db][0] * inv, o[db][1] * inv); w.y = cvt_pk_bf16(o[db][2] * inv, o[db][3] * inv);
        *(u32x2*)(Q + qrow * 512 + h * 64 + 16 * db + 4 * quad) = w; }
    LDS_BARRIER();
}

__device__ __forceinline__ unsigned pack2(float a, float b) { return cvt_pk_bf16(a, b); }
__device__ __forceinline__ int tsw(int row, int pos) { return row * ML_TP + ((((pos >> 3) ^ (row >> 3)) & 7) << 4) + ((pos & 7) << 1); }
#ifndef TIME_PHASE
#define TIME_PHASE -1
#endif
template <int CTRL, int RM, int BMK> __device__ __forceinline__ float dppf(float old, float src) { return __int_as_float(__builtin_amdgcn_update_dpp(__float_as_int(old), __float_as_int(src), CTRL, RM, BMK, false)); }
__device__ __forceinline__ float wave_scan_add(float v) {
    v += dppf<0x111, 0xf, 0xf>(0.f, v); v += dppf<0x112, 0xf, 0xf>(0.f, v); v += dppf<0x114, 0xf, 0xf>(0.f, v); v += dppf<0x118, 0xf, 0xf>(0.f, v);
    v += dppf<0x142, 0xa, 0xf>(0.f, v); v += dppf<0x143, 0xc, 0xf>(0.f, v); return v; }
__device__ __forceinline__ float wave_scan_max(float v) {
    v = fmaxf(v, dppf<0x111, 0xf, 0xf>(-INFINITY, v)); v = fmaxf(v, dppf<0x112, 0xf, 0xf>(-INFINITY, v)); v = fmaxf(v, dppf<0x114, 0xf, 0xf>(-INFINITY, v)); v = fmaxf(v, dppf<0x118, 0xf, 0xf>(-INFINITY, v));
    v = fmaxf(v, dppf<0x142, 0xa, 0xf>(-INFINITY, v)); v = fmaxf(v, dppf<0x143, 0xc, 0xf>(-INFINITY, v)); return v; }
__device__ __forceinline__ float lane63(float v) { return __int_as_float(__builtin_amdgcn_readlane(__float_as_int(v), 63)); }
#define MLT(k) if (TIME_PHASE == 20 + (k)) { const unsigned long long n_ = __builtin_amdgcn_s_memrealtime(); tacc += n_ - tlast; tlast = n_; } else if (TIME_PHASE >= 20 && TIME_PHASE < 24) { tlast = __builtin_amdgcn_s_memrealtime(); }
__device__ __forceinline__ unsigned long long ml_chain(LAS unsigned char* lds, const Params& P, int chain) {
    unsigned long long tacc = 0, tlast = 0;
    const int b = chain >> 3, h = (chain >> 1) & 3, dir = chain & 1;
    int tid_ = threadIdx.x; asm volatile("" : "+v"(tid_)); const int tid = tid_, lane = tid & 63, w = __builtin_amdgcn_readfirstlane(tid >> 6), l15 = lane & 15, quad = lane >> 4;
    unsigned char* ws = P.ws;
    const bf16_t* MLV = (const bf16_t*)(ws + WS_MLV);
    const float* GATES = (const float*)(ws + WS_GATES);
    bf16_t* HDIR = (bf16_t*)((unsigned char*)P.out + (dir ? DO_HBW : DO_HFW));
    LAS float* NV = (LAS float*)(lds + ML_NV); LAS float* NVP = (LAS float*)(lds + ML_CW); LAS float* ROWSUM = (LAS float*)(lds + ML_ROWSUM);
    LAS float* DENI = (LAS float*)(lds + ML_DENI); LAS float* WTS = (LAS float*)(lds + ML_WTS);
    if (tid < 256) NV[tid] = 0.f;
    f32x4 C[8];
#pragma unroll
    for (int e = 0; e < 8; ++e) C[e] = (f32x4){0.f, 0.f, 0.f, 0.f};
    float m_run = -1e30f;
    const float big = P.in[4][dir * 4 + h], bfg = P.in[5][dir * 4 + h];
    const int cgp = tid & 31, rg = tid >> 5; const bool isk = cgp >= 16; const int c8 = (cgp & 15) * 8;
    const bf16_t* qksrc = (const bf16_t*)((const unsigned char*)P.out + (isk ? DO_KC : DO_QC)) + h * 128 + c8;
    const int vcg = tid & 15, vrg = tid >> 4;
    const size_t brow = (size_t)b * 2048;
    struct MLPF { u32x4 raw[4]; u32x4 vraw[2]; float gi, gf; };
    MLPF pfA;
#define ML_ISSUE(pf, cc) do { const int tb_ = dir ? 2048 - 64 * ((cc) + 1) : 64 * (cc); \
        _Pragma("unroll") for (int i_ = 0; i_ < 4; ++i_) { const int t_ = tb_ + 4 * rg + i_; (pf).raw[i_] = *(const u32x4*)(qksrc + (brow + t_) * 512); } \
        _Pragma("unroll") for (int i_ = 0; i_ < 2; ++i_) { const int t_ = tb_ + 2 * vrg + i_; (pf).vraw[i_] = *(const u32x4*)(MLV + (brow + t_) * 512 + h * 128 + vcg * 8); } \
        { const int t_ = dir ? tb_ + 63 - lane : tb_ + lane; (pf).gi = GATES[(brow + t_) * 16 + (dir * 2) * 4 + h]; (pf).gf = GATES[(brow + t_) * 16 + (dir * 2 + 1) * 4 + h]; } } while (0)
    ML_ISSUE(pfA, 0);
    __syncthreads();
    {
      for (int c = 0; c < 32; ++c) {
        MLPF& pf = pfA;
        u32x4 raw[4], vraw[2];
#pragma unroll
        for (int i_ = 0; i_ < 4; ++i_) raw[i_] = pf.raw[i_];
        vraw[0] = pf.vraw[0]; vraw[1] = pf.vraw[1];
        const float gi_raw = pf.gi, gf_raw = pf.gf;
        const int tb = dir ? 2048 - 64 * (c + 1) : 64 * c; const int par = c & 1;
        MLT(3)
        const float gi = gi_raw + big, gf = gf_raw + bfg;
        const float lf = fminf(gf, 0.f) - __logf(1.0f + fast_exp(-fabsf(gf)));
        const float a = wave_scan_add(lf);
        const float g = lane63(a);
        const float u = gi - a; const float pm = wave_scan_max(u);
        const float mj = a + fmaxf(m_run, pm);
        const float inter_w = fast_exp(a + m_run - mj);
        const float pm63 = lane63(pm); const float m_new = fmaxf(g + m_run, g + pm63);
        const float decay = fast_exp(g + m_run - m_new);
        const float wt = fast_exp(g + u - m_new);
        const float emj = fast_exp(-mj);
        MLT(0)
        if (w == 0) { WTS[lane] = wt; }
        {
            LAS unsigned char* rm = lds + (isk ? ML_KS : ML_QS);
#pragma unroll
            for (int i = 0; i < 4; ++i) { const int p = dir ? 63 - (4 * rg + i) : 4 * rg + i; *(LAS u32x4*)(rm + p * ML_QP + c8 * 2) = raw[i]; }
            if (isk) {
#pragma unroll
                for (int cp = 0; cp < 4; ++cp) {
                    const unsigned t0 = cp == 0 ? raw[0].x : cp == 1 ? raw[0].y : cp == 2 ? raw[0].z : raw[0].w, t1 = cp == 0 ? raw[1].x : cp == 1 ? raw[1].y : cp == 2 ? raw[1].z : raw[1].w;
                    const unsigned t2 = cp == 0 ? raw[2].x : cp == 1 ? raw[2].y : cp == 2 ? raw[2].z : raw[2].w, t3 = cp == 0 ? raw[3].x : cp == 1 ? raw[3].y : cp == 2 ? raw[3].z : raw[3].w;
                    u32x2 lo, hi;
                    if (dir) { lo.x = (t3 & 0xffffu) | (t2 << 16); lo.y = (t1 & 0xffffu) | (t0 << 16); hi.x = (t3 >> 16) | (t2 & 0xffff0000u); hi.y = (t1 >> 16) | (t0 & 0xffff0000u); }
                    else { lo.x = (t0 & 0xffffu) | (t1 << 16); lo.y = (t2 & 0xffffu) | (t3 << 16); hi.x = (t0 >> 16) | (t1 & 0xffff0000u); hi.y = (t2 >> 16) | (t3 & 0xffff0000u); }
                    const int ppos = dir ? 60 - 4 * rg : 4 * rg;
                    *(LAS u32x2*)(lds + ML_KT + tsw(c8 + 2 * cp, ppos)) = lo; *(LAS u32x2*)(lds + ML_KT + tsw(c8 + 2 * cp + 1, ppos)) = hi; }
            }
        }
        {
            const int p0 = dir ? 63 - 2 * vrg : 2 * vrg, p1 = dir ? 62 - 2 * vrg : 2 * vrg + 1;
            const float wt0 = __shfl(wt, p0), wt1 = __shfl(wt, p1);
            float v0[8], v1[8];
            v0[0] = bf_lo(vraw[0].x); v0[1] = bf_hi(vraw[0].x); v0[2] = bf_lo(vraw[0].y); v0[3] = bf_hi(vraw[0].y); v0[4] = bf_lo(vraw[0].z); v0[5] = bf_hi(vraw[0].z); v0[6] = bf_lo(vraw[0].w); v0[7] = bf_hi(vraw[0].w);
            v1[0] = bf_lo(vraw[1].x); v1[1] = bf_hi(vraw[1].x); v1[2] = bf_lo(vraw[1].y); v1[3] = bf_hi(vraw[1].y); v1[4] = bf_lo(vraw[1].z); v1[5] = bf_hi(vraw[1].z); v1[6] = bf_lo(vraw[1].w); v1[7] = bf_hi(vraw[1].w);
            const int pw = dir ? p1 : p0;
#pragma unroll
            for (int ch = 0; ch < 8; ++ch) { const int d = vcg * 8 + ch;
                const unsigned a_ = dir ? pack2(v1[ch], v0[ch]) : pack2(v0[ch], v1[ch]);
                const unsigned b_ = dir ? pack2(v1[ch] * wt1, v0[ch] * wt0) : pack2(v0[ch] * wt0, v1[ch] * wt1);
                *(LAS unsigned*)(lds + ML_VT + tsw(d, pw)) = a_; *(LAS unsigned*)(lds + ML_WVT + tsw(d, pw)) = b_; }
        }
        if (c + 1 < 32) ML_ISSUE(pf, c + 1);
        LDS_BARRIER();
        MLT(1)
#pragma unroll
        for (int bb2 = 0; bb2 < 2; ++bb2) {
            const int id = 2 * w + bb2, jb = id >> 2, sb = id & 3; const int j = 16 * jb + l15;
            if (sb <= jb) {
                f32x4 sacc = {0.f, 0.f, 0.f, 0.f};
#pragma unroll
                for (int st = 0; st < 4; ++st) { const bf16x8 kf = *(const LAS bf16x8*)(lds + ML_KS + (16 * sb + l15) * ML_QP + (32 * st + 8 * quad) * 2);
                    const bf16x8 qf = *(const LAS bf16x8*)(lds + ML_QS + j * ML_QP + (32 * st + 8 * quad) * 2);
                    sacc = __builtin_amdgcn_mfma_f32_16x16x32_bf16(kf, qf, sacc, 0, 0, 0); }
                const float aj = __shfl(a, j), mjj = __shfl(mj, j);
                float pv[4]; float rsum = 0.f;
#pragma unroll
                for (int i = 0; i < 4; ++i) { const int sidx = 16 * sb + 4 * quad + i; const float us = __shfl(u, sidx);
                    const float e = fast_exp(fminf(aj + us - mjj, 0.f)) * sacc[i]; pv[i] = (sidx <= j) ? e : 0.f; rsum += pv[i]; }
                rsum += __shfl_xor(rsum, 16); rsum += __shfl_xor(rsum, 32);
                if (quad == 0) ROWSUM[sb * 64 + j] = rsum;
                u32x2 wv; wv.x = pack2(pv[0], pv[1]); wv.y = pack2(pv[2], pv[3]);
                *(LAS u32x2*)(lds + ML_PS + j * ML_TP + (16 * sb + 4 * quad) * 2) = wv;
            } else {
                *(LAS u32x2*)(lds + ML_PS + j * ML_TP + (16 * sb + 4 * quad) * 2) = (u32x2){0u, 0u}; if (quad == 0) ROWSUM[sb * 64 + j] = 0.f;
            }
        }
        {
            const int j = tid >> 3, eo = (tid & 7) * 16;
            const u32x4 q0 = *(const LAS u32x4*)(lds + ML_QS + j * ML_QP + eo * 2), q1 = *(const LAS u32x4*)(lds + ML_QS + j * ML_QP + eo * 2 + 16);
            const LAS float* nv = NV + par * 128 + eo;
            const f32x4 n0 = *(const LAS f32x4*)(nv), n1 = *(const LAS f32x4*)(nv + 4), n2 = *(const LAS f32x4*)(nv + 8), n3 = *(const LAS f32x4*)(nv + 12);
            float s = bf_lo(q0.x) * n0[0] + bf_hi(q0.x) * n0[1] + bf_lo(q0.y) * n0[2] + bf_hi(q0.y) * n0[3] + bf_lo(q0.z) * n1[0] + bf_hi(q0.z) * n1[1] + bf_lo(q0.w) * n1[2] + bf_hi(q0.w) * n1[3]
                    + bf_lo(q1.x) * n2[0] + bf_hi(q1.x) * n2[1] + bf_lo(q1.y) * n2[2] + bf_hi(q1.y) * n2[3] + bf_lo(q1.z) * n3[0] + bf_hi(q1.z) * n3[1] + bf_lo(q1.w) * n3[2] + bf_hi(q1.w) * n3[3];
            s += __shfl_xor(s, 1); s += __shfl_xor(s, 2); s += __shfl_xor(s, 4);
            if ((tid & 7) == 0) DENI[j] = s;
        }
        f32x4 acc[4];
#pragma unroll
        for (int t4 = 0; t4 < 4; ++t4) acc[t4] = (f32x4){0.f, 0.f, 0.f, 0.f};
#pragma unroll
        for (int st = 0; st < 4; ++st) {
            union { bf16x8 v; unsigned uu[4]; } ca;
            ca.uu[0] = pack2(C[2 * st][0], C[2 * st][1]); ca.uu[1] = pack2(C[2 * st][2], C[2 * st][3]); ca.uu[2] = pack2(C[2 * st + 1][0], C[2 * st + 1][1]); ca.uu[3] = pack2(C[2 * st + 1][2], C[2 * st + 1][3]);
#pragma unroll
            for (int t4 = 0; t4 < 4; ++t4) { const LAS unsigned char* qp = lds + ML_QS + (16 * t4 + l15) * ML_QP + (32 * st + 4 * quad) * 2;
                union { bf16x8 v; s16x4 hh[2]; } qb; qb.hh[0] = *(const LAS s16x4*)qp; qb.hh[1] = *(const LAS s16x4*)(qp + 32);
                acc[t4] = __builtin_amdgcn_mfma_f32_16x16x32_bf16(ca.v, qb.v, acc[t4], 0, 0, 0); }
        }
        { const int e = tid & 127, qq = tid >> 7; float s = 0.f;
#pragma unroll
            for (int q = 0; q < 2; ++q) { const int pos = 16 * qq + 8 * q; const u32x4 kv = *(const LAS u32x4*)(lds + ML_KT + tsw(e, pos)); const f32x4 wa = *(const LAS f32x4*)(WTS + pos), wb = *(const LAS f32x4*)(WTS + pos + 4);
                s += bf_lo(kv.x) * wa[0] + bf_hi(kv.x) * wa[1] + bf_lo(kv.y) * wa[2] + bf_hi(kv.y) * wa[3] + bf_lo(kv.z) * wb[0] + bf_hi(kv.z) * wb[1] + bf_lo(kv.w) * wb[2] + bf_hi(kv.w) * wb[3]; }
            NVP[qq * 128 + e] = s; }
#pragma unroll
        for (int eb = 0; eb < 8; ++eb) { C[eb] = C[eb] * decay;
#pragma unroll
            for (int ks = 0; ks < 2; ++ks) { const bf16x8 ka = *(const LAS bf16x8*)(lds + ML_KT + tsw(16 * eb + l15, 32 * ks + 8 * quad));
                const bf16x8 vb = *(const LAS bf16x8*)(lds + ML_WVT + tsw(16 * w + l15, 32 * ks + 8 * quad));
                C[eb] = __builtin_amdgcn_mfma_f32_16x16x32_bf16(ka, vb, C[eb], 0, 0, 0); } }
        LDS_BARRIER();
        MLT(2)
        if (tid < 128) NV[(par ^ 1) * 128 + tid] = decay * NV[par * 128 + tid] + ((NVP[tid] + NVP[128 + tid]) + (NVP[256 + tid] + NVP[384 + tid]));
#pragma unroll
        for (int t4 = 0; t4 < 4; ++t4) { const int tp = 16 * t4 + l15; const float iw = __shfl(inter_w, tp); const float em = __shfl(emj, tp);
            f32x4 r = acc[t4] * iw;
#pragma unroll
            for (int ks = 0; ks < 2; ++ks) { const bf16x8 va = *(const LAS bf16x8*)(lds + ML_VT + tsw(16 * w + l15, 32 * ks + 8 * quad));
                const bf16x8 pb = *(const LAS bf16x8*)(lds + ML_PS + tp * ML_TP + (32 * ks + 8 * quad) * 2);
                r = __builtin_amdgcn_mfma_f32_16x16x32_bf16(va, pb, r, 0, 0, 0); }
            const float den = ((ROWSUM[tp] + ROWSUM[64 + tp]) + (ROWSUM[128 + tp] + ROWSUM[192 + tp])) + iw * DENI[tp]; const float inv = 1.0f / fmaxf(fabsf(den), em);
            const int t = dir ? tb + 63 - tp : tb + tp;
            { const f32x4 rr = r * inv; u32x2 ov; ov.x = pack2(rr[0], rr[1]); ov.y = pack2(rr[2], rr[3]); *(u32x2*)(HDIR + (brow + t) * 512 + h * 128 + 16 * w + 4 * quad) = ov; } }
        m_run = m_new;
        LDS_BARRIER();
      }
    }
#undef ML_ISSUE
    return tacc;
}

__device__ __forceinline__ void unpack8(const u32x4 v, float* f) { f[0] = bf_lo(v.x); f[1] = bf_hi(v.x); f[2] = bf_lo(v.y); f[3] = bf_hi(v.y); f[4] = bf_lo(v.z); f[5] = bf_hi(v.z); f[6] = bf_lo(v.w); f[7] = bf_hi(v.w); }
__device__ __forceinline__ void p2b_combine(const Params& P, int G) {
    int tid_ = threadIdx.x; asm volatile("" : "+v"(tid_)); const int tid = tid_, lane = tid & 63, wave = tid >> 6; const int gw = blockIdx.x * 8 + wave, NGW = G * 8;
    const bf16_t* HF = (const bf16_t*)((unsigned char*)P.out + DO_HFW); const bf16_t* HB = (const bf16_t*)((unsigned char*)P.out + DO_HBW);
    bf16_t* O = (bf16_t*)(P.ws + WS_MLO); const float* ng = P.in[8];
    float gg[8]; { const f32x4 g0 = *(const f32x4*)(ng + 8 * lane), g1 = *(const f32x4*)(ng + 8 * lane + 4); gg[0] = g0[0]; gg[1] = g0[1]; gg[2] = g0[2]; gg[3] = g0[3]; gg[4] = g1[0]; gg[5] = g1[1]; gg[6] = g1[2]; gg[7] = g1[3]; }
    for (int row = gw; row < NTOK; row += 2 * NGW) {
        const int row2 = row + NGW; const bool has2 = row2 < NTOK;
        const size_t off = (size_t)row * 512 + 8 * lane, off2 = (size_t)(has2 ? row2 : row) * 512 + 8 * lane;
        const u32x4 fa = *(const u32x4*)(HF + off), fb = *(const u32x4*)(HB + off), fo = *(const u32x4*)(O + off);
        const u32x4 fa2 = *(const u32x4*)(HF + off2), fb2 = *(const u32x4*)(HB + off2), fo2 = *(const u32x4*)(O + off2);
#pragma unroll
        for (int rr = 0; rr < 2; ++rr) {
            float a[8], bb[8], o[8]; unpack8(rr ? fa2 : fa, a); unpack8(rr ? fb2 : fb, bb); unpack8(rr ? fo2 : fo, o);
            float ss = 0.f;
#pragma unroll
            for (int i = 0; i < 8; ++i) { a[i] += bb[i]; ss += a[i] * a[i]; }
            ss += __shfl_xor(ss, 1); ss += __shfl_xor(ss, 2); ss += __shfl_xor(ss, 4); ss += __shfl_xor(ss, 8);
            const float rstd = rsqrtf(ss * (1.0f / 128.0f) + EPS);
#pragma unroll
            for (int i = 0; i < 8; ++i) a[i] = a[i] * rstd * gg[i] * sigmoidf_(o[i]);
            u32x4 wv; wv.x = pack2(a[0], a[1]); wv.y = pack2(a[2], a[3]); wv.z = pack2(a[4], a[5]); wv.w = pack2(a[6], a[7]);
            if (rr == 0 || has2) *(u32x4*)(O + (rr ? off2 : off)) = wv;
        }
    }
}
__device__ __forceinline__ void p1b_conv(const Params& P, int G) {
    const bf16_t* MQ = (const bf16_t*)(P.ws + WS_MLQ); const bf16_t* MK = (const bf16_t*)(P.ws + WS_MLK);
    bf16_t* QC = (bf16_t*)((unsigned char*)P.out + DO_QC); bf16_t* KC = (bf16_t*)((unsigned char*)P.out + DO_KC);
    const float* cw = P.in[6]; const float* cb = P.in[7];
    const int nb0 = G >= 64 ? 32 : 0; if ((int)blockIdx.x < nb0) return;
    const int nth = (G - nb0) * 512;
    for (int task = ((int)blockIdx.x - nb0) * 512 + threadIdx.x; task < 2048 * 128; task += nth) {
        const int rgid = task >> 7, cgid = task & 127; const int row0 = 8 * rgid, ch0 = 8 * cgid; const int sp0 = row0 & 2047;
        const bool isk = ch0 >= 512; const float qs = isk ? 1.0f : 0.08838834764831845f;
        float w0[8], w1[8], w2[8], bb[8];
#pragma unroll
        for (int q = 0; q < 2; ++q) { const f32x4 t0 = *(const f32x4*)(cw + ch0 + 4 * q), t1 = *(const f32x4*)(cw + 1024 + ch0 + 4 * q), t2 = *(const f32x4*)(cw + 2048 + ch0 + 4 * q), t3 = *(const f32x4*)(cb + ch0 + 4 * q);
#pragma unroll
            for (int i = 0; i < 4; ++i) { w0[4 * q + i] = t0[i]; w1[4 * q + i] = t1[i]; w2[4 * q + i] = t2[i]; bb[4 * q + i] = t3[i]; } }
        const bf16_t* ap = (isk ? MK + (ch0 - 512) : MQ + ch0) + (size_t)row0 * 512; bf16_t* op = (isk ? KC + (ch0 - 512) : QC + ch0) + (size_t)row0 * 512;
        u32x4 rw[10];
#pragma unroll
        for (int i = 0; i < 10; ++i) { const int sp = sp0 - 1 + i; rw[i] = (sp >= 0 && sp < 2048) ? *(const u32x4*)(ap + (ptrdiff_t)(i - 1) * 512) : (u32x4){0u, 0u, 0u, 0u}; }
        float prev[8], cur[8], nxt[8]; unpack8(rw[0], prev); unpack8(rw[1], cur);
#pragma unroll
        for (int i = 0; i < 8; ++i) {
            unpack8(rw[i + 2], nxt);
            float o[8];
#pragma unroll
            for (int q = 0; q < 8; ++q) { const float y = w0[q] * prev[q] + w1[q] * cur[q] + w2[q] * nxt[q] + bb[q]; o[q] = y * sigmoidf_(y) * qs; prev[q] = cur[q]; cur[q] = nxt[q]; }
            u32x4 wv; wv.x = pack2(o[0], o[1]); wv.y = pack2(o[2], o[3]); wv.z = pack2(o[4], o[5]); wv.w = pack2(o[6], o[7]);
            *(u32x4*)(op + (size_t)i * 512) = wv;
        }
    }
}
__device__ __forceinline__ void p5b_glu(const Params& P, int G) {
    const bf16_t* A = (const bf16_t*)(P.ws + WS_ABUF); bf16_t* U = (bf16_t*)(P.ws + WS_UBUF);
    const float* cw = P.in[19]; const float* cb = P.in[20];
    const int nth = G * 512;
    for (int task = blockIdx.x * 512 + threadIdx.x; task < 2048 * 352; task += nth) {
        const int rgid = task / 352, cgid = task - rgid * 352; const int row0 = 8 * rgid, ch0 = 8 * cgid; const int sp0 = row0 & 2047;
        float w0[8], w1[8], w2[8], bb[8];
#pragma unroll
        for (int q = 0; q < 2; ++q) { const f32x4 t0 = *(const f32x4*)(cw + ch0 + 4 * q), t1 = *(const f32x4*)(cw + 2816 + ch0 + 4 * q), t2 = *(const f32x4*)(cw + 5632 + ch0 + 4 * q), t3 = *(const f32x4*)(cb + ch0 + 4 * q);
#pragma unroll
            for (int i = 0; i < 4; ++i) { w0[4 * q + i] = t0[i]; w1[4 * q + i] = t1[i]; w2[4 * q + i] = t2[i]; bb[4 * q + i] = t3[i]; } }
        const bf16_t* ap = A + (size_t)row0 * 2816 + ch0; bf16_t* up = U + (size_t)row0 * 2816 + ch0;
        u32x4 ra[10], ru[8];
#pragma unroll
        for (int i = 0; i < 10; ++i) { const int sp = sp0 - 1 + i; ra[i] = (sp >= 0 && sp < 2048) ? *(const u32x4*)(ap + (ptrdiff_t)(i - 1) * 2816) : (u32x4){0u, 0u, 0u, 0u}; }
#pragma unroll
        for (int i = 0; i < 8; ++i) ru[i] = *(const u32x4*)(up + (size_t)i * 2816);
        float prev[8], cur[8], nxt[8]; unpack8(ra[0], prev); unpack8(ra[1], cur);
#pragma unroll
        for (int i = 0; i < 8; ++i) {
            unpack8(ra[i + 2], nxt);
            float uu[8]; unpack8(ru[i], uu);
            float o[8];
#pragma unroll
            for (int q = 0; q < 8; ++q) { const float y = w0[q] * prev[q] + w1[q] * cur[q] + w2[q] * nxt[q] + bb[q];
                const float z = 1.5957691216057308f * (y + 0.044715f * y * y * y);
                o[q] = y * sigmoidf_(z) * uu[q]; prev[q] = cur[q]; cur[q] = nxt[q]; }
            u32x4 wv; wv.x = pack2(o[0], o[1]); wv.y = pack2(o[2], o[3]); wv.z = pack2(o[4], o[5]); wv.w = pack2(o[6], o[7]);
            *(u32x4*)(up + (size_t)i * 2816) = wv;
        }
    }
}
__device__ __forceinline__ void p7_final(const Params& P, int G) {
    int tid_ = threadIdx.x; asm volatile("" : "+v"(tid_)); const int tid = tid_, lane = tid & 63, wave = tid >> 6; const int gw = blockIdx.x * 8 + wave, NGW = G * 8;
    const float* gv = P.in[22];
    for (int m = gw; m < NTOK; m += NGW) {
        f32x4* row = (f32x4*)(P.out + (size_t)m * 1024);
        f32x4 v[4]; float s = 0.f;
#pragma unroll
        for (int j = 0; j < 4; ++j) { v[j] = row[64 * j + lane]; s += (v[j][0] * v[j][0] + v[j][1] * v[j][1]) + (v[j][2] * v[j][2] + v[j][3] * v[j][3]); }
        const float rstd = rsqrtf(wave_sum(s) * (1.0f / 1024.0f) + EPS);
#pragma unroll
        for (int j = 0; j < 4; ++j) { const f32x4 g4 = ((const f32x4*)gv)[64 * j + lane]; row[64 * j + lane] = v[j] * rstd * g4; }
    }
}


#define XB_TMO      128
#define XB_XCNT(j)  (256  + 64 * (j))
#define XB_XSUB(j)  (1280 + 64 * (j))
#define XB_XGEN(j)  (2304 + 64 * (j))
#define XB_TOP      3328
#define XB_TOPGEN   3392
#define XCD_BAR_WORDS 3456
#define XB_SPIN_CAP (1u << 18)

__device__ __forceinline__ unsigned xb_ld(unsigned* p)              { return __hip_atomic_load(p, __ATOMIC_RELAXED, __HIP_MEMORY_SCOPE_AGENT); }
__device__ __forceinline__ unsigned xb_add(unsigned* p, unsigned v) { return __hip_atomic_fetch_add(p, v, __ATOMIC_RELAXED, __HIP_MEMORY_SCOPE_AGENT); }
__device__ __forceinline__ unsigned xb_xcc_id() { return (unsigned)__builtin_amdgcn_s_getreg((3 << 11) | 20) & 0xFu; }
#define XB_SPIN(cond, bar) do { unsigned _sp = 0; while (cond) { __builtin_amdgcn_s_sleep(1); \
    if ((++_sp & 255u) == 0u) { if (xb_ld(&(bar)[XB_TMO])) break; if (_sp > XB_SPIN_CAP) { atomicAdd(&(bar)[XB_TMO], 1u); break; } } } } while (0)

struct XcdBarrier {
    unsigned* bar; unsigned x;
    volatile LAS unsigned* st;
};

__device__ __forceinline__ XcdBarrier xcd_barrier_post(unsigned* bar, volatile LAS unsigned* st) {
    XcdBarrier b; b.bar = bar; b.x = xb_xcc_id(); b.st = st;
    if (threadIdx.x == 0) (void)xb_add(&bar[XB_XCNT(b.x)], 1u);
    return b;
}
__device__ __forceinline__ void xcd_barrier_complete(unsigned* bar, unsigned x, unsigned& nloc, unsigned& nx) {
    const unsigned G = gridDim.x * gridDim.y * gridDim.z;
    unsigned sum, cnt, mine, sp = 0u;
    for (;;) {
        sum = 0u; cnt = 0u; mine = 0u;
#pragma unroll
        for (unsigned j = 0; j < 16; ++j) { const unsigned c = xb_ld(&bar[XB_XCNT(j)]); sum += c; cnt += (c > 0u) ? 1u : 0u; mine = (j == x) ? c : mine; }
        if (sum == G) break;
        __builtin_amdgcn_s_sleep(1);
        if ((++sp & 255u) == 0u) { if (xb_ld(&bar[XB_TMO])) break; if (sp > XB_SPIN_CAP) { atomicAdd(&bar[XB_TMO], 1u); break; } }
    }
    nloc = mine > 0u ? mine : 1u; nx = cnt > 0u ? cnt : 1u;
}

__device__ __forceinline__ void xcd_barrier(const XcdBarrier& b) {
    asm volatile("s_waitcnt vmcnt(0)" ::: "memory");
    __syncthreads();
    if (threadIdx.x == 0) {
        unsigned* bar = b.bar;
        __builtin_amdgcn_s_waitcnt(0);
        unsigned nloc = b.st[0], nx = b.st[1];
        if (nloc == 0u) { xcd_barrier_complete(bar, b.x, nloc, nx); b.st[0] = nloc; b.st[1] = nx; }
        const unsigned old = xb_add(&bar[XB_XSUB(b.x)], 1u);
        const unsigned gen = old / nloc;
        if (old + 1u == (gen + 1u) * nloc) {
            __builtin_amdgcn_fence(__ATOMIC_RELEASE, "agent");
            asm volatile("s_waitcnt vmcnt(0)" ::: "memory");
            const unsigned og = xb_add(&bar[XB_TOP], 1u);
            const unsigned tg = og / nx;
            if (og + 1u == (tg + 1u) * nx) xb_add(&bar[XB_TOPGEN], 1u);
            else XB_SPIN(xb_ld(&bar[XB_TOPGEN]) == tg, bar);
            __builtin_amdgcn_fence(__ATOMIC_ACQUIRE, "agent");
            xb_add(&bar[XB_XGEN(b.x)], 1u);
            asm volatile("s_waitcnt vmcnt(0)" ::: "memory");
        } else {
            XB_SPIN(xb_ld(&bar[XB_XGEN(b.x)]) == gen, bar);
            __builtin_amdgcn_fence(__ATOMIC_ACQUIRE, "agent");
            asm volatile("s_waitcnt vmcnt(0)" ::: "memory");
        }
    }
    __syncthreads();
}

#ifndef DBG_CUT
#define DBG_CUT 0
#endif
#ifndef DBG_NOOUT
#define DBG_NOOUT 0
#endif
__device__ __forceinline__ void dbg_dump(const Params& P, int G) {
    const unsigned short* w16 = (const unsigned short*)P.ws; unsigned* o = (unsigned*)P.out;
    for (size_t i = (size_t)blockIdx.x * 512 + threadIdx.x; i < (size_t)NTOK * 1024; i += (size_t)G * 512) {
        const unsigned ob = (DBG_CUT >= 2 && !DBG_NOOUT) ? o[i] : 0u; float s = (float)(ob & 0xffffu) + (float)(ob >> 16);
        for (int k = 0; k < 8; ++k) s += (float)w16[i + (size_t)k * NTOK * 1024];
        P.out[i] = s; }
}
#define GRID_SYNC() xcd_barrier(xbar)
#ifndef TIME_PHASE
#define TIME_PHASE -1
#endif
#define TSTART(n) if (TIME_PHASE == (n)) tt0 = __builtin_amdgcn_s_memrealtime();
#define TEND(n) if (TIME_PHASE == (n)) tt1 = __builtin_amdgcn_s_memrealtime();
#define CUT(n) if (DBG_CUT == (n)) { GRID_SYNC(); dbg_dump(P, G); return; }
__device__ __forceinline__ void sub_barrier(unsigned* cnt, unsigned n) {
    asm volatile("s_waitcnt vmcnt(0)" ::: "memory"); __syncthreads();
    if (threadIdx.x == 0) {
        asm volatile("buffer_wbl2 sc1\n\ts_waitcnt vmcnt(0)" ::: "memory");
        __hip_atomic_fetch_add(cnt, 1u, __ATOMIC_RELAXED, __HIP_MEMORY_SCOPE_AGENT);
        unsigned sp = 0; while (__hip_atomic_load(cnt, __ATOMIC_RELAXED, __HIP_MEMORY_SCOPE_AGENT) < n) { __builtin_amdgcn_s_sleep(4); if (++sp > (1u << 22)) break; }
        __builtin_amdgcn_fence(__ATOMIC_ACQUIRE, "agent"); asm volatile("s_waitcnt vmcnt(0)" ::: "memory");
    }
    __syncthreads();
}
#ifndef PH_LAST
#define PH_LAST 99
#endif
__global__ void __launch_bounds__(512, 2) mega(Params P) {
    extern __shared__ __attribute__((aligned(16))) unsigned char smem[];
    LAS unsigned char* lds = (LAS unsigned char*)smem;
    cg::grid_group grid = cg::this_grid();
    const int G = gridDim.x, bid = blockIdx.x;
    unsigned char* ws = P.ws; unsigned char* dob = (unsigned char*)P.out;
#ifndef PHMASK
#define PHMASK 0xFFFF
#endif
#define PH(n) if ((PHMASK >> (n)) & 1)
    unsigned long long tt0 = 0, tt1 = 0;
    if (threadIdx.x < 2) ((LAS unsigned*)(lds + LDS_XB_OFF))[threadIdx.x] = 0u;
    __syncthreads();
    XcdBarrier xbar = xcd_barrier_post((unsigned*)(ws + WS_XBAR), (volatile LAS unsigned*)(lds + LDS_XB_OFF));
    if (P.ws == nullptr) grid.sync();
    TSTART(0)
    PH(0) p0_prologue(lds, P, G);
    GRID_SYNC();
    TEND(0) TSTART(1)
    PH(1) { pg8::Gemm g{(const bf16_t*)(dob + DO_H), (const bf16_t*)(dob + DO_WINT), NTOK, INW_P, 1024}; pg8::StaticOrder S; S.init(NTOK, INW_P, G, bid);
      EpiProj E{ws, P.in[12], lds}; pg8::gemm_phase<EpiProj, pg8::StaticOrder, true, true>(lds, g, S, E); }
    GRID_SYNC();
    TEND(1) TSTART(2)
    CUT(1)
    PH(2) { pg8::Gemm g{(const bf16_t*)(dob + DO_MEMN), (const bf16_t*)(dob + DO_WMEMKVT), NMEM, 1024, 1024}; pg8::StaticOrder S; S.init(NMEM, 1024, G, bid);
      EpiMemKV E{ws, lds}; pg8::gemm_phase<EpiMemKV, pg8::StaticOrder, true, true>(lds, g, S, E); }
    p1b_conv(P, G);
    GRID_SYNC();
    { if (TIME_PHASE == 10 || TIME_PHASE == 11) tt0 = __builtin_amdgcn_s_memrealtime();
      if (G >= 128) {
          if (bid < 64) { PH(3) { const unsigned long long r_ = ml_chain(lds, P, bid); if (TIME_PHASE >= 20 && TIME_PHASE < 24) { tt0 = 0; tt1 = r_; } } }
          else { { const int wv_ = (int)(threadIdx.x >> 6); weight_items(lds, P, WI_EARLY, WI_ALL, (bid - 64) * 8 + wv_, (G - 64) * 8, wv_, (int)(threadIdx.x & 63)); __syncthreads(); }
              for (int u = bid - 64; u < 1280; u += G - 64) { if (u < 1024) { PH(4) na_unit(lds, ws, P.in[9], u); } else { PH(5) xa_unit(lds, ws, u - 1024); } }
              sub_barrier((unsigned*)(ws + WS_SUBCNT), (unsigned)(G - 64));
              pg8::Gemm g{(const bf16_t*)(ws + WS_MLO), (const bf16_t*)(ws + WS_WBR), 3 * NTOK, 3 * 1024, 512}; BranchOrder S; S.init(G, bid, 2, G - 64, bid - 64);
              EpiBranchAcc E{(bf16_t*)(ws + WS_G), (bf16_t*)(ws + WS_MERGED)};
              pg8::gemm_phase<EpiBranchAcc, BranchOrder, true, true>(lds, g, S, E); }
      } else {
          for (int u = bid; u < 1344; u += G) { if (u < 64) { PH(3) (void)ml_chain(lds, P, u); } else if (u < 1088) { PH(4) na_unit(lds, ws, P.in[9], u - 64); } else { PH(5) xa_unit(lds, ws, u - 1088); } }
      } }
    if ((TIME_PHASE == 10 && bid < 64) || (TIME_PHASE == 11 && bid >= 64)) tt1 = __builtin_amdgcn_s_memrealtime(); else if (TIME_PHASE == 10 || TIME_PHASE == 11) tt1 = tt0;
    GRID_SYNC();
    TEND(2) TSTART(3)
    PH(6) p2b_combine(P, G);
    GRID_SYNC();
    TEND(3) TSTART(4)
    CUT(2)
    PH(7) {
      pg8::Gemm g{(const bf16_t*)(ws + WS_MLO), (const bf16_t*)(ws + WS_WBR), 3 * NTOK, 3 * 1024, 512}; BranchOrder S; S.init(G, bid, G >= 128 ? 0 : 1, 0, 0);
      EpiBranchAcc E{(bf16_t*)(ws + WS_G), (bf16_t*)(ws + WS_MERGED)};
      pg8::gemm_phase<EpiBranchAcc, BranchOrder, true, true>(lds, g, S, E); }
    GRID_SYNC();
    TEND(4) TSTART(5)
    CUT(3)
    PH(8) { pg8::Gemm g{(const bf16_t*)(ws + WS_MERGED), (const bf16_t*)(ws + WS_WOUT), NTOK, 1024, 1024}; pg8::StaticOrder S; S.init(NTOK, 1024, G, bid);
      EpiOut E{P.in[0], P.out, (bf16_t*)(ws + WS_X1B), (float*)(ws + WS_RSS1)}; pg8::gemm_phase<EpiOut, pg8::StaticOrder, true, true>(lds, g, S, E); }
    GRID_SYNC();
    TEND(5) TSTART(6)
    CUT(4)
    PH(9) { pg8::Gemm g{(const bf16_t*)(ws + WS_X1B), (const bf16_t*)(ws + WS_WUP), NTOK, DFF, 1024}; pg8::StaticOrder S; S.init(NTOK, DFF, G, bid);
      EpiUp E{(const float*)(ws + WS_RSS1), (bf16_t*)(ws + WS_ABUF), (bf16_t*)(ws + WS_UBUF)}; pg8::gemm_phase<EpiUp, pg8::StaticOrder, true, true>(lds, g, S, E); }
    GRID_SYNC();
    TEND(6) TSTART(7)
    CUT(5)
    PH(10) { pg8::Gemm g{(const bf16_t*)(ws + WS_X1B), (const bf16_t*)(ws + WS_WUP) + (size_t)DFF * 1024, NTOK, DFF, 1024}; pg8::StaticOrder S; S.init(NTOK, DFF, G, bid);
      EpiUpGlu E{(const float*)(ws + WS_RSS1), (const bf16_t*)(ws + WS_ABUF), (bf16_t*)(ws + WS_UBUF), P.in[19], P.in[20]}; pg8::gemm_phase<EpiUpGlu, pg8::StaticOrder, true, true>(lds, g, S, E); }
    GRID_SYNC();
    TEND(7) TSTART(8)
    CUT(6)
    PH(11) { pg8::Gemm g{(const bf16_t*)(ws + WS_UBUF), (const bf16_t*)(ws + WS_WDOWN), NTOK, 1024, DFF}; pg8::StaticOrder S; S.init(NTOK, 1024, G, bid);
      if (G == 256) { EpiDownNorm E{(const bf16_t*)(ws + WS_X1B), P.in[22], (float*)(ws + WS_SLOTS), (unsigned*)(ws + WS_PCNT), P.out}; pg8::gemm_phase<EpiDownNorm, pg8::StaticOrder, false, true>(lds, g, S, E); }
      else { EpiDown E{(const bf16_t*)(ws + WS_X1B), P.out}; pg8::gemm_phase<EpiDown, pg8::StaticOrder, true, true>(lds, g, S, E); } }
    if (G != 256) { GRID_SYNC(); p7_final(P, G); }
    TEND(9)
#ifdef EXTRA_SYNCS
    for (int i_ = 0; i_ < EXTRA_SYNCS; ++i_) GRID_SYNC();
#endif
    if (TIME_PHASE >= 0) { const unsigned long long ts = __builtin_amdgcn_s_memrealtime(); while (__builtin_amdgcn_s_memrealtime() - ts < (tt1 - tt0)) __builtin_amdgcn_s_sleep(8); }
}

extern "C" void kernel_launch(void* const* d_in, const int* in_sizes, int n_in, void* d_out, int out_size, void* d_ws, size_t ws_size, hipStream_t stream) {
    static int grid = 0;
    if (grid == 0) {
        if (n_in != 23 || out_size != NTOK * DM || ws_size < WS_NEED) { fprintf(stderr, "kernel_launch: unexpected shapes (n_in %d out %d ws %zu)\n", n_in, out_size, ws_size); grid = -1; return; }
        int dev = 0, cus = 0, per_cu = 0;
        hipGetDevice(&dev); hipDeviceGetAttribute(&cus, hipDeviceAttributeMultiprocessorCount, dev);
        hipFuncSetAttribute((const void*)mega, hipFuncAttributeMaxDynamicSharedMemorySize, LDS_BYTES);
        hipOccupancyMaxActiveBlocksPerMultiprocessor(&per_cu, (const void*)mega, 512, LDS_BYTES);
        if (per_cu < 1) { fprintf(stderr, "kernel_launch: occupancy query says %d blocks per CU\n", per_cu); per_cu = 1; }
        grid = cus * 1;
        (void)hipGetLastError();
    }
    if (grid < 0) return;
    Params p{};
    for (int i = 0; i < 23; ++i) p.in[i] = (const float*)d_in[i];
    p.out = (float*)d_out; p.ws = (unsigned char*)d_ws;
    (void)hipMemsetAsync((char*)d_ws + WS_XBAR, 0, WS_CTLBYTES, stream);
    void* args[] = {&p};
    hipError_t e = hipLaunchCooperativeKernel((const void*)mega, dim3(grid), dim3(512), args, LDS_BYTES, stream);
    if (e != hipSuccess) fprintf(stderr, "cooperative launch failed: %s (grid %d)\n", hipGetErrorString(e), grid);
}
```

```cpp
#include <hip/hip_runtime.h>
#include <hip/hip_cooperative_groups.h>
#include <cstdio>
#include <cstdint>
namespace cg = cooperative_groups;

#define LAS __attribute__((address_space(3)))
typedef unsigned short bf16_t;
typedef short bf16x8 __attribute__((ext_vector_type(8)));
typedef short s16x4 __attribute__((ext_vector_type(4)));
typedef float f32x4 __attribute__((ext_vector_type(4)));
typedef float f32x16 __attribute__((ext_vector_type(16)));
typedef unsigned u32x4 __attribute__((ext_vector_type(4)));
typedef unsigned u32x2 __attribute__((ext_vector_type(2)));

typedef float f32x2_t __attribute__((ext_vector_type(2))); typedef __bf16 bf16x2_t __attribute__((ext_vector_type(2)));
__device__ __forceinline__ unsigned cvt_pk_bf16(float lo, float hi) { f32x2_t v = {lo, hi}; bf16x2_t b = __builtin_convertvector(v, bf16x2_t); return __builtin_bit_cast(unsigned, b); }
__device__ __forceinline__ float bf_lo(unsigned w) { return __uint_as_float(w << 16); }
__device__ __forceinline__ float bf_hi(unsigned w) { return __uint_as_float(w & 0xffff0000u); }
__device__ __forceinline__ float fast_exp2(float x) { return __builtin_amdgcn_exp2f(x); }
__device__ __forceinline__ float fast_exp(float x) { return __builtin_amdgcn_exp2f(x * 1.4426950408889634f); }
__device__ __forceinline__ float fast_rcp(float x) { return __builtin_amdgcn_rcpf(x); }
__device__ __forceinline__ float sigmoidf_(float x) { return fast_rcp(1.0f + fast_exp(-x)); }
#define LDS_WAIT() asm volatile("s_waitcnt lgkmcnt(0)" ::: "memory")

namespace pg8 {
#define PG8_LAS __attribute__((address_space(3)))
constexpr int BM = 256, BK = 64, HALF = 128, HTB = HALF * BK * 2, STAGE_BYTES = 8 * HTB, NXCD = 8, WGM = 8;
__host__ __device__ __forceinline__ int lds_byte(int r, int c) { const int st = (r >> 4) * 2 + (c >> 5), rr = r & 15, cc = c & 31, ob = rr * 64 + cc * 2; return st * 1024 + (ob ^ (((ob >> 9) & 1) << 5)); }
__host__ __device__ __forceinline__ void stage_rc(int b, int& R, int& C) { const int st = b / 1024, sb = b % 1024, swz = sb ^ (((sb >> 9) & 1) << 5); R = (st >> 1) * 16 + swz / 64; C = (st & 1) * 32 + (swz % 64) / 2; }
__host__ __device__ __forceinline__ int perm32(int rho) { const int n = rho >> 4, i = rho & 15; return 8 * (i >> 2) + 4 * n + (i & 3); }
struct Unit { int pm, pn; };
struct Gemm { const bf16_t* A; const bf16_t* Bt; int M, N, K; };
struct StaticOrder {
    int nM, nN, nwg, G, c;
    __host__ __device__ void init(int M, int N, int G_, int c_) { nM = M / BM; nN = N / BM; nwg = nM * nN; G = G_; c = c_; }
    __host__ __device__ bool next(int i, Unit& u) const {
        const long L = (long)i * G + c; if (L >= nwg) return false;
        int wgid = (int)L; { const int q = nwg / NXCD, r = nwg % NXCD, xcd = wgid % NXCD, off = wgid / NXCD; wgid = (xcd < r ? xcd * (q + 1) : r * (q + 1) + (xcd - r) * q) + off; }
        const int nig = WGM * nN, gid = wgid / nig, fm = gid * WGM, gsz = (nM - fm) < WGM ? (nM - fm) : WGM;
        u.pm = fm + ((wgid % nig) % gsz); u.pn = (wgid % nig) / gsz; return true;
    }
    __device__ __forceinline__ void a_ready(const Unit&) const {}
    __device__ __forceinline__ void done(const Unit&) const {}
};
template <class Epi, class Sched, bool ALIGN_EPI = false, bool SP2 = false>
__device__ __forceinline__ void gemm_phase(PG8_LAS unsigned char* lds, const Gemm g, const Sched& S, const Epi& E) {
    int tid_ = threadIdx.x; asm volatile("" : "+v"(tid_));
    const int tid = tid_, wid = __builtin_amdgcn_readfirstlane(tid >> 6), lane = tid & 63, wr = wid >> 2, wc = wid & 3, fr = lane & 15, fq = lane >> 4;
    const int K = g.K, nt = K / BK;
    unsigned voffA[2], voffB[2];
#pragma unroll
    for (int i = 0; i < 2; ++i) { int R, C; stage_rc(tid * 16 + i * 8192, R, C); const int Rb = Epi::PERM ? ((R & ~31) + perm32(R & 31)) : R;
        voffA[i] = (unsigned)(R * K + C) * 2u; voffB[i] = (unsigned)(Rb * K + C) * 2u; }
    const size_t kstep = (size_t)(BK * 2);
    const size_t hstep = (size_t)HALF * K * 2;
    const size_t tstep = 2 * hstep;
    const unsigned ldsw = (unsigned)wid * 1024u;
    const int aoff = lds_byte(wr * 64 + fr, fq * 8), boff = lds_byte(wc * 32 + fr, fq * 8);
#define PG8_SA(b, h) (((b) * 2 + (h)) * HTB)
#define PG8_SB(b, h) ((4 + (b) * 2 + (h)) * HTB)
#define PG8_STAGE(bufoff, gbase, voff) do { _Pragma("unroll") for (int _i = 0; _i < 2; ++_i) \
        __builtin_amdgcn_global_load_lds((const unsigned*)((const char*)(gbase) + (voff)[_i]), (PG8_LAS unsigned*)(lds + (bufoff) + ldsw + _i * 8192), 16, 0, 0); } while (0)
#define PG8_LDA(dst, b, h) do { _Pragma("unroll") for (int m = 0; m < 4; ++m) _Pragma("unroll") for (int k = 0; k < 2; ++k) dst[m][k] = *(const PG8_LAS bf16x8*)(lds + PG8_SA(b, h) + aoff + m * 2048 + k * 1024); } while (0)
#define PG8_LDB(dst, b, h) do { _Pragma("unroll") for (int n = 0; n < 2; ++n) _Pragma("unroll") for (int k = 0; k < 2; ++k) dst[n][k] = *(const PG8_LAS bf16x8*)(lds + PG8_SB(b, h) + boff + n * 2048 + k * 1024); } while (0)
#define PG8_MMA(ai, bj, At, Bt) do { __builtin_amdgcn_s_setprio(1); _Pragma("unroll") for (int m = 0; m < 4; ++m) _Pragma("unroll") for (int n = 0; n < 2; ++n) _Pragma("unroll") for (int k = 0; k < 2; ++k) \
        acc[ai][bj][m][n] = __builtin_amdgcn_mfma_f32_16x16x32_bf16(Bt[n][k], At[m][k], acc[ai][bj][m][n], 0, 0, 0); __builtin_amdgcn_s_setprio(0); } while (0)
#define PG8_WAIT_V(n) asm volatile("s_waitcnt vmcnt(" #n ")" ::: "memory")
#define PG8_WAIT_L(n) asm volatile("s_waitcnt lgkmcnt(" #n ")" ::: "memory")
#define PG8_BAR __builtin_amdgcn_s_barrier()
#define PG8_SCHED __builtin_amdgcn_sched_barrier(0)
    Unit cur, nxt; int ui = 0;
    if (!S.next(0, cur)) return;
    f32x4 acc[2][2][4][2];
#pragma unroll
    for (int a = 0; a < 2; ++a)
#pragma unroll
        for (int b = 0; b < 2; ++b)
#pragma unroll
            for (int m = 0; m < 4; ++m)
#pragma unroll
                for (int n = 0; n < 2; ++n) acc[a][b][m][n] = (f32x4){0.f, 0.f, 0.f, 0.f};
    bf16x8 At[4][2], B0[2][2], B1[2][2];
    const char* cA = (const char*)g.A + (size_t)cur.pm * tstep; const char* cB = (const char*)g.Bt + (size_t)cur.pn * tstep;
    S.a_ready(cur);
    if constexpr (SP2) {
        PG8_STAGE(PG8_SB(0, 0), cB, voffB); PG8_STAGE(PG8_SB(0, 1), cB + hstep, voffB); PG8_STAGE(PG8_SA(0, 0), cA, voffA); PG8_STAGE(PG8_SA(0, 1), cA + hstep, voffA);
        if (wr == 1) PG8_BAR;
        PG8_WAIT_V(2); PG8_BAR;
        PG8_STAGE(PG8_SB(1, 0), cB + kstep, voffB); PG8_STAGE(PG8_SA(1, 0), cA + kstep, voffA); PG8_STAGE(PG8_SB(1, 1), cB + hstep + kstep, voffB);
        PG8_WAIT_V(6); PG8_BAR;
    } else {
        PG8_STAGE(PG8_SB(0, 0), cB, voffB); PG8_STAGE(PG8_SA(0, 0), cA, voffA); PG8_STAGE(PG8_SB(0, 1), cB + hstep, voffB); PG8_STAGE(PG8_SA(0, 1), cA + hstep, voffA);
        if (wr == 1) PG8_BAR;
        PG8_WAIT_V(4); PG8_BAR;
        PG8_STAGE(PG8_SB(1, 0), cB + kstep, voffB); PG8_STAGE(PG8_SA(1, 0), cA + kstep, voffA); PG8_STAGE(PG8_SB(1, 1), cB + hstep + kstep, voffB);
        PG8_WAIT_V(6); PG8_BAR;
    }
    for (;;) {
        const bool has_next = S.next(ui + 1, nxt);
        const char* nA = has_next ? (const char*)g.A + (size_t)nxt.pm * tstep : cA; const char* nB = has_next ? (const char*)g.Bt + (size_t)nxt.pn * tstep : cB;
        for (int t = 0; t < nt; t += 2) {
            const bool last = (t == nt - 2);
            const char* a1 = cA + (size_t)(t + 1) * kstep;
            const char* a2 = last ? nA : cA + (size_t)(t + 2) * kstep; const char* b2 = last ? nB : cB + (size_t)(t + 2) * kstep;
            const char* a3 = a2 + kstep; const char* b3 = b2 + kstep;
            if (last && has_next) S.a_ready(nxt);
            if constexpr (SP2) {
            PG8_LDB(B0, 0, 0); PG8_LDB(B1, 0, 1); PG8_SCHED; PG8_LDA(At, 0, 0); PG8_STAGE(PG8_SA(1, 1), a1 + hstep, voffA);
            PG8_WAIT_V(8); PG8_WAIT_L(0); PG8_BAR; PG8_MMA(0, 0, At, B0); PG8_MMA(0, 1, At, B1); PG8_BAR; PG8_SCHED;
            PG8_LDA(At, 0, 1); PG8_STAGE(PG8_SB(0, 0), b2, voffB); PG8_STAGE(PG8_SB(0, 1), b2 + hstep, voffB); PG8_STAGE(PG8_SA(0, 0), a2, voffA);
            PG8_WAIT_V(8); PG8_WAIT_L(0); PG8_BAR; PG8_MMA(1, 0, At, B0); PG8_MMA(1, 1, At, B1); PG8_BAR; PG8_SCHED;
            PG8_LDB(B0, 1, 0); PG8_LDB(B1, 1, 1); PG8_SCHED; PG8_LDA(At, 1, 0); PG8_STAGE(PG8_SA(0, 1), a2 + hstep, voffA);
            PG8_WAIT_V(8); PG8_WAIT_L(0); PG8_BAR; PG8_MMA(0, 0, At, B0); PG8_MMA(0, 1, At, B1); PG8_BAR; PG8_SCHED;
            PG8_LDA(At, 1, 1); PG8_STAGE(PG8_SB(1, 0), b3, voffB); PG8_STAGE(PG8_SB(1, 1), b3 + hstep, voffB); PG8_STAGE(PG8_SA(1, 0), a3, voffA);
            PG8_WAIT_V(8); PG8_WAIT_L(0); PG8_BAR; PG8_MMA(1, 0, At, B0); PG8_MMA(1, 1, At, B1); PG8_BAR; PG8_SCHED;
            } else {
            PG8_LDB(B0, 0, 0); PG8_SCHED; PG8_LDA(At, 0, 0); PG8_STAGE(PG8_SA(1, 1), a1 + hstep, voffA);
            PG8_WAIT_L(8); PG8_BAR; PG8_WAIT_L(0); PG8_MMA(0, 0, At, B0); PG8_BAR; PG8_SCHED;
            PG8_LDB(B1, 0, 1); PG8_STAGE(PG8_SB(0, 0), b2, voffB);
            PG8_BAR; PG8_WAIT_L(0); PG8_MMA(0, 1, At, B1); PG8_BAR;
            PG8_LDA(At, 0, 1); PG8_STAGE(PG8_SA(0, 0), a2, voffA);
            PG8_BAR; PG8_WAIT_L(0); PG8_MMA(1, 0, At, B0); PG8_BAR; PG8_SCHED;
            PG8_STAGE(PG8_SB(0, 1), b2 + hstep, voffB);
            PG8_WAIT_V(6); PG8_BAR; PG8_MMA(1, 1, At, B1); PG8_BAR;
            PG8_LDB(B0, 1, 0); PG8_SCHED; PG8_LDA(At, 1, 0); PG8_STAGE(PG8_SA(0, 1), a2 + hstep, voffA);
            PG8_WAIT_L(8); PG8_BAR; PG8_WAIT_L(0); PG8_MMA(0, 0, At, B0); PG8_BAR; PG8_SCHED;
            PG8_LDB(B1, 1, 1); PG8_STAGE(PG8_SB(1, 0), b3, voffB);
            PG8_BAR; PG8_WAIT_L(0); PG8_MMA(0, 1, At, B1); PG8_BAR;
            PG8_LDA(At, 1, 1); PG8_STAGE(PG8_SA(1, 0), a3, voffA);
            PG8_BAR; PG8_WAIT_L(0); PG8_MMA(1, 0, At, B0); PG8_BAR; PG8_SCHED;
            PG8_STAGE(PG8_SB(1, 1), b3 + hstep, voffB);
            PG8_WAIT_V(6); PG8_BAR; PG8_MMA(1, 1, At, B1); PG8_BAR;
            }
        }
        if constexpr (ALIGN_EPI) { if (wr == 0) PG8_BAR; }
        if constexpr (!Epi::AFTER_DRAIN) { E(acc, cur, wr, wc, fr, fq); S.done(cur); }
        if (!has_next) break;
#pragma unroll
        for (int a = 0; a < 2; ++a)
#pragma unroll
            for (int b = 0; b < 2; ++b)
#pragma unroll
                for (int m = 0; m < 4; ++m)
#pragma unroll
                    for (int n = 0; n < 2; ++n) acc[a][b][m][n] = (f32x4){0.f, 0.f, 0.f, 0.f};
        cur = nxt; cA = nA; cB = nB; ++ui;
        if constexpr (ALIGN_EPI) { if (wr == 1) PG8_BAR; }
    }
    PG8_WAIT_V(0);
    if constexpr (!ALIGN_EPI) { if (wr == 0) PG8_BAR; }
    PG8_BAR;
    if constexpr (Epi::AFTER_DRAIN) { E.fused(acc, cur, wr, wc, fr, fq, lds, wid, lane); S.done(cur); }
#undef PG8_SA
#undef PG8_SB
#undef PG8_STAGE
#undef PG8_LDA
#undef PG8_LDB
#undef PG8_MMA
#undef PG8_WAIT_V
#undef PG8_WAIT_L
#undef PG8_BAR
#undef PG8_SCHED
}
}

constexpr int NTOK = 16384, DM = 1024, SEQ = 2048, NBATCH = 8, MEMLEN = 256, NMEM = NBATCH * MEMLEN, DFF = 2816;
constexpr int INW = 7184, INW_P = 7168;
constexpr float EPS = 1e-6f;
constexpr float LOG2E = 1.4426950408889634f;
constexpr size_t MiB = 1u << 20;
constexpr size_t WS_MLQ = 0, WS_MLK = 16 * MiB, WS_MLV = 32 * MiB, WS_MLO = 48 * MiB, WS_NAQ = 64 * MiB, WS_XAQ = 80 * MiB, WS_NAK = 96 * MiB, WS_NAVT = 112 * MiB, WS_G = 128 * MiB;
constexpr size_t WS_WBR = 224 * MiB, WS_WOUT = 227 * MiB, WS_WUP = 229 * MiB, WS_WDOWN = 240 * MiB, WS_MEMK = 246 * MiB, WS_MEMVT = 248 * MiB, WS_GATES = 250 * MiB, WS_RSS1 = 251 * MiB;
constexpr size_t WS_XBAR = 251 * MiB + 131072;
constexpr size_t WS_PCNT = WS_XBAR + 16384, WS_SUBCNT = WS_XBAR + 32768, WS_CTLBYTES = 32768 + 1024, WS_SLOTS = 251 * MiB + 262144;
constexpr size_t WS_NEED = 252 * MiB;
constexpr size_t WS_TMP = 0, WS_MERGED = WS_NAK, WS_X1B = 0, WS_UBUF = 32 * MiB, WS_ABUF = WS_G;
constexpr size_t DO_H = 0, DO_WINT = 32 * MiB, DO_WMEMKVT = 46 * MiB, DO_MEMN = 48 * MiB, DO_QC = 0, DO_KC = 16 * MiB, DO_HFW = 32 * MiB, DO_HBW = 48 * MiB;
constexpr int LDS_BYTES = 155648;
constexpr int XA_K_PITCH = 272, XA_VT_PITCH = 528, XA_VT_OFF = 256 * XA_K_PITCH;
constexpr int NA_RPB_OFF = 140000;
constexpr int LDS_XB_OFF = 155136;
constexpr int ML_QP = 272, ML_TP = 144;
constexpr int ML_QS = 0, ML_KS = ML_QS + 64 * ML_QP, ML_KT = ML_KS + 64 * ML_QP, ML_VT = ML_KT + 128 * ML_TP, ML_WVT = ML_VT + 128 * ML_TP, ML_PS = ML_WVT + 128 * ML_TP;
constexpr int ML_NV = ML_PS + 64 * ML_TP, ML_ROWSUM = ML_NV + 2 * 128 * 4, ML_DENI = ML_ROWSUM + 1024, ML_WTS = ML_DENI + 256, ML_CW = ML_WTS + 256, ML_END = ML_CW + 4 * 256 * 4;
static_assert(ML_END <= LDS_BYTES, "mlstm lds");

struct Params { const float* in[23]; float* out; unsigned char* ws; };

constexpr int TR_LDS_OFF = 131072, TR_PITCH = 48, TR_WAVE_BYTES = 32 * TR_PITCH;
__device__ __forceinline__ u32x4 tr16x32(PG8_LAS unsigned char* patch, int fr, int fq, int lane, const f32x4 v0, const f32x4 v1) {
    const unsigned w0 = cvt_pk_bf16(v0[0], v0[1]), w1 = cvt_pk_bf16(v0[2], v0[3]), w2 = cvt_pk_bf16(v1[0], v1[1]), w3 = cvt_pk_bf16(v1[2], v1[3]);
    PG8_LAS unsigned short* p = (PG8_LAS unsigned short*)(patch + (8 * fq) * TR_PITCH + fr * 2);
    p[0 * (TR_PITCH / 2)] = (unsigned short)w0; p[1 * (TR_PITCH / 2)] = (unsigned short)(w0 >> 16); p[2 * (TR_PITCH / 2)] = (unsigned short)w1; p[3 * (TR_PITCH / 2)] = (unsigned short)(w1 >> 16);
    p[4 * (TR_PITCH / 2)] = (unsigned short)w2; p[5 * (TR_PITCH / 2)] = (unsigned short)(w2 >> 16); p[6 * (TR_PITCH / 2)] = (unsigned short)w3; p[7 * (TR_PITCH / 2)] = (unsigned short)(w3 >> 16);
    asm volatile("s_waitcnt lgkmcnt(0)" ::: "memory");
    const u32x4 r = *(const PG8_LAS u32x4*)(patch + (lane >> 1) * TR_PITCH + (lane & 1) * 16);
    asm volatile("s_waitcnt lgkmcnt(0)" ::: "memory");
    return r;
}

struct EpiProj {
    static constexpr bool PERM = true, AFTER_DRAIN = false;
    unsigned char* ws; const float* bmerge; PG8_LAS unsigned char* lds;
    __device__ __forceinline__ void operator()(const f32x4 (&acc)[2][2][4][2], const pg8::Unit& u, int wr, int wc, int fr, int fq) const {
        const int row0 = u.pm * 256 + wr * 64 + fr; const int pn = u.pn; const int cl = wc * 32 + 8 * fq;
        if (pn >= 16) {
            bf16_t* G = (bf16_t*)(ws + WS_G); const int cg0 = (pn - 16) * 256 + cl;
            f32x4 bv[2][2];
#pragma unroll
            for (int bj = 0; bj < 2; ++bj)
#pragma unroll
                for (int n = 0; n < 2; ++n) bv[bj][n] = *(const f32x4*)(bmerge + cg0 + bj * 128 + 4 * n);
#pragma unroll
            for (int ai = 0; ai < 2; ++ai)
#pragma unroll
                for (int m = 0; m < 4; ++m) { const size_t row = row0 + ai * 128 + m * 16;
#pragma unroll
                    for (int bj = 0; bj < 2; ++bj) { const f32x4 v0 = acc[ai][bj][m][0] + bv[bj][0], v1 = acc[ai][bj][m][1] + bv[bj][1];
                        u32x4 w; w.x = cvt_pk_bf16(v0[0], v0[1]); w.y = cvt_pk_bf16(v0[2], v0[3]);
                        w.z = cvt_pk_bf16(v1[0], v1[1]); w.w = cvt_pk_bf16(v1[2], v1[3]);
                        *(u32x4*)(G + row * 3072 + cg0 + bj * 128) = w; } }
        } else {
            const int bi = pn >> 1, coff = (pn & 1) * 256 + cl;
            if (bi == 6) {
                bf16_t* VT = (bf16_t*)(ws + WS_NAVT);
                const int lane = fq * 16 + fr; PG8_LAS unsigned char* patch = lds + TR_LDS_OFF + (wr * 4 + wc) * TR_WAVE_BYTES;
#pragma unroll
                for (int ai = 0; ai < 2; ++ai)
#pragma unroll
                    for (int m = 0; m < 4; ++m) { const int rowb = u.pm * 256 + wr * 64 + ai * 128 + m * 16; const int b = rowb >> 11, tok0 = rowb & 2047;
#pragma unroll
                        for (int bj = 0; bj < 2; ++bj) { const u32x4 r = tr16x32(patch, fr, fq, lane, acc[ai][bj][m][0], acc[ai][bj][m][1]);
                            const int col = (pn & 1) * 256 + bj * 128 + wc * 32 + (lane >> 1);
                            *(u32x4*)(VT + ((size_t)(b * 512 + col)) * 2048 + tok0 + (lane & 1) * 8) = r; } }
            } else {
                const size_t boff = bi == 0 ? WS_MLQ : bi == 1 ? WS_MLK : bi == 2 ? WS_MLV : bi == 3 ? WS_MLO : bi == 4 ? WS_NAQ : bi == 5 ? WS_NAK : WS_XAQ;
                bf16_t* O = (bf16_t*)(ws + boff);
#pragma unroll
                for (int ai = 0; ai < 2; ++ai)
#pragma unroll
                    for (int m = 0; m < 4; ++m) { const size_t row = row0 + ai * 128 + m * 16;
#pragma unroll
                        for (int bj = 0; bj < 2; ++bj) { const f32x4 v0 = acc[ai][bj][m][0], v1 = acc[ai][bj][m][1];
                            u32x4 w; w.x = cvt_pk_bf16(v0[0], v0[1]); w.y = cvt_pk_bf16(v0[2], v0[3]); w.z = cvt_pk_bf16(v1[0], v1[1]); w.w = cvt_pk_bf16(v1[2], v1[3]);
                            *(u32x4*)(O + row * 512 + coff + bj * 128) = w; } }
            }
        }
    }
};
struct EpiMemKV {
    static constexpr bool PERM = true, AFTER_DRAIN = false;
    unsigned char* ws; PG8_LAS unsigned char* lds;
    __device__ __forceinline__ void operator()(const f32x4 (&acc)[2][2][4][2], const pg8::Unit& u, int wr, int wc, int fr, int fq) const {
        const int row0 = u.pm * 256 + wr * 64 + fr; const int pn = u.pn; const int coff = (pn & 1) * 256 + wc * 32 + 8 * fq;
        if (pn < 2) { bf16_t* O = (bf16_t*)(ws + WS_MEMK);
#pragma unroll
            for (int ai = 0; ai < 2; ++ai)
#pragma unroll
                for (int m = 0; m < 4; ++m) { const size_t row = row0 + ai * 128 + m * 16;
#pragma unroll
                    for (int bj = 0; bj < 2; ++bj) { const f32x4 v0 = acc[ai][bj][m][0], v1 = acc[ai][bj][m][1];
                        u32x4 w; w.x = cvt_pk_bf16(v0[0], v0[1]); w.y = cvt_pk_bf16(v0[2], v0[3]); w.z = cvt_pk_bf16(v1[0], v1[1]); w.w = cvt_pk_bf16(v1[2], v1[3]);
                        *(u32x4*)(O + row * 512 + coff + bj * 128) = w; } }
        } else { bf16_t* VT = (bf16_t*)(ws + WS_MEMVT);
            const int lane = fq * 16 + fr; PG8_LAS unsigned char* patch = lds + TR_LDS_OFF + (wr * 4 + wc) * TR_WAVE_BYTES;
#pragma unroll
            for (int ai = 0; ai < 2; ++ai)
#pragma unroll
                for (int m = 0; m < 4; ++m) { const int rowb = u.pm * 256 + wr * 64 + ai * 128 + m * 16; const int b = rowb >> 8, mm0 = rowb & 255;
#pragma unroll
                    for (int bj = 0; bj < 2; ++bj) { const u32x4 r = tr16x32(patch, fr, fq, lane, acc[ai][bj][m][0], acc[ai][bj][m][1]);
                        const int col = (pn & 1) * 256 + bj * 128 + wc * 32 + (lane >> 1);
                        *(u32x4*)(VT + ((size_t)(b * 512 + col)) * 256 + mm0 + (lane & 1) * 8) = r; } }
        }
    }
};
template <int MODE> struct EpiBranch {
    static constexpr bool PERM = true, AFTER_DRAIN = false;
    const bf16_t* G; float* tmp; bf16_t* merged; int br;
    __device__ __forceinline__ void operator()(const f32x4 (&acc)[2][2][4][2], const pg8::Unit& u, int wr, int wc, int fr, int fq) const {
        const int row0 = u.pm * 256 + wr * 64 + fr; const int col0 = u.pn * 256 + wc * 32 + 8 * fq;
#pragma unroll
        for (int ai = 0; ai < 2; ++ai)
#pragma unroll
            for (int m = 0; m < 4; ++m) { const size_t row = row0 + ai * 128 + m * 16;
#pragma unroll
                for (int bj = 0; bj < 2; ++bj) { const int col = col0 + bj * 128;
                    const u32x4 gw = *(const u32x4*)(G + row * 3072 + br * 1024 + col);
                    f32x4 v0 = acc[ai][bj][m][0], v1 = acc[ai][bj][m][1];
                    v0[0] *= bf_lo(gw.x); v0[1] *= bf_hi(gw.x); v0[2] *= bf_lo(gw.y); v0[3] *= bf_hi(gw.y);
                    v1[0] *= bf_lo(gw.z); v1[1] *= bf_hi(gw.z); v1[2] *= bf_lo(gw.w); v1[3] *= bf_hi(gw.w);
                    float* tp = tmp + row * 1024 + col;
                    if (MODE >= 1) { v0 += *(const f32x4*)tp; v1 += *(const f32x4*)(tp + 4); }
                    if (MODE <= 1) { *(f32x4*)tp = v0; *(f32x4*)(tp + 4) = v1; }
                    else { u32x4 w; w.x = cvt_pk_bf16(v0[0], v0[1]); w.y = cvt_pk_bf16(v0[2], v0[3]); w.z = cvt_pk_bf16(v1[0], v1[1]); w.w = cvt_pk_bf16(v1[2], v1[3]);
                        *(u32x4*)(merged + row * 1024 + col) = w; } } }
    }
};
struct BranchOrder {
    int G, c, mode, nblk, x;
    __host__ __device__ void init(int G_, int c_, int mode_, int nblk_, int x_) { G = G_; c = c_; mode = mode_; nblk = nblk_; x = x_; }
    __host__ __device__ bool next(int i, pg8::Unit& u) const {
        pg8::StaticOrder base; pg8::Unit t; int br;
        if (mode == 2) { const int q = x + i * nblk; if (q >= 512) return false; br = 1 + (q & 1); base.init(NTOK, 1024, 256, q >> 1); if (!base.next(0, t)) return false; }
        else { if (i >= (mode == 0 ? 1 : 3)) return false; br = mode == 0 ? 0 : (i == 2 ? 0 : i + 1); base.init(NTOK, 1024, G, c); if (!base.next(0, t)) return false; }
        u.pm = br * 64 + t.pm; u.pn = br * 4 + t.pn; return true;
    }
    __device__ __forceinline__ void a_ready(const pg8::Unit&) const {}
    __device__ __forceinline__ void done(const pg8::Unit&) const {}
};
struct EpiBranchAcc {
    static constexpr bool PERM = true, AFTER_DRAIN = false;
    bf16_t* G; bf16_t* merged;
    __device__ __forceinline__ void operator()(const f32x4 (&acc)[2][2][4][2], const pg8::Unit& u, int wr, int wc, int fr, int fq) const {
        const int br = u.pm >> 6, pm = u.pm & 63, pn = u.pn & 3;
        const int row0 = pm * 256 + wr * 64 + fr; const int col0 = pn * 256 + wc * 32 + 8 * fq;
#pragma unroll
        for (int ai = 0; ai < 2; ++ai)
#pragma unroll
            for (int m = 0; m < 4; ++m) { const size_t row = row0 + ai * 128 + m * 16;
#pragma unroll
                for (int bj = 0; bj < 2; ++bj) { const int col = col0 + bj * 128;
                    bf16_t* gp = G + row * 3072 + br * 1024 + col;
                    const u32x4 gw = *(const u32x4*)gp;
                    f32x4 v0 = acc[ai][bj][m][0], v1 = acc[ai][bj][m][1];
                    v0[0] *= sigmoidf_(bf_lo(gw.x)); v0[1] *= sigmoidf_(bf_hi(gw.x)); v0[2] *= sigmoidf_(bf_lo(gw.y)); v0[3] *= sigmoidf_(bf_hi(gw.y));
                    v1[0] *= sigmoidf_(bf_lo(gw.z)); v1[1] *= sigmoidf_(bf_hi(gw.z)); v1[2] *= sigmoidf_(bf_lo(gw.w)); v1[3] *= sigmoidf_(bf_hi(gw.w));
                    if (br != 0) { u32x4 w; w.x = cvt_pk_bf16(v0[0], v0[1]); w.y = cvt_pk_bf16(v0[2], v0[3]); w.z = cvt_pk_bf16(v1[0], v1[1]); w.w = cvt_pk_bf16(v1[2], v1[3]); *(u32x4*)gp = w; }
                    else {
                        const u32x4 p1 = *(const u32x4*)(gp + 1024), p2 = *(const u32x4*)(gp + 2048);
                        v0[0] += bf_lo(p1.x) + bf_lo(p2.x); v0[1] += bf_hi(p1.x) + bf_hi(p2.x); v0[2] += bf_lo(p1.y) + bf_lo(p2.y); v0[3] += bf_hi(p1.y) + bf_hi(p2.y);
                        v1[0] += bf_lo(p1.z) + bf_lo(p2.z); v1[1] += bf_hi(p1.z) + bf_hi(p2.z); v1[2] += bf_lo(p1.w) + bf_lo(p2.w); v1[3] += bf_hi(p1.w) + bf_hi(p2.w);
                        u32x4 w; w.x = cvt_pk_bf16(v0[0], v0[1]); w.y = cvt_pk_bf16(v0[2], v0[3]); w.z = cvt_pk_bf16(v1[0], v1[1]); w.w = cvt_pk_bf16(v1[2], v1[3]);
                        *(u32x4*)(merged + row * 1024 + col) = w; } } }
    }
};
struct EpiOut {
    static constexpr bool PERM = true, AFTER_DRAIN = false;
    const float* x; float* x1; bf16_t* x1b; float* rss;
    __device__ __forceinline__ void operator()(const f32x4 (&acc)[2][2][4][2], const pg8::Unit& u, int wr, int wc, int fr, int fq) const {
        const int row0 = u.pm * 256 + wr * 64 + fr; const int col0 = u.pn * 256 + wc * 32 + 8 * fq;
#pragma unroll
        for (int ai = 0; ai < 2; ++ai)
#pragma unroll
            for (int m = 0; m < 4; ++m) { const size_t row = row0 + ai * 128 + m * 16; float ss = 0.f;
#pragma unroll
                for (int bj = 0; bj < 2; ++bj) { const size_t off = row * 1024 + col0 + bj * 128;
                    const f32x4 v0 = acc[ai][bj][m][0] + *(const f32x4*)(x + off), v1 = acc[ai][bj][m][1] + *(const f32x4*)(x + off + 4);
                    u32x4 w; w.x = cvt_pk_bf16(v0[0], v0[1]); w.y = cvt_pk_bf16(v0[2], v0[3]); w.z = cvt_pk_bf16(v1[0], v1[1]); w.w = cvt_pk_bf16(v1[2], v1[3]);
                    *(u32x4*)(x1b + off) = w;
                    ss += (v0[0] * v0[0] + v0[1] * v0[1]) + (v0[2] * v0[2] + v0[3] * v0[3]) + (v1[0] * v1[0] + v1[1] * v1[1]) + (v1[2] * v1[2] + v1[3] * v1[3]); }
                ss += __shfl_xor(ss, 16); ss += __shfl_xor(ss, 32);
                if (fq == 0) atomicAdd(rss + row, ss); }
    }
};
struct EpiUp {
    static constexpr bool PERM = true, AFTER_DRAIN = false;
    const float* rss; bf16_t* A; bf16_t* U;
    __device__ __forceinline__ void operator()(const f32x4 (&acc)[2][2][4][2], const pg8::Unit& u, int wr, int wc, int fr, int fq) const {
        const int row0 = u.pm * 256 + wr * 64 + fr; const int pn = u.pn;
        bf16_t* O = pn < 11 ? A : U; const int col0 = (pn < 11 ? pn : pn - 11) * 256 + wc * 32 + 8 * fq;
#pragma unroll
        for (int ai = 0; ai < 2; ++ai)
#pragma unroll
            for (int m = 0; m < 4; ++m) { const size_t row = row0 + ai * 128 + m * 16; const float rstd = rsqrtf(rss[row] * (1.0f / 1024.0f) + EPS);
#pragma unroll
                for (int bj = 0; bj < 2; ++bj) { const f32x4 v0 = acc[ai][bj][m][0] * rstd, v1 = acc[ai][bj][m][1] * rstd;
                    u32x4 w; w.x = cvt_pk_bf16(v0[0], v0[1]); w.y = cvt_pk_bf16(v0[2], v0[3]); w.z = cvt_pk_bf16(v1[0], v1[1]); w.w = cvt_pk_bf16(v1[2], v1[3]);
                    *(u32x4*)(O + row * 2816 + col0 + bj * 128) = w; } }
    }
};
struct EpiUpGlu {
    static constexpr bool PERM = true, AFTER_DRAIN = false;
    const float* rss; const bf16_t* A; bf16_t* Gout; const float* cw; const float* cb;
    __device__ __forceinline__ void operator()(const f32x4 (&acc)[2][2][4][2], const pg8::Unit& u, int wr, int wc, int fr, int fq) const {
        const int row0 = u.pm * 256 + wr * 64 + fr;
#pragma unroll
        for (int bj = 0; bj < 2; ++bj) {
            const int ch0 = u.pn * 256 + bj * 128 + wc * 32 + 8 * fq;
            float w0[8], w1[8], w2[8], bb[8];
#pragma unroll
            for (int q = 0; q < 2; ++q) { const f32x4 t0 = *(const f32x4*)(cw + ch0 + 4 * q), t1 = *(const f32x4*)(cw + 2816 + ch0 + 4 * q), t2 = *(const f32x4*)(cw + 5632 + ch0 + 4 * q), t3 = *(const f32x4*)(cb + ch0 + 4 * q);
#pragma unroll
                for (int i = 0; i < 4; ++i) { w0[4 * q + i] = t0[i]; w1[4 * q + i] = t1[i]; w2[4 * q + i] = t2[i]; bb[4 * q + i] = t3[i]; } }
#pragma unroll
            for (int ai = 0; ai < 2; ++ai)
#pragma unroll
              for (int mh = 0; mh < 2; ++mh) {
                u32x4 am[2], ac[2], an[2]; float rs[2];
#pragma unroll
                for (int mm = 0; mm < 2; ++mm) { const int m = 2 * mh + mm; const size_t row = row0 + ai * 128 + m * 16; const int sp = (int)(row & 2047);
                    const bf16_t* ap = A + row * 2816 + ch0; const u32x4 zc = {0u, 0u, 0u, 0u};
                    ac[mm] = *(const u32x4*)ap; am[mm] = sp > 0 ? *(const u32x4*)(ap - 2816) : zc; an[mm] = sp < 2047 ? *(const u32x4*)(ap + 2816) : zc; rs[mm] = rss[row]; }
#pragma unroll
                for (int mm = 0; mm < 2; ++mm) { const int m = 2 * mh + mm; const size_t row = row0 + ai * 128 + m * 16;
                    const float rstd = rsqrtf(rs[mm] * (1.0f / 1024.0f) + EPS);
                    const float pv[8] = {bf_lo(am[mm].x), bf_hi(am[mm].x), bf_lo(am[mm].y), bf_hi(am[mm].y), bf_lo(am[mm].z), bf_hi(am[mm].z), bf_lo(am[mm].w), bf_hi(am[mm].w)};
                    const float cv[8] = {bf_lo(ac[mm].x), bf_hi(ac[mm].x), bf_lo(ac[mm].y), bf_hi(ac[mm].y), bf_lo(ac[mm].z), bf_hi(ac[mm].z), bf_lo(ac[mm].w), bf_hi(ac[mm].w)};
                    const float nv[8] = {bf_lo(an[mm].x), bf_hi(an[mm].x), bf_lo(an[mm].y), bf_hi(an[mm].y), bf_lo(an[mm].z), bf_hi(an[mm].z), bf_lo(an[mm].w), bf_hi(an[mm].w)};
                    const f32x4 u0 = acc[ai][bj][m][0] * rstd, u1 = acc[ai][bj][m][1] * rstd;
                    float o[8];
#pragma unroll
                    for (int q = 0; q < 8; ++q) { const float y = w0[q] * pv[q] + w1[q] * cv[q] + w2[q] * nv[q] + bb[q];
                        const float z = 1.5957691216057308f * (y + 0.044715f * y * y * y);
                        o[q] = y * sigmoidf_(z) * (q < 4 ? u0[q] : u1[q - 4]); }
                    u32x4 w; w.x = cvt_pk_bf16(o[0], o[1]); w.y = cvt_pk_bf16(o[2], o[3]); w.z = cvt_pk_bf16(o[4], o[5]); w.w = cvt_pk_bf16(o[6], o[7]);
                    *(u32x4*)(Gout + row * 2816 + ch0) = w; }
              }
        }
    }
};
struct EpiDown {
    static constexpr bool PERM = true, AFTER_DRAIN = false;
    const bf16_t* x1; float* outp;
    __device__ __forceinline__ void operator()(const f32x4 (&acc)[2][2][4][2], const pg8::Unit& u, int wr, int wc, int fr, int fq) const {
        const int row0 = u.pm * 256 + wr * 64 + fr; const int col0 = u.pn * 256 + wc * 32 + 8 * fq;
#pragma unroll
        for (int ai = 0; ai < 2; ++ai)
#pragma unroll
            for (int m = 0; m < 4; ++m) { const size_t row = row0 + ai * 128 + m * 16;
#pragma unroll
                for (int bj = 0; bj < 2; ++bj) { const size_t off = row * 1024 + col0 + bj * 128; const u32x4 xw = *(const u32x4*)(x1 + off); float* p = outp + off;
                    const f32x4 v0 = acc[ai][bj][m][0] + (f32x4){bf_lo(xw.x), bf_hi(xw.x), bf_lo(xw.y), bf_hi(xw.y)}, v1 = acc[ai][bj][m][1] + (f32x4){bf_lo(xw.z), bf_hi(xw.z), bf_lo(xw.w), bf_hi(xw.w)};
                    *(f32x4*)p = v0; *(f32x4*)(p + 4) = v1; } }
    }
};

struct EpiDownNorm {
    static constexpr bool PERM = true, AFTER_DRAIN = true;
    const bf16_t* x1; const float* gfin; float* slots; unsigned* cnt; float* outp;
    __device__ __forceinline__ void operator()(const f32x4 (&)[2][2][4][2], const pg8::Unit&, int, int, int, int) const {}
    __device__ __forceinline__ void fused(f32x4 (&acc)[2][2][4][2], const pg8::Unit& u, int wr, int wc, int fr, int fq, PG8_LAS unsigned char* lds, int wid, int lane) const {
        PG8_LAS float* Pt = (PG8_LAS float*)lds;
        PG8_LAS float* St = (PG8_LAS float*)(lds + 4096);
        const int row0 = u.pm * 256 + wr * 64 + fr; const int col0 = u.pn * 256 + wc * 32 + 8 * fq;
#pragma unroll
        for (int ai = 0; ai < 2; ++ai)
#pragma unroll
            for (int m = 0; m < 4; ++m) { const size_t row = row0 + ai * 128 + m * 16; float ss = 0.f;
#pragma unroll
                for (int bj = 0; bj < 2; ++bj) { const u32x4 xw = *(const u32x4*)(x1 + row * 1024 + col0 + bj * 128);
                    const f32x4 v0 = acc[ai][bj][m][0] + (f32x4){bf_lo(xw.x), bf_hi(xw.x), bf_lo(xw.y), bf_hi(xw.y)}, v1 = acc[ai][bj][m][1] + (f32x4){bf_lo(xw.z), bf_hi(xw.z), bf_lo(xw.w), bf_hi(xw.w)};
                    acc[ai][bj][m][0] = v0; acc[ai][bj][m][1] = v1;
                    ss += (v0[0] * v0[0] + v0[1] * v0[1]) + (v0[2] * v0[2] + v0[3] * v0[3]) + (v1[0] * v1[0] + v1[1] * v1[1]) + (v1[2] * v1[2] + v1[3] * v1[3]); }
                ss += __shfl_xor(ss, 16); ss += __shfl_xor(ss, 32);
                if (fq == 0) Pt[(ai * 128 + wr * 64 + m * 16 + fr) * 4 + wc] = ss; }
        asm volatile("s_waitcnt lgkmcnt(0)" ::: "memory"); __builtin_amdgcn_s_barrier(); asm volatile("" ::: "memory");
        const int t = wid * 64 + lane;
        if (t < 256) { const float tot = (Pt[t * 4] + Pt[t * 4 + 1]) + (Pt[t * 4 + 2] + Pt[t * 4 + 3]);
            __hip_atomic_store(slots + ((size_t)(u.pm * 256 + t) * 4 + u.pn), tot, __ATOMIC_RELAXED, __HIP_MEMORY_SCOPE_AGENT); }
        asm volatile("s_waitcnt vmcnt(0)" ::: "memory"); __builtin_amdgcn_s_barrier(); asm volatile("" ::: "memory");
        if (t == 0) { __hip_atomic_fetch_add(cnt + 64 * u.pm, 1u, __ATOMIC_RELAXED, __HIP_MEMORY_SCOPE_AGENT);
            unsigned sp = 0; while (__hip_atomic_load(cnt + 64 * u.pm, __ATOMIC_RELAXED, __HIP_MEMORY_SCOPE_AGENT) < 4u) { __builtin_amdgcn_s_sleep(2); if (++sp > (1u << 22)) break; }
            __builtin_amdgcn_fence(__ATOMIC_ACQUIRE, "agent"); asm volatile("s_waitcnt vmcnt(0)" ::: "memory"); }
        __builtin_amdgcn_s_barrier(); asm volatile("" ::: "memory");
        if (t < 256) { const float* sl = slots + (size_t)(u.pm * 256 + t) * 4;
            const float tot = (__hip_atomic_load(sl, __ATOMIC_RELAXED, __HIP_MEMORY_SCOPE_AGENT) + __hip_atomic_load(sl + 1, __ATOMIC_RELAXED, __HIP_MEMORY_SCOPE_AGENT))
                            + (__hip_atomic_load(sl + 2, __ATOMIC_RELAXED, __HIP_MEMORY_SCOPE_AGENT) + __hip_atomic_load(sl + 3, __ATOMIC_RELAXED, __HIP_MEMORY_SCOPE_AGENT));
            St[t] = rsqrtf(tot * (1.0f / 1024.0f) + EPS); }
        asm volatile("s_waitcnt lgkmcnt(0)" ::: "memory"); __builtin_amdgcn_s_barrier(); asm volatile("" ::: "memory");
        f32x4 gv[2][2];
#pragma unroll
        for (int bj = 0; bj < 2; ++bj) { gv[bj][0] = *(const f32x4*)(gfin + col0 + bj * 128); gv[bj][1] = *(const f32x4*)(gfin + col0 + bj * 128 + 4); }
#pragma unroll
        for (int ai = 0; ai < 2; ++ai)
#pragma unroll
            for (int m = 0; m < 4; ++m) { const int rl = ai * 128 + wr * 64 + m * 16 + fr; const float rstd = St[rl]; const size_t row = (size_t)u.pm * 256 + rl;
#pragma unroll
                for (int bj = 0; bj < 2; ++bj) { float* p = outp + row * 1024 + col0 + bj * 128;
                    *(f32x4*)p = acc[ai][bj][m][0] * rstd * gv[bj][0]; *(f32x4*)(p + 4) = acc[ai][bj][m][1] * rstd * gv[bj][1]; } }
    }
};

__device__ __forceinline__ float wave_sum(float v) {
#pragma unroll
    for (int o = 1; o < 64; o <<= 1) v += __shfl_xor(v, o);
    return v;
}
__device__ __forceinline__ void transpose_item(const float* W, int ldw, int col0, int k0, bf16_t* WT, int K, int row_dst0, const float* kscale, LAS float* scr, int lane) {
    f32x4 v[8];
#pragma unroll
    for (int i = 0; i < 8; ++i) { const int kk = 8 * i + (lane >> 3); v[i] = *(const f32x4*)(W + (size_t)(k0 + kk) * ldw + col0 + (lane & 7) * 4); }
#pragma unroll
    for (int i = 0; i < 8; ++i) { const int kk = 8 * i + (lane >> 3); f32x4 t = v[i]; if (kscale) t = t * kscale[k0 + kk];
        LAS float* d = scr + kk * 33 + (lane & 7) * 4; d[0] = t[0]; d[1] = t[1]; d[2] = t[2]; d[3] = t[3]; }
    LDS_WAIT(); asm volatile("" ::: "memory");
    const int c = lane & 7;
#pragma unroll
    for (int j = 0; j < 4; ++j) { const int n = (lane >> 3) + 8 * j; const LAS float* s = scr + (8 * c) * 33 + n;
        u32x4 o; o.x = cvt_pk_bf16(s[0 * 33], s[1 * 33]); o.y = cvt_pk_bf16(s[2 * 33], s[3 * 33]); o.z = cvt_pk_bf16(s[4 * 33], s[5 * 33]); o.w = cvt_pk_bf16(s[6 * 33], s[7 * 33]);
        *(u32x4*)(WT + (size_t)(row_dst0 + n) * K + k0 + 8 * c) = o; }
    LDS_WAIT(); asm volatile("" ::: "memory");
}
constexpr int WI_IN = 16 * 224, WI_MKV = 16 * 32, WI_BR = 8 * 32, WI_OUT = 16 * 32, WI_UP = 16 * 176, WI_DN = 44 * 32;
constexpr int WI_EARLY = WI_IN + WI_MKV, WI_ALL = WI_IN + WI_MKV + 3 * WI_BR + WI_OUT + WI_UP + WI_DN;
__device__ __forceinline__ void weight_items(LAS unsigned char* lds, const Params& P, int it_begin, int it_end, int gw, int NGW, int wave, int lane) {
    unsigned char* ws = P.ws; unsigned char* dob = (unsigned char*)P.out;
    LAS float* scr = (LAS float*)(lds + wave * 8448);
    constexpr int I_IN = WI_IN, I_MKV = WI_MKV, I_BR = WI_BR, I_OUT = WI_OUT, I_UP = WI_UP;
    for (int it = it_begin + gw; it < it_end; it += NGW) {
        int r = it;
        if (r < I_IN) { const int kb = r / 224, nb = r % 224, n0 = 32 * nb; transpose_item(P.in[3], INW, n0 + (n0 >= 2048 ? 16 : 0), 64 * kb, (bf16_t*)(dob + DO_WINT), 1024, n0, nullptr, scr, lane); continue; } r -= I_IN;
        if (r < I_MKV) { const int kb = r / 32, nb = r % 32; transpose_item(P.in[11], 1024, 32 * nb, 64 * kb, (bf16_t*)(dob + DO_WMEMKVT), 1024, 32 * nb, nullptr, scr, lane); continue; } r -= I_MKV;
        if (r < 3 * I_BR) { const int br = r / I_BR; r -= br * I_BR; const int kb = r / 32, nb = r % 32; transpose_item(P.in[13 + br], 1024, 32 * nb, 64 * kb, (bf16_t*)(ws + WS_WBR + br * MiB), 512, 32 * nb, nullptr, scr, lane); continue; } r -= 3 * I_BR;
        if (r < I_OUT) { const int kb = r / 32, nb = r % 32; transpose_item(P.in[16], 1024, 32 * nb, 64 * kb, (bf16_t*)(ws + WS_WOUT), 1024, 32 * nb, nullptr, scr, lane); continue; } r -= I_OUT;
        if (r < I_UP) { const int kb = r / 176, nb = r % 176; transpose_item(P.in[18], 5632, 32 * nb, 64 * kb, (bf16_t*)(ws + WS_WUP), 1024, 32 * nb, P.in[17], scr, lane); continue; } r -= I_UP;
        { const int kb = r / 32, nb = r % 32; transpose_item(P.in[21], 1024, 32 * nb, 64 * kb, (bf16_t*)(ws + WS_WDOWN), 2816, 32 * nb, nullptr, scr, lane); }
    }
}
__device__ __forceinline__ void p0_prologue(LAS unsigned char* lds, const Params& P, int G) {
    int tid_ = threadIdx.x; asm volatile("" : "+v"(tid_)); const int tid = tid_, lane = tid & 63, wave = tid >> 6;
    const int gw = blockIdx.x * 8 + wave, NGW = G * 8;
    unsigned char* ws = P.ws; unsigned char* dob = (unsigned char*)P.out;
    LAS float* scr = (LAS float*)(lds + wave * 8448);
    LAS float* tab = (LAS float*)(lds + 8 * 8448);
    { const float* win = P.in[3];
      for (int k = tid; k < 1024; k += 512) {
          const f32x4* src = (const f32x4*)(win + (size_t)k * INW + 2048);
#pragma unroll
          for (int q = 0; q < 4; ++q) { const f32x4 v = src[q]; tab[(4 * q + 0) * 1024 + k] = v[0]; tab[(4 * q + 1) * 1024 + k] = v[1]; tab[(4 * q + 2) * 1024 + k] = v[2]; tab[(4 * q + 3) * 1024 + k] = v[3]; } } }
    { float* rss = (float*)(ws + WS_RSS1); for (int i = blockIdx.x * 512 + tid; i < NTOK; i += G * 512) rss[i] = 0.f; }
    weight_items(lds, P, 0, G >= 128 ? WI_EARLY : WI_ALL, gw, NGW, wave, lane);
    __syncthreads();
    {
        const int NR = NTOK + NMEM;
        f32x4 gx[4], gm[4];
#pragma unroll
        for (int j = 0; j < 4; ++j) { gx[j] = ((const f32x4*)P.in[2])[64 * j + lane]; gm[j] = ((const f32x4*)P.in[10])[64 * j + lane]; }
        for (int m0 = gw; m0 < NR; m0 += 2 * NGW) {
            const int m1 = m0 + NGW; const bool has1 = m1 < NR;
            f32x4 va[4], vb[4];
            { const float* xr = m0 < NTOK ? P.in[0] + (size_t)m0 * 1024 : P.in[1] + (size_t)(m0 - NTOK) * 1024;
#pragma unroll
              for (int j = 0; j < 4; ++j) va[j] = ((const f32x4*)xr)[64 * j + lane]; }
            { const int mm = has1 ? m1 : m0; const float* xr = mm < NTOK ? P.in[0] + (size_t)mm * 1024 : P.in[1] + (size_t)(mm - NTOK) * 1024;
#pragma unroll
              for (int j = 0; j < 4; ++j) vb[j] = ((const f32x4*)xr)[64 * j + lane]; }
#pragma unroll
            for (int rr = 0; rr < 2; ++rr) {
                if (rr == 1 && !has1) break;
                const int m = rr ? m1 : m0; const bool is_x = m < NTOK;
                f32x4 v[4];
#pragma unroll
                for (int j = 0; j < 4; ++j) v[j] = rr ? vb[j] : va[j];
                bf16_t* orow = is_x ? (bf16_t*)(dob + DO_H) + (size_t)m * 1024 : (bf16_t*)(dob + DO_MEMN) + (size_t)(m - NTOK) * 1024;
                float s = 0.f;
#pragma unroll
                for (int j = 0; j < 4; ++j) s += (v[j][0] * v[j][0] + v[j][1] * v[j][1]) + (v[j][2] * v[j][2] + v[j][3] * v[j][3]);
                const float rstd = rsqrtf(wave_sum(s) * (1.0f / 1024.0f) + EPS);
#pragma unroll
                for (int j = 0; j < 4; ++j) { v[j] = v[j] * rstd * (is_x ? gx[j] : gm[j]);
                    u32x2 w; w.x = cvt_pk_bf16(v[j][0], v[j][1]); w.y = cvt_pk_bf16(v[j][2], v[j][3]); ((u32x2*)orow)[64 * j + lane] = w; }
                if (is_x) {
                    float a[16];
#pragma unroll
                    for (int gi = 0; gi < 16; ++gi) { float acc = 0.f;
#pragma unroll
                        for (int j = 0; j < 4; ++j) { const f32x4 t = *(const LAS f32x4*)(tab + gi * 1024 + 256 * j + 4 * lane); acc += (v[j][0] * t[0] + v[j][1] * t[1]) + (v[j][2] * t[2] + v[j][3] * t[3]); }
                        a[gi] = acc; }
                    const bool u32_ = (lane & 32) != 0, u16_ = (lane & 16) != 0, u8_ = (lane & 8) != 0, u4_ = (lane & 4) != 0;
                    float b8[8], c4[4], d2[2];
#pragma unroll
                    for (int i = 0; i < 8; ++i) { const float mine = u32_ ? a[i + 8] : a[i], oth = u32_ ? a[i] : a[i + 8]; b8[i] = mine + __shfl_xor(oth, 32); }
#pragma unroll
                    for (int i = 0; i < 4; ++i) { const float mine = u16_ ? b8[i + 4] : b8[i], oth = u16_ ? b8[i] : b8[i + 4]; c4[i] = mine + __shfl_xor(oth, 16); }
#pragma unroll
                    for (int i = 0; i < 2; ++i) { const float mine = u8_ ? c4[i + 2] : c4[i], oth = u8_ ? c4[i] : c4[i + 2]; d2[i] = mine + __shfl_xor(oth, 8); }
                    float e = (u4_ ? d2[1] : d2[0]) + __shfl_xor(u4_ ? d2[0] : d2[1], 4);
                    e += __shfl_xor(e, 2); e += __shfl_xor(e, 1);
                    if ((lane & 3) == 0) ((float*)(ws + WS_GATES))[(size_t)m * 16 + (lane >> 2)] = e;
                }
            }
        }
    }
}

__device__ __forceinline__ void xa_unit(LAS unsigned char* lds, unsigned char* ws, int unit) {
    const int b = unit >> 5, h = (unit >> 3) & 3, qb = unit & 7;
    int tid_ = threadIdx.x; asm volatile("" : "+v"(tid_)); const int tid = tid_, lane = tid & 63, wid = tid >> 6, r32 = lane & 31, hi = lane >> 5;
    const bf16_t* Kg = (const bf16_t*)(ws + WS_MEMK) + (size_t)(b * 256) * 512 + h * 128;
    const bf16_t* Vg = (const bf16_t*)(ws + WS_MEMVT) + (size_t)(b * 512 + h * 128) * 256;
#ifdef XA_TEST_OUT
    bf16_t* XA_OUT = (bf16_t*)(ws + WS_MLO);
#else
    bf16_t* XA_OUT = (bf16_t*)(ws + WS_XAQ);
#endif
    bf16_t* Q = (bf16_t*)(ws + WS_XAQ);
#pragma unroll
    for (int i = 0; i < 8; ++i) { const int idx = tid + 512 * i; const int row = idx >> 4, ch = idx & 15;
        const u32x4 v = *(const u32x4*)(Kg + (size_t)row * 512 + ch * 8); *(LAS u32x4*)(lds + row * XA_K_PITCH + ch * 16) = v; }
#pragma unroll
    for (int i = 0; i < 8; ++i) { const int idx = tid + 512 * i; const int d = idx >> 5, ch = idx & 31;
        const u32x4 v = *(const u32x4*)(Vg + (size_t)d * 256 + ch * 8); *(LAS u32x4*)(lds + XA_VT_OFF + d * XA_VT_PITCH + ch * 16) = v; }
    const size_t qrow = (size_t)b * 2048 + qb * 256 + wid * 32 + r32;
    bf16x8 qf[8];
#pragma unroll
    for (int s = 0; s < 8; ++s) qf[s] = *(const bf16x8*)(Q + qrow * 512 + h * 128 + 16 * s + 8 * hi);
    __syncthreads();
    const float sc = 0.08838834764831845f * LOG2E;
    f32x16 o[4];
#pragma unroll
    for (int d = 0; d < 4; ++d)
#pragma unroll
        for (int r = 0; r < 16; ++r) o[d][r] = 0.f;
    float mrun = -INFINITY, lsum = 0.f;
    for (int kt = 0; kt < 4; ++kt) {
        f32x16 p[2];
#pragma unroll
        for (int blk = 0; blk < 2; ++blk) {
#pragma unroll
            for (int r = 0; r < 16; ++r) p[blk][r] = 0.f;
            const LAS unsigned char* kp = lds + (64 * kt + 32 * blk + r32) * XA_K_PITCH + hi * 16;
#pragma unroll
            for (int s = 0; s < 8; ++s) { const bf16x8 kf = *(const LAS bf16x8*)(kp + s * 32); p[blk] = __builtin_amdgcn_mfma_f32_32x32x16_bf16(kf, qf[s], p[blk], 0, 0, 0); }
        }
        float tmax = p[0][0];
#pragma unroll
        for (int r = 0; r < 16; ++r) { tmax = fmaxf(tmax, p[0][r]); tmax = fmaxf(tmax, p[1][r]); }
        tmax = fmaxf(tmax, __shfl_xor(tmax, 32));
        const float mnew = fmaxf(mrun, tmax * sc);
        const float alpha = fast_exp2(mrun - mnew);
        mrun = mnew;
        float ps = 0.f;
#pragma unroll
        for (int blk = 0; blk < 2; ++blk)
#pragma unroll
            for (int r = 0; r < 16; ++r) { const float e = fast_exp2(p[blk][r] * sc - mnew); p[blk][r] = e; ps += e; }
        lsum = lsum * alpha + ps;
#pragma unroll
        for (int d = 0; d < 4; ++d)
#pragma unroll
            for (int r = 0; r < 16; ++r) o[d][r] *= alpha;
#pragma unroll
        for (int blk = 0; blk < 2; ++blk)
#pragma unroll
            for (int st = 0; st < 2; ++st) {
                union { bf16x8 v; unsigned u[4]; } pb;
#pragma unroll
                for (int q = 0; q < 4; ++q) pb.u[q] = cvt_pk_bf16(p[blk][8 * st + 2 * q], p[blk][8 * st + 2 * q + 1]);
                const int kbase = 64 * kt + 32 * blk + 16 * st;
#pragma unroll
                for (int d = 0; d < 4; ++d) {
                    const LAS unsigned char* vp = lds + XA_VT_OFF + (32 * d + r32) * XA_VT_PITCH + (kbase + 4 * hi) * 2;
                    union { bf16x8 v; s16x4 h[2]; } va; va.h[0] = *(const LAS s16x4*)vp; va.h[1] = *(const LAS s16x4*)(vp + 16);
                    o[d] = __builtin_amdgcn_mfma_f32_32x32x16_bf16(va.v, pb.v, o[d], 0, 0, 0);
                }
            }
    }
    lsum += __shfl_xor(lsum, 32);
    const float inv = 1.0f / lsum;
#ifdef XA_COPY
    {
#pragma unroll
    for (int d = 0; d < 4; ++d)
#pragma unroll
        for (int g = 0; g < 4; ++g) { u32x2 w;
            if (XA_COPY == 1) { union { bf16x8 v; unsigned u[4]; } t; t.v = qf[(d * 4 + g) >> 1]; w.x = t.u[((d * 4 + g) & 1) * 2]; w.y = t.u[((d * 4 + g) & 1) * 2 + 1]; }
            else if (XA_COPY == 2) { w = *(const LAS u32x2*)(lds + (wid * 32 + r32) * XA_K_PITCH + hi * 128 + (d * 4 + g) * 8); }
            else { const int L = wid * 64 + lane; w = *(const LAS u32x2*)(lds + XA_VT_OFF + (L >> 2) * XA_VT_PITCH + (L & 3) * 128 + (d * 4 + g) * 8); }
            *(u32x2*)(XA_OUT + qrow * 512 + h * 128 + 32 * d + 8 * g + 4 * hi) = w; }
    __syncthreads(); return;
    }
#endif
#pragma unroll
    for (int d = 0; d < 4; ++d)
#pragma unroll
        for (int g = 0; g < 4; ++g) { u32x2 w; w.x = cvt_pk_bf16(o[d][4 * g] * inv, o[d][4 * g + 1] * inv); w.y = cvt_pk_bf16(o[d][4 * g + 2] * inv, o[d][4 * g + 3] * inv);
            *(u32x2*)(XA_OUT + qrow * 512 + h * 128 + 32 * d + 8 * g + 4 * hi) = w; }
    __syncthreads();
}

#define LDS_BARRIER() asm volatile("s_waitcnt lgkmcnt(0)\n\ts_barrier" ::: "memory")
constexpr int NA_VT_OFF = 576 * 128, NA_VT_PITCH = 1168, NA2_RPB_OFF = NA_VT_OFF + 64 * NA_VT_PITCH;
__device__ __forceinline__ void na_unit(LAS unsigned char* lds, unsigned char* ws, const float* rpb_g, int unit) {
    const int b = unit >> 7, h = (unit >> 4) & 7, rp = unit & 15;
    int tid_ = threadIdx.x; asm volatile("" : "+v"(tid_)); const int tid = tid_, lane = tid & 63, wid = tid >> 6, l15 = lane & 15, quad = lane >> 4;
    bf16_t* Q = (bf16_t*)(ws + WS_NAQ); const bf16_t* K = (const bf16_t*)(ws + WS_NAK); const bf16_t* VT = (const bf16_t*)(ws + WS_NAVT);
    const int r0 = 2 * rp, rsA = min(max(r0 - 4, 0), 24);
    const int r = r0 + (wid >> 2), j = wid & 3;
    const int c = 16 * j + l15, kc0 = min(max(16 * j - 8, 0), 32), cs = min(max(c - 8, 0), 48);
    const int rs = min(max(r - 4, 0), 24), dr = rs - rsA;
    const size_t qrow = (size_t)b * 2048 + r * 64 + c;
    bf16x8 qf[2];
    qf[0] = *(const bf16x8*)(Q + qrow * 512 + h * 64 + 8 * quad); qf[1] = *(const bf16x8*)(Q + qrow * 512 + h * 64 + 32 + 8 * quad);
#pragma unroll
    for (int i = 0; i < 9; ++i) { const int p = tid + 512 * i; const int tl = p >> 3, ch = p & 7; const int row = min(rsA + (tl >> 6), 31);
        const u32x4 v = *(const u32x4*)(K + ((size_t)b * 2048 + row * 64 + (tl & 63)) * 512 + h * 64 + ch * 8);
        *(LAS u32x4*)(lds + tl * 128 + ((ch ^ (tl & 7)) << 4)) = v; }
#pragma unroll
    for (int i = 0; i < 9; ++i) { const int p = tid + 512 * i; const int d = p / 72, ch = p - d * 72;
        const u32x4 v = *(const u32x4*)(VT + ((size_t)(b * 512 + h * 64 + d)) * 2048 + rsA * 64 + ch * 8);
        *(LAS u32x4*)(lds + NA_VT_OFF + d * NA_VT_PITCH + ch * 16) = v; }
    if (tid < 465) ((LAS float*)(lds + NA2_RPB_OFF))[tid] = rpb_g[h * 465 + tid];
    LDS_BARRIER();
    const LAS float* rpb = (const LAS float*)(lds + NA2_RPB_OFF);
    f32x4 s[8][2];
#pragma unroll
    for (int kr = 0; kr < 8; ++kr)
#pragma unroll
        for (int hf = 0; hf < 2; ++hf) {
            const int tl = (dr + kr) * 64 + kc0 + 16 * hf + l15;
            const bf16x8 k0 = *(const LAS bf16x8*)(lds + tl * 128 + ((quad ^ (tl & 7)) << 4)), k1 = *(const LAS bf16x8*)(lds + tl * 128 + (((4 + quad) ^ (tl & 7)) << 4));
            f32x4 a = {0.f, 0.f, 0.f, 0.f};
            a = __builtin_amdgcn_mfma_f32_16x16x32_bf16(k0, qf[0], a, 0, 0, 0);
            a = __builtin_amdgcn_mfma_f32_16x16x32_bf16(k1, qf[1], a, 0, 0, 0);
            s[kr][hf] = a;
        }
    float mx = -INFINITY;
#pragma unroll
    for (int kr = 0; kr < 8; ++kr)
#pragma unroll
        for (int hf = 0; hf < 2; ++hf)
#pragma unroll
            for (int i = 0; i < 4; ++i) { const int kc = kc0 + 16 * hf + 4 * quad + i; const bool valid = (kc >= cs) && (kc < cs + 16);
                const int bidx = valid ? ((rs + kr - r + 7) * 31 + (kc - c + 15)) : 0;
                const float t = valid ? (s[kr][hf][i] * 0.125f + rpb[bidx]) * LOG2E : -INFINITY;
                s[kr][hf][i] = t; mx = fmaxf(mx, t); }
    mx = fmaxf(mx, __shfl_xor(mx, 16)); mx = fmaxf(mx, __shfl_xor(mx, 32));
    float sum = 0.f;
#pragma unroll
    for (int kr = 0; kr < 8; ++kr)
#pragma unroll
        for (int hf = 0; hf < 2; ++hf)
#pragma unroll
            for (int i = 0; i < 4; ++i) { const float e = fast_exp2(s[kr][hf][i] - mx); s[kr][hf][i] = e; sum += e; }
    sum += __shfl_xor(sum, 16); sum += __shfl_xor(sum, 32);
    const float inv = 1.0f / sum;
    f32x4 o[4];
#pragma unroll
    for (int db = 0; db < 4; ++db) o[db] = (f32x4){0.f, 0.f, 0.f, 0.f};
#pragma unroll
    for (int kr = 0; kr < 8; ++kr) {
        union { bf16x8 v; unsigned u[4]; } pb;
        pb.u[0] = cvt_pk_bf16(s[kr][0][0], s[kr][0][1]); pb.u[1] = cvt_pk_bf16(s[kr][0][2], s[kr][0][3]);
        pb.u[2] = cvt_pk_bf16(s[kr][1][0], s[kr][1][1]); pb.u[3] = cvt_pk_bf16(s[kr][1][2], s[kr][1][3]);
#pragma unroll
        for (int db = 0; db < 4; ++db) {
            const LAS unsigned char* vp = lds + NA_VT_OFF + (16 * db + l15) * NA_VT_PITCH + ((dr + kr) * 64 + kc0 + 4 * quad) * 2;
            union { bf16x8 v; s16x4 hh[2]; } va; va.hh[0] = *(const LAS s16x4*)vp; va.hh[1] = *(const LAS s16x4*)(vp + 32);
            o[db] = __builtin_amdgcn_mfma_f32_16x16x32_bf16(va.v, pb.v, o[db], 0, 0, 0);
        }
    }
#pragma unroll
    for (int db = 0; db < 4; ++db) { u32x2 w; w.x = cvt_pk_bf16(o[db][0] * inv, o[db][1] * inv); w.y = cvt_pk_bf16(o[db][2] * inv, o[db][3] * inv);
        *(u32x2*)(Q + qrow * 512 + h * 64 + 16 * db + 4 * quad) = w; }
    LDS_BARRIER();
}

__device__ __forceinline__ unsigned pack2(float a, float b) { return cvt_pk_bf16(a, b); }
__device__ __forceinline__ int tsw(int row, int pos) { return row * ML_TP + ((((pos >> 3) ^ (row >> 3)) & 7) << 4) + ((pos & 7) << 1); }
#ifndef TIME_PHASE
#define TIME_PHASE -1
#endif
template <int CTRL, int RM, int BMK> __device__ __forceinline__ float dppf(float old, float src) { return __int_as_float(__builtin_amdgcn_update_dpp(__float_as_int(old), __float_as_int(src), CTRL, RM, BMK, false)); }
__device__ __forceinline__ float wave_scan_add(float v) {
    v += dppf<0x111, 0xf, 0xf>(0.f, v); v += dppf<0x112, 0xf, 0xf>(0.f, v); v += dppf<0x114, 0xf, 0xf>(0.f, v); v += dppf<0x118, 0xf, 0xf>(0.f, v);
    v += dppf<0x142, 0xa, 0xf>(0.f, v); v += dppf<0x143, 0xc, 0xf>(0.f, v); return v; }
__device__ __forceinline__ float wave_scan_max(float v) {
    v = fmaxf(v, dppf<0x111, 0xf, 0xf>(-INFINITY, v)); v = fmaxf(v, dppf<0x112, 0xf, 0xf>(-INFINITY, v)); v = fmaxf(v, dppf<0x114, 0xf, 0xf>(-INFINITY, v)); v = fmaxf(v, dppf<0x118, 0xf, 0xf>(-INFINITY, v));
    v = fmaxf(v, dppf<0x142, 0xa, 0xf>(-INFINITY, v)); v = fmaxf(v, dppf<0x143, 0xc, 0xf>(-INFINITY, v)); return v; }
__device__ __forceinline__ float lane63(float v) { return __int_as_float(__builtin_amdgcn_readlane(__float_as_int(v), 63)); }
#define MLT(k) if (TIME_PHASE == 20 + (k)) { const unsigned long long n_ = __builtin_amdgcn_s_memrealtime(); tacc += n_ - tlast; tlast = n_; } else if (TIME_PHASE >= 20 && TIME_PHASE < 24) { tlast = __builtin_amdgcn_s_memrealtime(); }
__device__ __forceinline__ unsigned long long ml_chain(LAS unsigned char* lds, const Params& P, int chain) {
    unsigned long long tacc = 0, tlast = 0;
    const int b = chain >> 3, h = (chain >> 1) & 3, dir = chain & 1;
    int tid_ = threadIdx.x; asm volatile("" : "+v"(tid_)); const int tid = tid_, lane = tid & 63, w = __builtin_amdgcn_readfirstlane(tid >> 6), l15 = lane & 15, quad = lane >> 4;
    unsigned char* ws = P.ws;
    const bf16_t* MLV = (const bf16_t*)(ws + WS_MLV);
    const float* GATES = (const float*)(ws + WS_GATES);
    bf16_t* HDIR = (bf16_t*)((unsigned char*)P.out + (dir ? DO_HBW : DO_HFW));
    LAS float* NV = (LAS float*)(lds + ML_NV); LAS float* NVP = (LAS float*)(lds + ML_CW); LAS float* ROWSUM = (LAS float*)(lds + ML_ROWSUM);
    LAS float* DENI = (LAS float*)(lds + ML_DENI); LAS float* WTS = (LAS float*)(lds + ML_WTS);
    if (tid < 256) NV[tid] = 0.f;
    f32x4 C[8];
#pragma unroll
    for (int e = 0; e < 8; ++e) C[e] = (f32x4){0.f, 0.f, 0.f, 0.f};
    float m_run = -1e30f;
    const float big = P.in[4][dir * 4 + h], bfg = P.in[5][dir * 4 + h];
    const int cgp = tid & 31, rg = tid >> 5; const bool isk = cgp >= 16; const int c8 = (cgp & 15) * 8;
    const bf16_t* qksrc = (const bf16_t*)((const unsigned char*)P.out + (isk ? DO_KC : DO_QC)) + h * 128 + c8;
    const int vcg = tid & 15, vrg = tid >> 4;
    const size_t brow = (size_t)b * 2048;
    struct MLPF { u32x4 raw[4]; u32x4 vraw[2]; float gi, gf; };
    MLPF pfA;
#define ML_ISSUE(pf, cc) do { const int tb_ = dir ? 2048 - 64 * ((cc) + 1) : 64 * (cc); \
        _Pragma("unroll") for (int i_ = 0; i_ < 4; ++i_) { const int t_ = tb_ + 4 * rg + i_; (pf).raw[i_] = *(const u32x4*)(qksrc + (brow + t_) * 512); } \
        _Pragma("unroll") for (int i_ = 0; i_ < 2; ++i_) { const int t_ = tb_ + 2 * vrg + i_; (pf).vraw[i_] = *(const u32x4*)(MLV + (brow + t_) * 512 + h * 128 + vcg * 8); } \
        { const int t_ = dir ? tb_ + 63 - lane : tb_ + lane; (pf).gi = GATES[(brow + t_) * 16 + (dir * 2) * 4 + h]; (pf).gf = GATES[(brow + t_) * 16 + (dir * 2 + 1) * 4 + h]; } } while (0)
    ML_ISSUE(pfA, 0);
    __syncthreads();
    {
      for (int c = 0; c < 32; ++c) {
        MLPF& pf = pfA;
        u32x4 raw[4], vraw[2];
#pragma unroll
        for (int i_ = 0; i_ < 4; ++i_) raw[i_] = pf.raw[i_];
        vraw[0] = pf.vraw[0]; vraw[1] = pf.vraw[1];
        const float gi_raw = pf.gi, gf_raw = pf.gf;
        const int tb = dir ? 2048 - 64 * (c + 1) : 64 * c; const int par = c & 1;
        MLT(3)
        const float gi = gi_raw + big, gf = gf_raw + bfg;
        const float lf = fminf(gf, 0.f) - __logf(1.0f + fast_exp(-fabsf(gf)));
        const float a = wave_scan_add(lf);
        const float g = lane63(a);
        const float u = gi - a; const float pm = wave_scan_max(u);
        const float mj = a + fmaxf(m_run, pm);
        const float inter_w = fast_exp(a + m_run - mj);
        const float pm63 = lane63(pm); const float m_new = fmaxf(g + m_run, g + pm63);
        const float decay = fast_exp(g + m_run - m_new);
        const float wt = fast_exp(g + u - m_new);
        const float emj = fast_exp(-mj);
        MLT(0)
        if (w == 0) { WTS[lane] = wt; }
        {
            LAS unsigned char* rm = lds + (isk ? ML_KS : ML_QS);
#pragma unroll
            for (int i = 0; i < 4; ++i) { const int p = dir ? 63 - (4 * rg + i) : 4 * rg + i; *(LAS u32x4*)(rm + p * ML_QP + c8 * 2) = raw[i]; }
            if (isk) {
#pragma unroll
                for (int cp = 0; cp < 4; ++cp) {
                    const unsigned t0 = cp == 0 ? raw[0].x : cp == 1 ? raw[0].y : cp == 2 ? raw[0].z : raw[0].w, t1 = cp == 0 ? raw[1].x : cp == 1 ? raw[1].y : cp == 2 ? raw[1].z : raw[1].w;
                    const unsigned t2 = cp == 0 ? raw[2].x : cp == 1 ? raw[2].y : cp == 2 ? raw[2].z : raw[2].w, t3 = cp == 0 ? raw[3].x : cp == 1 ? raw[3].y : cp == 2 ? raw[3].z : raw[3].w;
                    u32x2 lo, hi;
                    if (dir) { lo.x = (t3 & 0xffffu) | (t2 << 16); lo.y = (t1 & 0xffffu) | (t0 << 16); hi.x = (t3 >> 16) | (t2 & 0xffff0000u); hi.y = (t1 >> 16) | (t0 & 0xffff0000u); }
                    else { lo.x = (t0 & 0xffffu) | (t1 << 16); lo.y = (t2 & 0xffffu) | (t3 << 16); hi.x = (t0 >> 16) | (t1 & 0xffff0000u); hi.y = (t2 >> 16) | (t3 & 0xffff0000u); }
                    const int ppos = dir ? 60 - 4 * rg : 4 * rg;
                    *(LAS u32x2*)(lds + ML_KT + tsw(c8 + 2 * cp, ppos)) = lo; *(LAS u32x2*)(lds + ML_KT + tsw(c8 + 2 * cp + 1, ppos)) = hi; }
            }
        }
        {
            const int p0 = dir ? 63 - 2 * vrg : 2 * vrg, p1 = dir ? 62 - 2 * vrg : 2 * vrg + 1;
            const float wt0 = __shfl(wt, p0), wt1 = __shfl(wt, p1);
            float v0[8], v1[8];
            v0[0] = bf_lo(vraw[0].x); v0[1] = bf_hi(vraw[0].x); v0[2] = bf_lo(vraw[0].y); v0[3] = bf_hi(vraw[0].y); v0[4] = bf_lo(vraw[0].z); v0[5] = bf_hi(vraw[0].z); v0[6] = bf_lo(vraw[0].w); v0[7] = bf_hi(vraw[0].w);
            v1[0] = bf_lo(vraw[1].x); v1[1] = bf_hi(vraw[1].x); v1[2] = bf_lo(vraw[1].y); v1[3] = bf_hi(vraw[1].y); v1[4] = bf_lo(vraw[1].z); v1[5] = bf_hi(vraw[1].z); v1[6] = bf_lo(vraw[1].w); v1[7] = bf_hi(vraw[1].w);
            const int pw = dir ? p1 : p0;
#pragma unroll
            for (int ch = 0; ch < 8; ++ch) { const int d = vcg * 8 + ch;
                const unsigned a_ = dir ? pack2(v1[ch], v0[ch]) : pack2(v0[ch], v1[ch]);
                const unsigned b_ = dir ? pack2(v1[ch] * wt1, v0[ch] * wt0) : pack2(v0[ch] * wt0, v1[ch] * wt1);
                *(LAS unsigned*)(lds + ML_VT + tsw(d, pw)) = a_; *(LAS unsigned*)(lds + ML_WVT + tsw(d, pw)) = b_; }
        }
        if (c + 1 < 32) ML_ISSUE(pf, c + 1);
        LDS_BARRIER();
        MLT(1)
#pragma unroll
        for (int bb2 = 0; bb2 < 2; ++bb2) {
            const int id = 2 * w + bb2, jb = id >> 2, sb = id & 3; const int j = 16 * jb + l15;
            if (sb <= jb) {
                f32x4 sacc = {0.f, 0.f, 0.f, 0.f};
#pragma unroll
                for (int st = 0; st < 4; ++st) { const bf16x8 kf = *(const LAS bf16x8*)(lds + ML_KS + (16 * sb + l15) * ML_QP + (32 * st + 8 * quad) * 2);
                    const bf16x8 qf = *(const LAS bf16x8*)(lds + ML_QS + j * ML_QP + (32 * st + 8 * quad) * 2);
                    sacc = __builtin_amdgcn_mfma_f32_16x16x32_bf16(kf, qf, sacc, 0, 0, 0); }
                const float aj = __shfl(a, j), mjj = __shfl(mj, j);
                float pv[4]; float rsum = 0.f;
#pragma unroll
                for (int i = 0; i < 4; ++i) { const int sidx = 16 * sb + 4 * quad + i; const float us = __shfl(u, sidx);
                    const float e = fast_exp(fminf(aj + us - mjj, 0.f)) * sacc[i]; pv[i] = (sidx <= j) ? e : 0.f; rsum += pv[i]; }
                rsum += __shfl_xor(rsum, 16); rsum += __shfl_xor(rsum, 32);
                if (quad == 0) ROWSUM[sb * 64 + j] = rsum;
                u32x2 wv; wv.x = pack2(pv[0], pv[1]); wv.y = pack2(pv[2], pv[3]);
                *(LAS u32x2*)(lds + ML_PS + j * ML_TP + (16 * sb + 4 * quad) * 2) = wv;
            } else {
                *(LAS u32x2*)(lds + ML_PS + j * ML_TP + (16 * sb + 4 * quad) * 2) = (u32x2){0u, 0u}; if (quad == 0) ROWSUM[sb * 64 + j] = 0.f;
            }
        }
        {
            const int j = tid >> 3, eo = (tid & 7) * 16;
            const u32x4 q0 = *(const LAS u32x4*)(lds + ML_QS + j * ML_QP + eo * 2), q1 = *(const LAS u32x4*)(lds + ML_QS + j * ML_QP + eo * 2 + 16);
            const LAS float* nv = NV + par * 128 + eo;
            const f32x4 n0 = *(const LAS f32x4*)(nv), n1 = *(const LAS f32x4*)(nv + 4), n2 = *(const LAS f32x4*)(nv + 8), n3 = *(const LAS f32x4*)(nv + 12);
            float s = bf_lo(q0.x) * n0[0] + bf_hi(q0.x) * n0[1] + bf_lo(q0.y) * n0[2] + bf_hi(q0.y) * n0[3] + bf_lo(q0.z) * n1[0] + bf_hi(q0.z) * n1[1] + bf_lo(q0.w) * n1[2] + bf_hi(q0.w) * n1[3]
                    + bf_lo(q1.x) * n2[0] + bf_hi(q1.x) * n2[1] + bf_lo(q1.y) * n2[2] + bf_hi(q1.y) * n2[3] + bf_lo(q1.z) * n3[0] + bf_hi(q1.z) * n3[1] + bf_lo(q1.w) * n3[2] + bf_hi(q1.w) * n3[3];
            s += __shfl_xor(s, 1); s += __shfl_xor(s, 2); s += __shfl_xor(s, 4);
            if ((tid & 7) == 0) DENI[j] = s;
        }
        f32x4 acc[4];
#pragma unroll
        for (int t4 = 0; t4 < 4; ++t4) acc[t4] = (f32x4){0.f, 0.f, 0.f, 0.f};
#pragma unroll
        for (int st = 0; st < 4; ++st) {
            union { bf16x8 v; unsigned uu[4]; } ca;
            ca.uu[0] = pack2(C[2 * st][0], C[2 * st][1]); ca.uu[1] = pack2(C[2 * st][2], C[2 * st][3]); ca.uu[2] = pack2(C[2 * st + 1][0], C[2 * st + 1][1]); ca.uu[3] = pack2(C[2 * st + 1][2], C[2 * st + 1][3]);
#pragma unroll
            for (int t4 = 0; t4 < 4; ++t4) { const LAS unsigned char* qp = lds + ML_QS + (16 * t4 + l15) * ML_QP + (32 * st + 4 * quad) * 2;
                union { bf16x8 v; s16x4 hh[2]; } qb; qb.hh[0] = *(const LAS s16x4*)qp; qb.hh[1] = *(const LAS s16x4*)(qp + 32);
                acc[t4] = __builtin_amdgcn_mfma_f32_16x16x32_bf16(ca.v, qb.v, acc[t4], 0, 0, 0); }
        }
        { const int e = tid & 127, qq = tid >> 7; float s = 0.f;
#pragma unroll
            for (int q = 0; q < 2; ++q) { const int pos = 16 * qq + 8 * q; const u32x4 kv = *(const LAS u32x4*)(lds + ML_KT + tsw(e, pos)); const f32x4 wa = *(const LAS f32x4*)(WTS + pos), wb = *(const LAS f32x4*)(WTS + pos + 4);
                s += bf_lo(kv.x) * wa[0] + bf_hi(kv.x) * wa[1] + bf_lo(kv.y) * wa[2] + bf_hi(kv.y) * wa[3] + bf_lo(kv.z) * wb[0] + bf_hi(kv.z) * wb[1] + bf_lo(kv.w) * wb[2] + bf_hi(kv.w) * wb[3]; }
            NVP[qq * 128 + e] = s; }
#pragma unroll
        for (int eb = 0; eb < 8; ++eb) { C[eb] = C[eb] * decay;
#pragma unroll
            for (int ks = 0; ks < 2; ++ks) { const bf16x8 ka = *(const LAS bf16x8*)(lds + ML_KT + tsw(16 * eb + l15, 32 * ks + 8 * quad));
                const bf16x8 vb = *(const LAS bf16x8*)(lds + ML_WVT + tsw(16 * w + l15, 32 * ks + 8 * quad));
                C[eb] = __builtin_amdgcn_mfma_f32_16x16x32_bf16(ka, vb, C[eb], 0, 0, 0); } }
        LDS_BARRIER();
        MLT(2)
        if (tid < 128) NV[(par ^ 1) * 128 + tid] = decay * NV[par * 128 + tid] + ((NVP[tid] + NVP[128 + tid]) + (NVP[256 + tid] + NVP[384 + tid]));
#pragma unroll
        for (int t4 = 0; t4 < 4; ++t4) { const int tp = 16 * t4 + l15; const float iw = __shfl(inter_w, tp); const float em = __shfl(emj, tp);
            f32x4 r = acc[t4] * iw;
#pragma unroll
            for (int ks = 0; ks < 2; ++ks) { const bf16x8 va = *(const LAS bf16x8*)(lds + ML_VT + tsw(16 * w + l15, 32 * ks + 8 * quad));
                const bf16x8 pb = *(const LAS bf16x8*)(lds + ML_PS + tp * ML_TP + (32 * ks + 8 * quad) * 2);
                r = __builtin_amdgcn_mfma_f32_16x16x32_bf16(va, pb, r, 0, 0, 0); }
            const float den = ((ROWSUM[tp] + ROWSUM[64 + tp]) + (ROWSUM[128 + tp] + ROWSUM[192 + tp])) + iw * DENI[tp]; const float inv = 1.0f / fmaxf(fabsf(den), em);
            const int t = dir ? tb + 63 - tp : tb + tp;
            { const f32x4 rr = r * inv; u32x2 ov; ov.x = pack2(rr[0], rr[1]); ov.y = pack2(rr[2], rr[3]); *(u32x2*)(HDIR + (brow + t) * 512 + h * 128 + 16 * w + 4 * quad) = ov; } }
        m_run = m_new;
        LDS_BARRIER();
      }
    }
#undef ML_ISSUE
    return tacc;
}

__device__ __forceinline__ void unpack8(const u32x4 v, float* f) { f[0] = bf_lo(v.x); f[1] = bf_hi(v.x); f[2] = bf_lo(v.y); f[3] = bf_hi(v.y); f[4] = bf_lo(v.z); f[5] = bf_hi(v.z); f[6] = bf_lo(v.w); f[7] = bf_hi(v.w); }
__device__ __forceinline__ void p2b_combine(const Params& P, int G) {
    int tid_ = threadIdx.x; asm volatile("" : "+v"(tid_)); const int tid = tid_, lane = tid & 63, wave = tid >> 6; const int gw = blockIdx.x * 8 + wave, NGW = G * 8;
    const bf16_t* HF = (const bf16_t*)((unsigned char*)P.out + DO_HFW); const bf16_t* HB = (const bf16_t*)((unsigned char*)P.out + DO_HBW);
    bf16_t* O = (bf16_t*)(P.ws + WS_MLO); const float* ng = P.in[8];
    float gg[8]; { const f32x4 g0 = *(const f32x4*)(ng + 8 * lane), g1 = *(const f32x4*)(ng + 8 * lane + 4); gg[0] = g0[0]; gg[1] = g0[1]; gg[2] = g0[2]; gg[3] = g0[3]; gg[4] = g1[0]; gg[5] = g1[1]; gg[6] = g1[2]; gg[7] = g1[3]; }
    for (int row = gw; row < NTOK; row += 2 * NGW) {
        const int row2 = row + NGW; const bool has2 = row2 < NTOK;
        const size_t off = (size_t)row * 512 + 8 * lane, off2 = (size_t)(has2 ? row2 : row) * 512 + 8 * lane;
        const u32x4 fa = *(const u32x4*)(HF + off), fb = *(const u32x4*)(HB + off), fo = *(const u32x4*)(O + off);
        const u32x4 fa2 = *(const u32x4*)(HF + off2), fb2 = *(const u32x4*)(HB + off2), fo2 = *(const u32x4*)(O + off2);
#pragma unroll
        for (int rr = 0; rr < 2; ++rr) {
            float a[8], bb[8], o[8]; unpack8(rr ? fa2 : fa, a); unpack8(rr ? fb2 : fb, bb); unpack8(rr ? fo2 : fo, o);
            float ss = 0.f;
#pragma unroll
            for (int i = 0; i < 8; ++i) { a[i] += bb[i]; ss += a[i] * a[i]; }
            ss += __shfl_xor(ss, 1); ss += __shfl_xor(ss, 2); ss += __shfl_xor(ss, 4); ss += __shfl_xor(ss, 8);
            const float rstd = rsqrtf(ss * (1.0f / 128.0f) + EPS);
#pragma unroll
            for (int i = 0; i < 8; ++i) a[i] = a[i] * rstd * gg[i] * sigmoidf_(o[i]);
            u32x4 wv; wv.x = pack2(a[0], a[1]); wv.y = pack2(a[2], a[3]); wv.z = pack2(a[4], a[5]); wv.w = pack2(a[6], a[7]);
            if (rr == 0 || has2) *(u32x4*)(O + (rr ? off2 : off)) = wv;
        }
    }
}
__device__ __forceinline__ void p1b_conv(const Params& P, int G) {
    const bf16_t* MQ = (const bf16_t*)(P.ws + WS_MLQ); const bf16_t* MK = (const bf16_t*)(P.ws + WS_MLK);
    bf16_t* QC = (bf16_t*)((unsigned char*)P.out + DO_QC); bf16_t* KC = (bf16_t*)((unsigned char*)P.out + DO_KC);
    const float* cw = P.in[6]; const float* cb = P.in[7];
    const int nb0 = G >= 64 ? 32 : 0; if ((int)blockIdx.x < nb0) return;
    const int nth = (G - nb0) * 512;
    for (int task = ((int)blockIdx.x - nb0) * 512 + threadIdx.x; task < 2048 * 128; task += nth) {
        const int rgid = task >> 7, cgid = task & 127; const int row0 = 8 * rgid, ch0 = 8 * cgid; const int sp0 = row0 & 2047;
        const bool isk = ch0 >= 512; const float qs = isk ? 1.0f : 0.08838834764831845f;
        float w0[8], w1[8], w2[8], bb[8];
#pragma unroll
        for (int q = 0; q < 2; ++q) { const f32x4 t0 = *(const f32x4*)(cw + ch0 + 4 * q), t1 = *(const f32x4*)(cw + 1024 + ch0 + 4 * q), t2 = *(const f32x4*)(cw + 2048 + ch0 + 4 * q), t3 = *(const f32x4*)(cb + ch0 + 4 * q);
#pragma unroll
            for (int i = 0; i < 4; ++i) { w0[4 * q + i] = t0[i]; w1[4 * q + i] = t1[i]; w2[4 * q + i] = t2[i]; bb[4 * q + i] = t3[i]; } }
        const bf16_t* ap = (isk ? MK + (ch0 - 512) : MQ + ch0) + (size_t)row0 * 512; bf16_t* op = (isk ? KC + (ch0 - 512) : QC + ch0) + (size_t)row0 * 512;
        u32x4 rw[10];
#pragma unroll
        for (int i = 0; i < 10; ++i) { const int sp = sp0 - 1 + i; rw[i] = (sp >= 0 && sp < 2048) ? *(const u32x4*)(ap + (ptrdiff_t)(i - 1) * 512) : (u32x4){0u, 0u, 0u, 0u}; }
        float prev[8], cur[8], nxt[8]; unpack8(rw[0], prev); unpack8(rw[1], cur);
#pragma unroll
        for (int i = 0; i < 8; ++i) {
            unpack8(rw[i + 2], nxt);
            float o[8];
#pragma unroll
            for (int q = 0; q < 8; ++q) { const float y = w0[q] * prev[q] + w1[q] * cur[q] + w2[q] * nxt[q] + bb[q]; o[q] = y * sigmoidf_(y) * qs; prev[q] = cur[q]; cur[q] = nxt[q]; }
            u32x4 wv; wv.x = pack2(o[0], o[1]); wv.y = pack2(o[2], o[3]); wv.z = pack2(o[4], o[5]); wv.w = pack2(o[6], o[7]);
            *(u32x4*)(op + (size_t)i * 512) = wv;
        }
    }
}
__device__ __forceinline__ void p5b_glu(const Params& P, int G) {
    const bf16_t* A = (const bf16_t*)(P.ws + WS_ABUF); bf16_t* U = (bf16_t*)(P.ws + WS_UBUF);
    const float* cw = P.in[19]; const float* cb = P.in[20];
    const int nth = G * 512;
    for (int task = blockIdx.x * 512 + threadIdx.x; task < 2048 * 352; task += nth) {
        const int rgid = task / 352, cgid = task - rgid * 352; const int row0 = 8 * rgid, ch0 = 8 * cgid; const int sp0 = row0 & 2047;
        float w0[8], w1[8], w2[8], bb[8];
#pragma unroll
        for (int q = 0; q < 2; ++q) { const f32x4 t0 = *(const f32x4*)(cw + ch0 + 4 * q), t1 = *(const f32x4*)(cw + 2816 + ch0 + 4 * q), t2 = *(const f32x4*)(cw + 5632 + ch0 + 4 * q), t3 = *(const f32x4*)(cb + ch0 + 4 * q);
#pragma unroll
            for (int i = 0; i < 4; ++i) { w0[4 * q + i] = t0[i]; w1[4 * q + i] = t1[i]; w2[4 * q + i] = t2[i]; bb[4 * q + i] = t3[i]; } }
        const bf16_t* ap = A + (size_t)row0 * 2816 + ch0; bf16_t* up = U + (size_t)row0 * 2816 + ch0;
        u32x4 ra[10], ru[8];
#pragma unroll
        for (int i = 0; i < 10; ++i) { const int sp = sp0 - 1 + i; ra[i] = (sp >= 0 && sp < 2048) ? *(const u32x4*)(ap + (ptrdiff_t)(i - 1) * 2816) : (u32x4){0u, 0u, 0u, 0u}; }
#pragma unroll
        for (int i = 0; i < 8; ++i) ru[i] = *(const u32x4*)(up + (size_t)i * 2816);
        float prev[8], cur[8], nxt[8]; unpack8(ra[0], prev); unpack8(ra[1], cur);
#pragma unroll
        for (int i = 0; i < 8; ++i) {
            unpack8(ra[i + 2], nxt);
            float uu[8]; unpack8(ru[i], uu);
            float o[8];
#pragma unroll
            for (int q = 0; q < 8; ++q) { const float y = w0[q] * prev[q] + w1[q] * cur[q] + w2[q] * nxt[q] + bb[q];
                const float z = 1.5957691216057308f * (y + 0.044715f * y * y * y);
                o[q] = y * sigmoidf_(z) * uu[q]; prev[q] = cur[q]; cur[q] = nxt[q]; }
            u32x4 wv; wv.x = pack2(o[0], o[1]); wv.y = pack2(o[2], o[3]); wv.z = pack2(o[4], o[5]); wv.w = pack2(o[6], o[7]);
            *(u32x4*)(up + (size_t)i * 2816) = wv;
        }
    }
}
__device__ __forceinline__ void p7_final(const Params& P, int G) {
    int tid_ = threadIdx.x; asm volatile("" : "+v"(tid_)); const int tid = tid_, lane = tid & 63, wave = tid >> 6; const int gw = blockIdx.x * 8 + wave, NGW = G * 8;
    const float* gv = P.in[22];
    for (int m = gw; m < NTOK; m += NGW) {
        f32x4* row = (f32x4*)(P.out + (size_t)m * 1024);
        f32x4 v[4]; float s = 0.f;
#pragma unroll
        for (int j = 0; j < 4; ++j) { v[j] = row[64 * j + lane]; s += (v[j][0] * v[j][0] + v[j][1] * v[j][1]) + (v[j][2] * v[j][2] + v[j][3] * v[j][3]); }
        const float rstd = rsqrtf(wave_sum(s) * (1.0f / 1024.0f) + EPS);
#pragma unroll
        for (int j = 0; j < 4; ++j) { const f32x4 g4 = ((const f32x4*)gv)[64 * j + lane]; row[64 * j + lane] = v[j] * rstd * g4; }
    }
}


#define XB_TMO      128
#define XB_XCNT(j)  (256  + 64 * (j))
#define XB_XSUB(j)  (1280 + 64 * (j))
#define XB_XGEN(j)  (2304 + 64 * (j))
#define XB_TOP      3328
#define XB_TOPGEN   3392
#define XCD_BAR_WORDS 3456
#define XB_SPIN_CAP (1u << 18)

__device__ __forceinline__ unsigned xb_ld(unsigned* p)              { return __hip_atomic_load(p, __ATOMIC_RELAXED, __HIP_MEMORY_SCOPE_AGENT); }
__device__ __forceinline__ unsigned xb_add(unsigned* p, unsigned v) { return __hip_atomic_fetch_add(p, v, __ATOMIC_RELAXED, __HIP_MEMORY_SCOPE_AGENT); }
__device__ __forceinline__ unsigned xb_xcc_id() { return (unsigned)__builtin_amdgcn_s_getreg((3 << 11) | 20) & 0xFu; }
#define XB_SPIN(cond, bar) do { unsigned _sp = 0; while (cond) { __builtin_amdgcn_s_sleep(1); \
    if ((++_sp & 255u) == 0u) { if (xb_ld(&(bar)[XB_TMO])) break; if (_sp > XB_SPIN_CAP) { atomicAdd(&(bar)[XB_TMO], 1u); break; } } } } while (0)

struct XcdBarrier {
    unsigned* bar; unsigned x;
    volatile LAS unsigned* st;
};

__device__ __forceinline__ XcdBarrier xcd_barrier_post(unsigned* bar, volatile LAS unsigned* st) {
    XcdBarrier b; b.bar = bar; b.x = xb_xcc_id(); b.st = st;
    if (threadIdx.x == 0) (void)xb_add(&bar[XB_XCNT(b.x)], 1u);
    return b;
}
__device__ __forceinline__ void xcd_barrier_complete(unsigned* bar, unsigned x, unsigned& nloc, unsigned& nx) {
    const unsigned G = gridDim.x * gridDim.y * gridDim.z;
    unsigned sum, cnt, mine, sp = 0u;
    for (;;) {
        sum = 0u; cnt = 0u; mine = 0u;
#pragma unroll
        for (unsigned j = 0; j < 16; ++j) { const unsigned c = xb_ld(&bar[XB_XCNT(j)]); sum += c; cnt += (c > 0u) ? 1u : 0u; mine = (j == x) ? c : mine; }
        if (sum == G) break;
        __builtin_amdgcn_s_sleep(1);
        if ((++sp & 255u) == 0u) { if (xb_ld(&bar[XB_TMO])) break; if (sp > XB_SPIN_CAP) { atomicAdd(&bar[XB_TMO], 1u); break; } }
    }
    nloc = mine > 0u ? mine : 1u; nx = cnt > 0u ? cnt : 1u;
}

__device__ __forceinline__ void xcd_barrier(const XcdBarrier& b) {
    asm volatile("s_waitcnt vmcnt(0)" ::: "memory");
    __syncthreads();
    if (threadIdx.x == 0) {
        unsigned* bar = b.bar;
        __builtin_amdgcn_s_waitcnt(0);
        unsigned nloc = b.st[0], nx = b.st[1];
        if (nloc == 0u) { xcd_barrier_complete(bar, b.x, nloc, nx); b.st[0] = nloc; b.st[1] = nx; }
        const unsigned old = xb_add(&bar[XB_XSUB(b.x)], 1u);
        const unsigned gen = old / nloc;
        if (old + 1u == (gen + 1u) * nloc) {
            __builtin_amdgcn_fence(__ATOMIC_RELEASE, "agent");
            asm volatile("s_waitcnt vmcnt(0)" ::: "memory");
            const unsigned og = xb_add(&bar[XB_TOP], 1u);
            const unsigned tg = og / nx;
            if (og + 1u == (tg + 1u) * nx) xb_add(&bar[XB_TOPGEN], 1u);
            else XB_SPIN(xb_ld(&bar[XB_TOPGEN]) == tg, bar);
            __builtin_amdgcn_fence(__ATOMIC_ACQUIRE, "agent");
            xb_add(&bar[XB_XGEN(b.x)], 1u);
            asm volatile("s_waitcnt vmcnt(0)" ::: "memory");
        } else {
            XB_SPIN(xb_ld(&bar[XB_XGEN(b.x)]) == gen, bar);
            __builtin_amdgcn_fence(__ATOMIC_ACQUIRE, "agent");
            asm volatile("s_waitcnt vmcnt(0)" ::: "memory");
        }
    }
    __syncthreads();
}

#ifndef DBG_CUT
#define DBG_CUT 0
#endif
#ifndef DBG_NOOUT
#define DBG_NOOUT 0
#endif
__device__ __forceinline__ void dbg_dump(const Params& P, int G) {
    const unsigned short* w16 = (const unsigned short*)P.ws; unsigned* o = (unsigned*)P.out;
    for (size_t i = (size_t)blockIdx.x * 512 + threadIdx.x; i < (size_t)NTOK * 1024; i += (size_t)G * 512) {
        const unsigned ob = (DBG_CUT >= 2 && !DBG_NOOUT) ? o[i] : 0u; float s = (float)(ob & 0xffffu) + (float)(ob >> 16);
        for (int k = 0; k < 8; ++k) s += (float)w16[i + (size_t)k * NTOK * 1024];
        P.out[i] = s; }
}
#define GRID_SYNC() xcd_barrier(xbar)
#ifndef TIME_PHASE
#define TIME_PHASE -1
#endif
#define TSTART(n) if (TIME_PHASE == (n)) tt0 = __builtin_amdgcn_s_memrealtime();
#define TEND(n) if (TIME_PHASE == (n)) tt1 = __builtin_amdgcn_s_memrealtime();
#define CUT(n) if (DBG_CUT == (n)) { GRID_SYNC(); dbg_dump(P, G); return; }
__device__ __forceinline__ void sub_barrier(unsigned* cnt, unsigned n) {
    asm volatile("s_waitcnt vmcnt(0)" ::: "memory"); __syncthreads();
    if (threadIdx.x == 0) {
        asm volatile("buffer_wbl2 sc1\n\ts_waitcnt vmcnt(0)" ::: "memory");
        __hip_atomic_fetch_add(cnt, 1u, __ATOMIC_RELAXED, __HIP_MEMORY_SCOPE_AGENT);
        unsigned sp = 0; while (__hip_atomic_load(cnt, __ATOMIC_RELAXED, __HIP_MEMORY_SCOPE_AGENT) < n) { __builtin_amdgcn_s_sleep(4); if (++sp > (1u << 22)) break; }
        __builtin_amdgcn_fence(__ATOMIC_ACQUIRE, "agent"); asm volatile("s_waitcnt vmcnt(0)" ::: "memory");
    }
    __syncthreads();
}
#ifndef PH_LAST
#define PH_LAST 99
#endif
__global__ void __launch_bounds__(512, 2) mega(Params P) {
    extern __shared__ __attribute__((aligned(16))) unsigned char smem[];
    LAS unsigned char* lds = (LAS unsigned char*)smem;
    cg::grid_group grid = cg::this_grid();
    const int G = gridDim.x, bid = blockIdx.x;
    unsigned char* ws = P.ws; unsigned char* dob = (unsigned char*)P.out;
#ifndef PHMASK
#define PHMASK 0xFFFF
#endif
#define PH(n) if ((PHMASK >> (n)) & 1)
    unsigned long long tt0 = 0, tt1 = 0;
    if (threadIdx.x < 2) ((LAS unsigned*)(lds + LDS_XB_OFF))[threadIdx.x] = 0u;
    __syncthreads();
    XcdBarrier xbar = xcd_barrier_post((unsigned*)(ws + WS_XBAR), (volatile LAS unsigned*)(lds + LDS_XB_OFF));
    if (P.ws == nullptr) grid.sync();
    TSTART(0)
    PH(0) p0_prologue(lds, P, G);
    GRID_SYNC();
    TEND(0) TSTART(1)
    PH(1) { pg8::Gemm g{(const bf16_t*)(dob + DO_H), (const bf16_t*)(dob + DO_WINT), NTOK, INW_P, 1024}; pg8::StaticOrder S; S.init(NTOK, INW_P, G, bid);
      EpiProj E{ws, P.in[12], lds}; pg8::gemm_phase<EpiProj, pg8::StaticOrder, true, true>(lds, g, S, E); }
    GRID_SYNC();
    TEND(1) TSTART(2)
    CUT(1)
    PH(2) { pg8::Gemm g{(const bf16_t*)(dob + DO_MEMN), (const bf16_t*)(dob + DO_WMEMKVT), NMEM, 1024, 1024}; pg8::StaticOrder S; S.init(NMEM, 1024, G, bid);
      EpiMemKV E{ws, lds}; pg8::gemm_phase<EpiMemKV, pg8::StaticOrder, true, true>(lds, g, S, E); }
    p1b_conv(P, G);
    GRID_SYNC();
    { if (TIME_PHASE == 10 || TIME_PHASE == 11) tt0 = __builtin_amdgcn_s_memrealtime();
      if (G >= 128) {
          if (bid < 64) { PH(3) { const unsigned long long r_ = ml_chain(lds, P, bid); if (TIME_PHASE >= 20 && TIME_PHASE < 24) { tt0 = 0; tt1 = r_; } } }
          else { { const int wv_ = (int)(threadIdx.x >> 6); weight_items(lds, P, WI_EARLY, WI_ALL, (bid - 64) * 8 + wv_, (G - 64) * 8, wv_, (int)(threadIdx.x & 63)); __syncthreads(); }
              for (int u = bid - 64; u < 1280; u += G - 64) { if (u < 1024) { PH(4) na_unit(lds, ws, P.in[9], u); } else { PH(5) xa_unit(lds, ws, u - 1024); } }
              sub_barrier((unsigned*)(ws + WS_SUBCNT), (unsigned)(G - 64));
              pg8::Gemm g{(const bf16_t*)(ws + WS_MLO), (const bf16_t*)(ws + WS_WBR), 3 * NTOK, 3 * 1024, 512}; BranchOrder S; S.init(G, bid, 2, G - 64, bid - 64);
              EpiBranchAcc E{(bf16_t*)(ws + WS_G), (bf16_t*)(ws + WS_MERGED)};
              pg8::gemm_phase<EpiBranchAcc, BranchOrder, true, true>(lds, g, S, E); }
      } else {
          for (int u = bid; u < 1344; u += G) { if (u < 64) { PH(3) (void)ml_chain(lds, P, u); } else if (u < 1088) { PH(4) na_unit(lds, ws, P.in[9], u - 64); } else { PH(5) xa_unit(lds, ws, u - 1088); } }
      } }
    if ((TIME_PHASE == 10 && bid < 64) || (TIME_PHASE == 11 && bid >= 64)) tt1 = __builtin_amdgcn_s_memrealtime(); else if (TIME_PHASE == 10 || TIME_PHASE == 11) tt1 = tt0;
    GRID_SYNC();
    TEND(2) TSTART(3)
    PH(6) p2b_combine(P, G);
    GRID_SYNC();
    TEND(3) TSTART(4)
    CUT(2)
    PH(7) {
      pg8::Gemm g{(const bf16_t*)(ws + WS_MLO), (const bf16_t*)(ws + WS_WBR), 3 * NTOK, 3 * 1024, 512}; BranchOrder S; S.init(G, bid, G >= 128 ? 0 : 1, 0, 0);
      EpiBranchAcc E{(bf16_t*)(ws + WS_G), (bf16_t*)(ws + WS_MERGED)};
      pg8::gemm_phase<EpiBranchAcc, BranchOrder, true, true>(lds, g, S, E); }
    GRID_SYNC();
    TEND(4) TSTART(5)
    CUT(3)
    PH(8) { pg8::Gemm g{(const bf16_t*)(ws + WS_MERGED), (const bf16_t*)(ws + WS_WOUT), NTOK, 1024, 1024}; pg8::StaticOrder S; S.init(NTOK, 1024, G, bid);
      EpiOut E{P.in[0], P.out, (bf16_t*)(ws + WS_X1B), (float*)(ws + WS_RSS1)}; pg8::gemm_phase<EpiOut, pg8::StaticOrder, true, true>(lds, g, S, E); }
    GRID_SYNC();
    TEND(5) TSTART(6)
    CUT(4)
    PH(9) { pg8::Gemm g{(const bf16_t*)(ws + WS_X1B), (const bf16_t*)(ws + WS_WUP), NTOK, DFF, 1024}; pg8::StaticOrder S; S.init(NTOK, DFF, G, bid);
      EpiUp E{(const float*)(ws + WS_RSS1), (bf16_t*)(ws + WS_ABUF), (bf16_t*)(ws + WS_UBUF)}; pg8::gemm_phase<EpiUp, pg8::StaticOrder, true, true>(lds, g, S, E); }
    GRID_SYNC();
    TEND(6) TSTART(7)
    CUT(5)
    PH(10) { pg8::Gemm g{(const bf16_t*)(ws + WS_X1B), (const bf16_t*)(ws + WS_WUP) + (size_t)DFF * 1024, NTOK, DFF, 1024}; pg8::StaticOrder S; S.init(NTOK, DFF, G, bid);
      EpiUpGlu E{(const float*)(ws + WS_RSS1), (const bf16_t*)(ws + WS_ABUF), (bf16_t*)(ws + WS_UBUF), P.in[19], P.in[20]}; pg8::gemm_phase<EpiUpGlu, pg8::StaticOrder, true, true>(lds, g, S, E); }
    GRID_SYNC();
    TEND(7) TSTART(8)
    CUT(6)
    PH(11) { pg8::Gemm g{(const bf16_t*)(ws + WS_UBUF), (const bf16_t*)(ws + WS_WDOWN), NTOK, 1024, DFF}; pg8::StaticOrder S; S.init(NTOK, 1024, G, bid);
      if (G == 256) { EpiDownNorm E{(const bf16_t*)(ws + WS_X1B), P.in[22], (float*)(ws + WS_SLOTS), (unsigned*)(ws + WS_PCNT), P.out}; pg8::gemm_phase<EpiDownNorm, pg8::StaticOrder, false, true>(lds, g, S, E); }
      else { EpiDown E{(const bf16_t*)(ws + WS_X1B), P.out}; pg8::gemm_phase<EpiDown, pg8::StaticOrder, true, true>(lds, g, S, E); } }
    if (G != 256) { GRID_SYNC(); p7_final(P, G); }
    TEND(9)
#ifdef EXTRA_SYNCS
    for (int i_ = 0; i_ < EXTRA_SYNCS; ++i_) GRID_SYNC();
#endif
    if (TIME_PHASE >= 0) { const unsigned long long ts = __builtin_amdgcn_s_memrealtime(); while (__builtin_amdgcn_s_memrealtime() - ts < (tt1 - tt0)) __builtin_amdgcn_s_sleep(8); }
}

extern "C" void kernel_launch(void* const* d_in, const int* in_sizes, int n_in, void* d_out, int out_size, void* d_ws, size_t ws_size, hipStream_t stream) {
    static int grid = 0;
    if (grid == 0) {
        if (n_in != 23 || out_size != NTOK * DM || ws_size < WS_NEED) { fprintf(stderr, "kernel_launch: unexpected shapes (n_in %d out %d ws %zu)\n", n_in, out_size, ws_size); grid = -1; return; }
        int dev = 0, cus = 0, per_cu = 0;
        hipGetDevice(&dev); hipDeviceGetAttribute(&cus, hipDeviceAttributeMultiprocessorCount, dev);
        hipFuncSetAttribute((const void*)mega, hipFuncAttributeMaxDynamicSharedMemorySize, LDS_BYTES);
        hipOccupancyMaxActiveBlocksPerMultiprocessor(&per_cu, (const void*)mega, 512, LDS_BYTES);
        if (per_cu < 1) { fprintf(stderr, "kernel_launch: occupancy query says %d blocks per CU\n", per_cu); per_cu = 1; }
        grid = cus * 1;
        (void)hipGetLastError();
    }
    if (grid < 0) return;
    Params p{};
    for (int i = 0; i < 23; ++i) p.in[i] = (const float*)d_in[i];
    p.out = (float*)d_out; p.ws = (unsigned char*)d_ws;
    (void)hipMemsetAsync((char*)d_ws + WS_XBAR, 0, WS_CTLBYTES, stream);
    void* args[] = {&p};
    hipError_t e = hipLaunchCooperativeKernel((const void*)mega, dim3(grid), dim3(512), args, LDS_BYTES, stream);
    if (e != hipSuccess) fprintf(stderr, "cooperative launch failed: %s (grid %d)\n", hipGetErrorString(e), grid);
}
```

```cpp
#include <hip/hip_runtime.h>
#include <hip/hip_cooperative_groups.h>
#include <cstdio>
#include <cstdint>
namespace cg = cooperative_groups;

#define LAS __attribute__((address_space(3)))
typedef unsigned short bf16_t;
typedef short bf16x8 __attribute__((ext_vector_type(8)));
typedef short s16x4 __attribute__((ext_vector_type(4)));
typedef float f32x4 __attribute__((ext_vector_type(4)));
typedef float f32x16 __attribute__((ext_vector_type(16)));
typedef unsigned u32x4 __attribute__((ext_vector_type(4)));
typedef unsigned u32x2 __attribute__((ext_vector_type(2)));

typedef float f32x2_t __attribute__((ext_vector_type(2))); typedef __bf16 bf16x2_t __attribute__((ext_vector_type(2)));
__device__ __forceinline__ unsigned cvt_pk_bf16(float lo, float hi) { f32x2_t v = {lo, hi}; bf16x2_t b = __builtin_convertvector(v, bf16x2_t); return __builtin_bit_cast(unsigned, b); }
__device__ __forceinline__ float bf_lo(unsigned w) { return __uint_as_float(w << 16); }
__device__ __forceinline__ float bf_hi(unsigned w) { return __uint_as_float(w & 0xffff0000u); }
__device__ __forceinline__ float fast_exp2(float x) { return __builtin_amdgcn_exp2f(x); }
__device__ __forceinline__ float fast_exp(float x) { return __builtin_amdgcn_exp2f(x * 1.4426950408889634f); }
__device__ __forceinline__ float fast_rcp(float x) { return __builtin_amdgcn_rcpf(x); }
__device__ __forceinline__ float sigmoidf_(float x) { return fast_rcp(1.0f + fast_exp(-x)); }
#define LDS_WAIT() asm volatile("s_waitcnt lgkmcnt(0)" ::: "memory")

namespace pg8 {
#define PG8_LAS __attribute__((address_space(3)))
constexpr int BM = 256, BK = 64, HALF = 128, HTB = HALF * BK * 2, STAGE_BYTES = 8 * HTB, NXCD = 8, WGM = 8;
__host__ __device__ __forceinline__ int lds_byte(int r, int c) { const int st = (r >> 4) * 2 + (c >> 5), rr = r & 15, cc = c & 31, ob = rr * 64 + cc * 2; return st * 1024 + (ob ^ (((ob >> 9) & 1) << 5)); }
__host__ __device__ __forceinline__ void stage_rc(int b, int& R, int& C) { const int st = b / 1024, sb = b % 1024, swz = sb ^ (((sb >> 9) & 1) << 5); R = (st >> 1) * 16 + swz / 64; C = (st & 1) * 32 + (swz % 64) / 2; }
__host__ __device__ __forceinline__ int perm32(int rho) { const int n = rho >> 4, i = rho & 15; return 8 * (i >> 2) + 4 * n + (i & 3); }
struct Unit { int pm, pn; };
struct Gemm { const bf16_t* A; const bf16_t* Bt; int M, N, K; };
struct StaticOrder {
    int nM, nN, nwg, G, c;
    __host__ __device__ void init(int M, int N, int G_, int c_) { nM = M / BM; nN = N / BM; nwg = nM * nN; G = G_; c = c_; }
    __host__ __device__ bool next(int i, Unit& u) const {
        const long L = (long)i * G + c; if (L >= nwg) return false;
        int wgid = (int)L; { const int q = nwg / NXCD, r = nwg % NXCD, xcd = wgid % NXCD, off = wgid / NXCD; wgid = (xcd < r ? xcd * (q + 1) : r * (q + 1) + (xcd - r) * q) + off; }
        const int nig = WGM * nN, gid = wgid / nig, fm = gid * WGM, gsz = (nM - fm) < WGM ? (nM - fm) : WGM;
        u.pm = fm + ((wgid % nig) % gsz); u.pn = (wgid % nig) / gsz; return true;
    }
    __device__ __forceinline__ void a_ready(const Unit&) const {}
    __device__ __forceinline__ void done(const Unit&) const {}
};
template <class Epi, class Sched, bool ALIGN_EPI = false, bool SP2 = false>
__device__ __forceinline__ void gemm_phase(PG8_LAS unsigned char* lds, const Gemm g, const Sched& S, const Epi& E) {
    int tid_ = threadIdx.x; asm volatile("" : "+v"(tid_));
    const int tid = tid_, wid = __builtin_amdgcn_readfirstlane(tid >> 6), lane = tid & 63, wr = wid >> 2, wc = wid & 3, fr = lane & 15, fq = lane >> 4;
    const int K = g.K, nt = K / BK;
    unsigned voffA[2], voffB[2];
#pragma unroll
    for (int i = 0; i < 2; ++i) { int R, C; stage_rc(tid * 16 + i * 8192, R, C); const int Rb = Epi::PERM ? ((R & ~31) + perm32(R & 31)) : R;
        voffA[i] = (unsigned)(R * K + C) * 2u; voffB[i] = (unsigned)(Rb * K + C) * 2u; }
    const size_t kstep = (size_t)(BK * 2);
    const size_t hstep = (size_t)HALF * K * 2;
    const size_t tstep = 2 * hstep;
    const unsigned ldsw = (unsigned)wid * 1024u;
    const int aoff = lds_byte(wr * 64 + fr, fq * 8), boff = lds_byte(wc * 32 + fr, fq * 8);
#define PG8_SA(b, h) (((b) * 2 + (h)) * HTB)
#define PG8_SB(b, h) ((4 + (b) * 2 + (h)) * HTB)
#define PG8_STAGE(bufoff, gbase, voff) do { _Pragma("unroll") for (int _i = 0; _i < 2; ++_i) \
        __builtin_amdgcn_global_load_lds((const unsigned*)((const char*)(gbase) + (voff)[_i]), (PG8_LAS unsigned*)(lds + (bufoff) + ldsw + _i * 8192), 16, 0, 0); } while (0)
#define PG8_LDA(dst, b, h) do { _Pragma("unroll") for (int m = 0; m < 4; ++m) _Pragma("unroll") for (int k = 0; k < 2; ++k) dst[m][k] = *(const PG8_LAS bf16x8*)(lds + PG8_SA(b, h) + aoff + m * 2048 + k * 1024); } while (0)
#define PG8_LDB(dst, b, h) do { _Pragma("unroll") for (int n = 0; n < 2; ++n) _Pragma("unroll") for (int k = 0; k < 2; ++k) dst[n][k] = *(const PG8_LAS bf16x8*)(lds + PG8_SB(b, h) + boff + n * 2048 + k * 1024); } while (0)
#define PG8_MMA(ai, bj, At, Bt) do { __builtin_amdgcn_s_setprio(1); _Pragma("unroll") for (int m = 0; m < 4; ++m) _Pragma("unroll") for (int n = 0; n < 2; ++n) _Pragma("unroll") for (int k = 0; k < 2; ++k) \
        acc[ai][bj][m][n] = __builtin_amdgcn_mfma_f32_16x16x32_bf16(Bt[n][k], At[m][k], acc[ai][bj][m][n], 0, 0, 0); __builtin_amdgcn_s_setprio(0); } while (0)
#define PG8_WAIT_V(n) asm volatile("s_waitcnt vmcnt(" #n ")" ::: "memory")
#define PG8_WAIT_L(n) asm volatile("s_waitcnt lgkmcnt(" #n ")" ::: "memory")
#define PG8_BAR __builtin_amdgcn_s_barrier()
#define PG8_SCHED __builtin_amdgcn_sched_barrier(0)
    Unit cur, nxt; int ui = 0;
    if (!S.next(0, cur)) return;
    f32x4 acc[2][2][4][2];
#pragma unroll
    for (int a = 0; a < 2; ++a)
#pragma unroll
        for (int b = 0; b < 2; ++b)
#pragma unroll
            for (int m = 0; m < 4; ++m)
#pragma unroll
                for (int n = 0; n < 2; ++n) acc[a][b][m][n] = (f32x4){0.f, 0.f, 0.f, 0.f};
    bf16x8 At[4][2], B0[2][2], B1[2][2];
    const char* cA = (const char*)g.A + (size_t)cur.pm * tstep; const char* cB = (const char*)g.Bt + (size_t)cur.pn * tstep;
    S.a_ready(cur);
    if constexpr (SP2) {
        PG8_STAGE(PG8_SB(0, 0), cB, voffB); PG8_STAGE(PG8_SB(0, 1), cB + hstep, voffB); PG8_STAGE(PG8_SA(0, 0), cA, voffA); PG8_STAGE(PG8_SA(0, 1), cA + hstep, voffA);
        if (wr == 1) PG8_BAR;
        PG8_WAIT_V(2); PG8_BAR;
        PG8_STAGE(PG8_SB(1, 0), cB + kstep, voffB); PG8_STAGE(PG8_SA(1, 0), cA + kstep, voffA); PG8_STAGE(PG8_SB(1, 1), cB + hstep + kstep, voffB);
        PG8_WAIT_V(6); PG8_BAR;
    } else {
        PG8_STAGE(PG8_SB(0, 0), cB, voffB); PG8_STAGE(PG8_SA(0, 0), cA, voffA); PG8_STAGE(PG8_SB(0, 1), cB + hstep, voffB); PG8_STAGE(PG8_SA(0, 1), cA + hstep, voffA);
        if (wr == 1) PG8_BAR;
        PG8_WAIT_V(4); PG8_BAR;
        PG8_STAGE(PG8_SB(1, 0), cB + kstep, voffB); PG8_STAGE(PG8_SA(1, 0), cA + kstep, voffA); PG8_STAGE(PG8_SB(1, 1), cB + hstep + kstep, voffB);
        PG8_WAIT_V(6); PG8_BAR;
    }
    for (;;) {
        const bool has_next = S.next(ui + 1, nxt);
        const char* nA = has_next ? (const char*)g.A + (size_t)nxt.pm * tstep : cA; const char* nB = has_next ? (const char*)g.Bt + (size_t)nxt.pn * tstep : cB;
        for (int t = 0; t < nt; t += 2) {
            const bool last = (t == nt - 2);
            const char* a1 = cA + (size_t)(t + 1) * kstep;
            const char* a2 = last ? nA : cA + (size_t)(t + 2) * kstep; const char* b2 = last ? nB : cB + (size_t)(t + 2) * kstep;
            const char* a3 = a2 + kstep; const char* b3 = b2 + kstep;
            if (last && has_next) S.a_ready(nxt);
            if constexpr (SP2) {
            PG8_LDB(B0, 0, 0); PG8_LDB(B1, 0, 1); PG8_SCHED; PG8_LDA(At, 0, 0); PG8_STAGE(PG8_SA(1, 1), a1 + hstep, voffA);
            PG8_WAIT_V(8); PG8_WAIT_L(0); PG8_BAR; PG8_MMA(0, 0, At, B0); PG8_MMA(0, 1, At, B1); PG8_BAR; PG8_SCHED;
            PG8_LDA(At, 0, 1); PG8_STAGE(PG8_SB(0, 0), b2, voffB); PG8_STAGE(PG8_SB(0, 1), b2 + hstep, voffB); PG8_STAGE(PG8_SA(0, 0), a2, voffA);
            PG8_WAIT_V(8); PG8_WAIT_L(0); PG8_BAR; PG8_MMA(1, 0, At, B0); PG8_MMA(1, 1, At, B1); PG8_BAR; PG8_SCHED;
            PG8_LDB(B0, 1, 0); PG8_LDB(B1, 1, 1); PG8_SCHED; PG8_LDA(At, 1, 0); PG8_STAGE(PG8_SA(0, 1), a2 + hstep, voffA);
            PG8_WAIT_V(8); PG8_WAIT_L(0); PG8_BAR; PG8_MMA(0, 0, At, B0); PG8_MMA(0, 1, At, B1); PG8_BAR; PG8_SCHED;
            PG8_LDA(At, 1, 1); PG8_STAGE(PG8_SB(1, 0), b3, voffB); PG8_STAGE(PG8_SB(1, 1), b3 + hstep, voffB); PG8_STAGE(PG8_SA(1, 0), a3, voffA);
            PG8_WAIT_V(8); PG8_WAIT_L(0); PG8_BAR; PG8_MMA(1, 0, At, B0); PG8_MMA(1, 1, At, B1); PG8_BAR; PG8_SCHED;
            } else {
            PG8_LDB(B0, 0, 0); PG8_SCHED; PG8_LDA(At, 0, 0); PG8_STAGE(PG8_SA(1, 1), a1 + hstep, voffA);
            PG8_WAIT_L(8); PG8_BAR; PG8_WAIT_L(0); PG8_MMA(0, 0, At, B0); PG8_BAR; PG8_SCHED;
            PG8_LDB(B1, 0, 1); PG8_STAGE(PG8_SB(0, 0), b2, voffB);
            PG8_BAR; PG8_WAIT_L(0); PG8_MMA(0, 1, At, B1); PG8_BAR;
            PG8_LDA(At, 0, 1); PG8_STAGE(PG8_SA(0, 0), a2, voffA);
            PG8_BAR; PG8_WAIT_L(0); PG8_MMA(1, 0, At, B0); PG8_BAR; PG8_SCHED;
            PG8_STAGE(PG8_SB(0, 1), b2 + hstep, voffB);
            PG8_WAIT_V(6); PG8_BAR; PG8_MMA(1, 1, At, B1); PG8_BAR;
            PG8_LDB(B0, 1, 0); PG8_SCHED; PG8_LDA(At, 1, 0); PG8_STAGE(PG8_SA(0, 1), a2 + hstep, voffA);
            PG8_WAIT_L(8); PG8_BAR; PG8_WAIT_L(0); PG8_MMA(0, 0, At, B0); PG8_BAR; PG8_SCHED;
            PG8_LDB(B1, 1, 1); PG8_STAGE(PG8_SB(1, 0), b3, voffB);
            PG8_BAR; PG8_WAIT_L(0); PG8_MMA(0, 1, At, B1); PG8_BAR;
            PG8_LDA(At, 1, 1); PG8_STAGE(PG8_SA(1, 0), a3, voffA);
            PG8_BAR; PG8_WAIT_L(0); PG8_MMA(1, 0, At, B0); PG8_BAR; PG8_SCHED;
            PG8_STAGE(PG8_SB(1, 1), b3 + hstep, voffB);
            PG8_WAIT_V(6); PG8_BAR; PG8_MMA(1, 1, At, B1); PG8_BAR;
            }
        }
        if constexpr (ALIGN_EPI) { if (wr == 0) PG8_BAR; }
        if constexpr (!Epi::AFTER_DRAIN) { E(acc, cur, wr, wc, fr, fq); S.done(cur); }
        if (!has_next) break;
#pragma unroll
        for (int a = 0; a < 2; ++a)
#pragma unroll
            for (int b = 0; b < 2; ++b)
#pragma unroll
                for (int m = 0; m < 4; ++m)
#pragma unroll
                    for (int n = 0; n < 2; ++n) acc[a][b][m][n] = (f32x4){0.f, 0.f, 0.f, 0.f};
        cur = nxt; cA = nA; cB = nB; ++ui;
        if constexpr (ALIGN_EPI) { if (wr == 1) PG8_BAR; }
    }
    PG8_WAIT_V(0);
    if constexpr (!ALIGN_EPI) { if (wr == 0) PG8_BAR; }
    PG8_BAR;
    if constexpr (Epi::AFTER_DRAIN) { E.fused(acc, cur, wr, wc, fr, fq, lds, wid, lane); S.done(cur); }
#undef PG8_SA
#undef PG8_SB
#undef PG8_STAGE
#undef PG8_LDA
#undef PG8_LDB
#undef PG8_MMA
#undef PG8_WAIT_V
#undef PG8_WAIT_L
#undef PG8_BAR
#undef PG8_SCHED
}
}

constexpr int NTOK = 16384, DM = 1024, SEQ = 2048, NBATCH = 8, MEMLEN = 256, NMEM = NBATCH * MEMLEN, DFF = 2816;
constexpr int INW = 7184, INW_P = 7168;
constexpr float EPS = 1e-6f;
constexpr float LOG2E = 1.4426950408889634f;
constexpr size_t MiB = 1u << 20;
constexpr size_t WS_MLQ = 0, WS_MLK = 16 * MiB, WS_MLV = 32 * MiB, WS_MLO = 48 * MiB, WS_NAQ = 64 * MiB, WS_XAQ = 80 * MiB, WS_NAK = 96 * MiB, WS_NAVT = 112 * MiB, WS_G = 128 * MiB;
constexpr size_t WS_WBR = 224 * MiB, WS_WOUT = 227 * MiB, WS_WUP = 229 * MiB, WS_WDOWN = 240 * MiB, WS_MEMK = 246 * MiB, WS_MEMVT = 248 * MiB, WS_GATES = 250 * MiB, WS_RSS1 = 251 * MiB;
constexpr size_t WS_XBAR = 251 * MiB + 131072;
constexpr size_t WS_PCNT = WS_XBAR + 16384, WS_SUBCNT = WS_XBAR + 32768, WS_CTLBYTES = 32768 + 1024, WS_SLOTS = 251 * MiB + 262144;
constexpr size_t WS_NEED = 252 * MiB;
constexpr size_t WS_TMP = 0, WS_MERGED = WS_NAK, WS_X1B = 0, WS_UBUF = 32 * MiB, WS_ABUF = WS_G;
constexpr size_t DO_H = 0, DO_WINT = 32 * MiB, DO_WMEMKVT = 46 * MiB, DO_MEMN = 48 * MiB, DO_QC = 0, DO_KC = 16 * MiB, DO_HFW = 32 * MiB, DO_HBW = 48 * MiB;
constexpr int LDS_BYTES = 155648;
constexpr int XA_K_PITCH = 272, XA_VT_PITCH = 528, XA_VT_OFF = 256 * XA_K_PITCH;
constexpr int NA_RPB_OFF = 140000;
constexpr int LDS_XB_OFF = 155136;
constexpr int ML_QP = 272, ML_TP = 144;
constexpr int ML_QS = 0, ML_KS = ML_QS + 64 * ML_QP, ML_KT = ML_KS + 64 * ML_QP, ML_VT = ML_KT + 128 * ML_TP, ML_WVT = ML_VT + 128 * ML_TP, ML_PS = ML_WVT + 128 * ML_TP;
constexpr int ML_NV = ML_PS + 64 * ML_TP, ML_ROWSUM = ML_NV + 2 * 128 * 4, ML_DENI = ML_ROWSUM + 1024, ML_WTS = ML_DENI + 256, ML_CW = ML_WTS + 256, ML_END = ML_CW + 4 * 256 * 4;
static_assert(ML_END <= LDS_BYTES, "mlstm lds");

struct Params { const float* in[23]; float* out; unsigned char* ws; };

constexpr int TR_LDS_OFF = 131072, TR_PITCH = 48, TR_WAVE_BYTES = 32 * TR_PITCH;
__device__ __forceinline__ u32x4 tr16x32(PG8_LAS unsigned char* patch, int fr, int fq, int lane, const f32x4 v0, const f32x4 v1) {
    const unsigned w0 = cvt_pk_bf16(v0[0], v0[1]), w1 = cvt_pk_bf16(v0[2], v0[3]), w2 = cvt_pk_bf16(v1[0], v1[1]), w3 = cvt_pk_bf16(v1[2], v1[3]);
    PG8_LAS unsigned short* p = (PG8_LAS unsigned short*)(patch + (8 * fq) * TR_PITCH + fr * 2);
    p[0 * (TR_PITCH / 2)] = (unsigned short)w0; p[1 * (TR_PITCH / 2)] = (unsigned short)(w0 >> 16); p[2 * (TR_PITCH / 2)] = (unsigned short)w1; p[3 * (TR_PITCH / 2)] = (unsigned short)(w1 >> 16);
    p[4 * (TR_PITCH / 2)] = (unsigned short)w2; p[5 * (TR_PITCH / 2)] = (unsigned short)(w2 >> 16); p[6 * (TR_PITCH / 2)] = (unsigned short)w3; p[7 * (TR_PITCH / 2)] = (unsigned short)(w3 >> 16);
    asm volatile("s_waitcnt lgkmcnt(0)" ::: "memory");
    const u32x4 r = *(const PG8_LAS u32x4*)(patch + (lane >> 1) * TR_PITCH + (lane & 1) * 16);
    asm volatile("s_waitcnt lgkmcnt(0)" ::: "memory");
    return r;
}

struct EpiProj {
    static constexpr bool PERM = true, AFTER_DRAIN = false;
    unsigned char* ws; const float* bmerge; PG8_LAS unsigned char* lds;
    __device__ __forceinline__ void operator()(const f32x4 (&acc)[2][2][4][2], const pg8::Unit& u, int wr, int wc, int fr, int fq) const {
        const int row0 = u.pm * 256 + wr * 64 + fr; const int pn = u.pn; const int cl = wc * 32 + 8 * fq;
        if (pn >= 16) {
            bf16_t* G = (bf16_t*)(ws + WS_G); const int cg0 = (pn - 16) * 256 + cl;
            f32x4 bv[2][2];
#pragma unroll
            for (int bj = 0; bj < 2; ++bj)
#pragma unroll
                for (int n = 0; n < 2; ++n) bv[bj][n] = *(const f32x4*)(bmerge + cg0 + bj * 128 + 4 * n);
#pragma unroll
            for (int ai = 0; ai < 2; ++ai)
#pragma unroll
                for (int m = 0; m < 4; ++m) { const size_t row = row0 + ai * 128 + m * 16;
#pragma unroll
                    for (int bj = 0; bj < 2; ++bj) { const f32x4 v0 = acc[ai][bj][m][0] + bv[bj][0], v1 = acc[ai][bj][m][1] + bv[bj][1];
                        u32x4 w; w.x = cvt_pk_bf16(v0[0], v0[1]); w.y = cvt_pk_bf16(v0[2], v0[3]);
                        w.z = cvt_pk_bf16(v1[0], v1[1]); w.w = cvt_pk_bf16(v1[2], v1[3]);
                        *(u32x4*)(G + row * 3072 + cg0 + bj * 128) = w; } }
        } else {
            const int bi = pn >> 1, coff = (pn & 1) * 256 + cl;
            if (bi == 6) {
                bf16_t* VT = (bf16_t*)(ws + WS_NAVT);
                const int lane = fq * 16 + fr; PG8_LAS unsigned char* patch = lds + TR_LDS_OFF + (wr * 4 + wc) * TR_WAVE_BYTES;
#pragma unroll
                for (int ai = 0; ai < 2; ++ai)
#pragma unroll
                    for (int m = 0; m < 4; ++m) { const int rowb = u.pm * 256 + wr * 64 + ai * 128 + m * 16; const int b = rowb >> 11, tok0 = rowb & 2047;
#pragma unroll
                        for (int bj = 0; bj < 2; ++bj) { const u32x4 r = tr16x32(patch, fr, fq, lane, acc[ai][bj][m][0], acc[ai][bj][m][1]);
                            const int col = (pn & 1) * 256 + bj * 128 + wc * 32 + (lane >> 1);
                            *(u32x4*)(VT + ((size_t)(b * 512 + col)) * 2048 + tok0 + (lane & 1) * 8) = r; } }
            } else {
                const size_t boff = bi == 0 ? WS_MLQ : bi == 1 ? WS_MLK : bi == 2 ? WS_MLV : bi == 3 ? WS_MLO : bi == 4 ? WS_NAQ : bi == 5 ? WS_NAK : WS_XAQ;
                bf16_t* O = (bf16_t*)(ws + boff);
#pragma unroll
                for (int ai = 0; ai < 2; ++ai)
#pragma unroll
                    for (int m = 0; m < 4; ++m) { const size_t row = row0 + ai * 128 + m * 16;
#pragma unroll
                        for (int bj = 0; bj < 2; ++bj) { const f32x4 v0 = acc[ai][bj][m][0], v1 = acc[ai][bj][m][1];
                            u32x4 w; w.x = cvt_pk_bf16(v0[0], v0[1]); w.y = cvt_pk_bf16(v0[2], v0[3]); w.z = cvt_pk_bf16(v1[0], v1[1]); w.w = cvt_pk_bf16(v1[2], v1[3]);
                            *(u32x4*)(O + row * 512 + coff + bj * 128) = w; } }
            }
        }
    }
};
struct EpiMemKV {
    static constexpr bool PERM = true, AFTER_DRAIN = false;
    unsigned char* ws; PG8_LAS unsigned char* lds;
    __device__ __forceinline__ void operator()(const f32x4 (&acc)[2][2][4][2], const pg8::Unit& u, int wr, int wc, int fr, int fq) const {
        const int row0 = u.pm * 256 + wr * 64 + fr; const int pn = u.pn; const int coff = (pn & 1) * 256 + wc * 32 + 8 * fq;
        if (pn < 2) { bf16_t* O = (bf16_t*)(ws + WS_MEMK);
#pragma unroll
            for (int ai = 0; ai < 2; ++ai)
#pragma unroll
                for (int m = 0; m < 4; ++m) { const size_t row = row0 + ai * 128 + m * 16;
#pragma unroll
                    for (int bj = 0; bj < 2; ++bj) { const f32x4 v0 = acc[ai][bj][m][0], v1 = acc[ai][bj][m][1];
                        u32x4 w; w.x = cvt_pk_bf16(v0[0], v0[1]); w.y = cvt_pk_bf16(v0[2], v0[3]); w.z = cvt_pk_bf16(v1[0], v1[1]); w.w = cvt_pk_bf16(v1[2], v1[3]);
                        *(u32x4*)(O + row * 512 + coff + bj * 128) = w; } }
        } else { bf16_t* VT = (bf16_t*)(ws + WS_MEMVT);
            const int lane = fq * 16 + fr; PG8_LAS unsigned char* patch = lds + TR_LDS_OFF + (wr * 4 + wc) * TR_WAVE_BYTES;
#pragma unroll
            for (int ai = 0; ai < 2; ++ai)
#pragma unroll
                for (int m = 0; m < 4; ++m) { const int rowb = u.pm * 256 + wr * 64 + ai * 128 + m * 16; const int b = rowb >> 8, mm0 = rowb & 255;
#pragma unroll
                    for (int bj = 0; bj < 2; ++bj) { const u32x4 r = tr16x32(patch, fr, fq, lane, acc[ai][bj][m][0], acc[ai][bj][m][1]);
                        const int col = (pn & 1) * 256 + bj * 128 + wc * 32 + (lane >> 1);
                        *(u32x4*)(VT + ((size_t)(b * 512 + col)) * 256 + mm0 + (lane & 1) * 8) = r; } }
        }
    }
};
template <int MODE> struct EpiBranch {
    static constexpr bool PERM = true, AFTER_DRAIN = false;
    const bf16_t* G; float* tmp; bf16_t* merged; int br;
    __device__ __forceinline__ void operator()(const f32x4 (&acc)[2][2][4][2], const pg8::Unit& u, int wr, int wc, int fr, int fq) const {
        const int row0 = u.pm * 256 + wr * 64 + fr; const int col0 = u.pn * 256 + wc * 32 + 8 * fq;
#pragma unroll
        for (int ai = 0; ai < 2; ++ai)
#pragma unroll
            for (int m = 0; m < 4; ++m) { const size_t row = row0 + ai * 128 + m * 16;
#pragma unroll
                for (int bj = 0; bj < 2; ++bj) { const int col = col0 + bj * 128;
                    const u32x4 gw = *(const u32x4*)(G + row * 3072 + br * 1024 + col);
                    f32x4 v0 = acc[ai][bj][m][0], v1 = acc[ai][bj][m][1];
                    v0[0] *= bf_lo(gw.x); v0[1] *= bf_hi(gw.x); v0[2] *= bf_lo(gw.y); v0[3] *= bf_hi(gw.y);
                    v1[0] *= bf_lo(gw.z); v1[1] *= bf_hi(gw.z); v1[2] *= bf_lo(gw.w); v1[3] *= bf_hi(gw.w);
                    float* tp = tmp + row * 1024 + col;
                    if (MODE >= 1) { v0 += *(const f32x4*)tp; v1 += *(const f32x4*)(tp + 4); }
                    if (MODE <= 1) { *(f32x4*)tp = v0; *(f32x4*)(tp + 4) = v1; }
                    else { u32x4 w; w.x = cvt_pk_bf16(v0[0], v0[1]); w.y = cvt_pk_bf16(v0[2], v0[3]); w.z = cvt_pk_bf16(v1[0], v1[1]); w.w = cvt_pk_bf16(v1[2], v1[3]);
                        *(u32x4*)(merged + row * 1024 + col) = w; } } }
    }
};
struct BranchOrder {
    int G, c, mode, nblk, x;
    __host__ __device__ void init(int G_, int c_, int mode_, int nblk_, int x_) { G = G_; c = c_; mode = mode_; nblk = nblk_; x = x_; }
    __host__ __device__ bool next(int i, pg8::Unit& u) const {
        pg8::StaticOrder base; pg8::Unit t; int br;
        if (mode == 2) { const int q = x + i * nblk; if (q >= 512) return false; br = 1 + (q & 1); base.init(NTOK, 1024, 256, q >> 1); if (!base.next(0, t)) return false; }
        else { if (i >= (mode == 0 ? 1 : 3)) return false; br = mode == 0 ? 0 : (i == 2 ? 0 : i + 1); base.init(NTOK, 1024, G, c); if (!base.next(0, t)) return false; }
        u.pm = br * 64 + t.pm; u.pn = br * 4 + t.pn; return true;
    }
    __device__ __forceinline__ void a_ready(const pg8::Unit&) const {}
    __device__ __forceinline__ void done(const pg8::Unit&) const {}
};
struct EpiBranchAcc {
    static constexpr bool PERM = true, AFTER_DRAIN = false;
    bf16_t* G; bf16_t* merged;
    __device__ __forceinline__ void operator()(const f32x4 (&acc)[2][2][4][2], const pg8::Unit& u, int wr, int wc, int fr, int fq) const {
        const int br = u.pm >> 6, pm = u.pm & 63, pn = u.pn & 3;
        const int row0 = pm * 256 + wr * 64 + fr; const int col0 = pn * 256 + wc * 32 + 8 * fq;
#pragma unroll
        for (int ai = 0; ai < 2; ++ai)
#pragma unroll
          for (int mh = 0; mh < 2; ++mh) {
            u32x4 gw[2][2], p1[2][2], p2[2][2];
#pragma unroll
            for (int mm = 0; mm < 2; ++mm)
#pragma unroll
                for (int bj = 0; bj < 2; ++bj) { const size_t row = row0 + ai * 128 + (2 * mh + mm) * 16; const bf16_t* gp = G + row * 3072 + br * 1024 + col0 + bj * 128;
                    gw[mm][bj] = *(const u32x4*)gp;
                    if (br == 0) { p1[mm][bj] = *(const u32x4*)(gp + 1024); p2[mm][bj] = *(const u32x4*)(gp + 2048); } }
#pragma unroll
            for (int mm = 0; mm < 2; ++mm)
#pragma unroll
                for (int bj = 0; bj < 2; ++bj) { const int m = 2 * mh + mm; const size_t row = row0 + ai * 128 + m * 16; const int col = col0 + bj * 128;
                    const u32x4 g = gw[mm][bj];
                    f32x4 v0 = acc[ai][bj][m][0], v1 = acc[ai][bj][m][1];
                    v0[0] *= sigmoidf_(bf_lo(g.x)); v0[1] *= sigmoidf_(bf_hi(g.x)); v0[2] *= sigmoidf_(bf_lo(g.y)); v0[3] *= sigmoidf_(bf_hi(g.y));
                    v1[0] *= sigmoidf_(bf_lo(g.z)); v1[1] *= sigmoidf_(bf_hi(g.z)); v1[2] *= sigmoidf_(bf_lo(g.w)); v1[3] *= sigmoidf_(bf_hi(g.w));
                    if (br != 0) { u32x4 w; w.x = cvt_pk_bf16(v0[0], v0[1]); w.y = cvt_pk_bf16(v0[2], v0[3]); w.z = cvt_pk_bf16(v1[0], v1[1]); w.w = cvt_pk_bf16(v1[2], v1[3]);
                        *(u32x4*)(G + row * 3072 + br * 1024 + col) = w; }
                    else { const u32x4 q1 = p1[mm][bj], q2 = p2[mm][bj];
                        v0[0] += bf_lo(q1.x) + bf_lo(q2.x); v0[1] += bf_hi(q1.x) + bf_hi(q2.x); v0[2] += bf_lo(q1.y) + bf_lo(q2.y); v0[3] += bf_hi(q1.y) + bf_hi(q2.y);
                        v1[0] += bf_lo(q1.z) + bf_lo(q2.z); v1[1] += bf_hi(q1.z) + bf_hi(q2.z); v1[2] += bf_lo(q1.w) + bf_lo(q2.w); v1[3] += bf_hi(q1.w) + bf_hi(q2.w);
                        u32x4 w; w.x = cvt_pk_bf16(v0[0], v0[1]); w.y = cvt_pk_bf16(v0[2], v0[3]); w.z = cvt_pk_bf16(v1[0], v1[1]); w.w = cvt_pk_bf16(v1[2], v1[3]);
                        *(u32x4*)(merged + row * 1024 + col) = w; } }
          }
    }
};
struct EpiOut {
    static constexpr bool PERM = true, AFTER_DRAIN = false;
    const float* x; float* x1; bf16_t* x1b; float* rss;
    __device__ __forceinline__ void operator()(const f32x4 (&acc)[2][2][4][2], const pg8::Unit& u, int wr, int wc, int fr, int fq) const {
        const int row0 = u.pm * 256 + wr * 64 + fr; const int col0 = u.pn * 256 + wc * 32 + 8 * fq;
#pragma unroll
        for (int ai = 0; ai < 2; ++ai)
#pragma unroll
          for (int mh = 0; mh < 2; ++mh) {
            f32x4 xa[2][2], xb[2][2];
#pragma unroll
            for (int mm = 0; mm < 2; ++mm)
#pragma unroll
                for (int bj = 0; bj < 2; ++bj) { const size_t off = (size_t)(row0 + ai * 128 + (2 * mh + mm) * 16) * 1024 + col0 + bj * 128; xa[mm][bj] = *(const f32x4*)(x + off); xb[mm][bj] = *(const f32x4*)(x + off + 4); }
#pragma unroll
            for (int mm = 0; mm < 2; ++mm) { const int m = 2 * mh + mm; const size_t row = row0 + ai * 128 + m * 16; float ss = 0.f;
#pragma unroll
                for (int bj = 0; bj < 2; ++bj) { const size_t off = row * 1024 + col0 + bj * 128;
                    const f32x4 v0 = acc[ai][bj][m][0] + xa[mm][bj], v1 = acc[ai][bj][m][1] + xb[mm][bj];
                    u32x4 w; w.x = cvt_pk_bf16(v0[0], v0[1]); w.y = cvt_pk_bf16(v0[2], v0[3]); w.z = cvt_pk_bf16(v1[0], v1[1]); w.w = cvt_pk_bf16(v1[2], v1[3]);
                    *(u32x4*)(x1b + off) = w;
                    ss += (v0[0] * v0[0] + v0[1] * v0[1]) + (v0[2] * v0[2] + v0[3] * v0[3]) + (v1[0] * v1[0] + v1[1] * v1[1]) + (v1[2] * v1[2] + v1[3] * v1[3]); }
                ss += __shfl_xor(ss, 16); ss += __shfl_xor(ss, 32);
                if (fq == 0) atomicAdd(rss + row, ss); }
          }
    }
};
struct EpiUp {
    static constexpr bool PERM = true, AFTER_DRAIN = false;
    const float* rss; bf16_t* A; bf16_t* U;
    __device__ __forceinline__ void operator()(const f32x4 (&acc)[2][2][4][2], const pg8::Unit& u, int wr, int wc, int fr, int fq) const {
        const int row0 = u.pm * 256 + wr * 64 + fr; const int pn = u.pn;
        bf16_t* O = pn < 11 ? A : U; const int col0 = (pn < 11 ? pn : pn - 11) * 256 + wc * 32 + 8 * fq;
#pragma unroll
        for (int ai = 0; ai < 2; ++ai)
#pragma unroll
            for (int m = 0; m < 4; ++m) { const size_t row = row0 + ai * 128 + m * 16; const float rstd = rsqrtf(rss[row] * (1.0f / 1024.0f) + EPS);
#pragma unroll
                for (int bj = 0; bj < 2; ++bj) { const f32x4 v0 = acc[ai][bj][m][0] * rstd, v1 = acc[ai][bj][m][1] * rstd;
                    u32x4 w; w.x = cvt_pk_bf16(v0[0], v0[1]); w.y = cvt_pk_bf16(v0[2], v0[3]); w.z = cvt_pk_bf16(v1[0], v1[1]); w.w = cvt_pk_bf16(v1[2], v1[3]);
                    *(u32x4*)(O + row * 2816 + col0 + bj * 128) = w; } }
    }
};
struct EpiUpGlu {
    static constexpr bool PERM = true, AFTER_DRAIN = false;
    const float* rss; const bf16_t* A; bf16_t* Gout; const float* cw; const float* cb;
    __device__ __forceinline__ void operator()(const f32x4 (&acc)[2][2][4][2], const pg8::Unit& u, int wr, int wc, int fr, int fq) const {
        const int row0 = u.pm * 256 + wr * 64 + fr;
#pragma unroll
        for (int bj = 0; bj < 2; ++bj) {
            const int ch0 = u.pn * 256 + bj * 128 + wc * 32 + 8 * fq;
            float w0[8], w1[8], w2[8], bb[8];
#pragma unroll
            for (int q = 0; q < 2; ++q) { const f32x4 t0 = *(const f32x4*)(cw + ch0 + 4 * q), t1 = *(const f32x4*)(cw + 2816 + ch0 + 4 * q), t2 = *(const f32x4*)(cw + 5632 + ch0 + 4 * q), t3 = *(const f32x4*)(cb + ch0 + 4 * q);
#pragma unroll
                for (int i = 0; i < 4; ++i) { w0[4 * q + i] = t0[i]; w1[4 * q + i] = t1[i]; w2[4 * q + i] = t2[i]; bb[4 * q + i] = t3[i]; } }
#pragma unroll
            for (int ai = 0; ai < 2; ++ai)
#pragma unroll
              for (int mh = 0; mh < 2; ++mh) {
                u32x4 am[2], ac[2], an[2]; float rs[2];
#pragma unroll
                for (int mm = 0; mm < 2; ++mm) { const int m = 2 * mh + mm; const size_t row = row0 + ai * 128 + m * 16; const int sp = (int)(row & 2047);
                    const bf16_t* ap = A + row * 2816 + ch0; const u32x4 zc = {0u, 0u, 0u, 0u};
                    ac[mm] = *(const u32x4*)ap; am[mm] = sp > 0 ? *(const u32x4*)(ap - 2816) : zc; an[mm] = sp < 2047 ? *(const u32x4*)(ap + 2816) : zc; rs[mm] = rss[row]; }
#pragma unroll
                for (int mm = 0; mm < 2; ++mm) { const int m = 2 * mh + mm; const size_t row = row0 + ai * 128 + m * 16;
                    const float rstd = rsqrtf(rs[mm] * (1.0f / 1024.0f) + EPS);
                    const float pv[8] = {bf_lo(am[mm].x), bf_hi(am[mm].x), bf_lo(am[mm].y), bf_hi(am[mm].y), bf_lo(am[mm].z), bf_hi(am[mm].z), bf_lo(am[mm].w), bf_hi(am[mm].w)};
                    const float cv[8] = {bf_lo(ac[mm].x), bf_hi(ac[mm].x), bf_lo(ac[mm].y), bf_hi(ac[mm].y), bf_lo(ac[mm].z), bf_hi(ac[mm].z), bf_lo(ac[mm].w), bf_hi(ac[mm].w)};
                    const float nv[8] = {bf_lo(an[mm].x), bf_hi(an[mm].x), bf_lo(an[mm].y), bf_hi(an[mm].y), bf_lo(an[mm].z), bf_hi(an[mm].z), bf_lo(an[mm].w), bf_hi(an[mm].w)};
                    const f32x4 u0 = acc[ai][bj][m][0] * rstd, u1 = acc[ai][bj][m][1] * rstd;
                    float o[8];
#pragma unroll
                    for (int q = 0; q < 8; ++q) { const float y = w0[q] * pv[q] + w1[q] * cv[q] + w2[q] * nv[q] + bb[q];
                        const float z = 1.5957691216057308f * (y + 0.044715f * y * y * y);
                        o[q] = y * sigmoidf_(z) * (q < 4 ? u0[q] : u1[q - 4]); }
                    u32x4 w; w.x = cvt_pk_bf16(o[0], o[1]); w.y = cvt_pk_bf16(o[2], o[3]); w.z = cvt_pk_bf16(o[4], o[5]); w.w = cvt_pk_bf16(o[6], o[7]);
                    *(u32x4*)(Gout + row * 2816 + ch0) = w; }
              }
        }
    }
};
struct EpiDown {
    static constexpr bool PERM = true, AFTER_DRAIN = false;
    const bf16_t* x1; float* outp;
    __device__ __forceinline__ void operator()(const f32x4 (&acc)[2][2][4][2], const pg8::Unit& u, int wr, int wc, int fr, int fq) const {
        const int row0 = u.pm * 256 + wr * 64 + fr; const int col0 = u.pn * 256 + wc * 32 + 8 * fq;
#pragma unroll
        for (int ai = 0; ai < 2; ++ai)
#pragma unroll
            for (int m = 0; m < 4; ++m) { const size_t row = row0 + ai * 128 + m * 16;
#pragma unroll
                for (int bj = 0; bj < 2; ++bj) { const size_t off = row * 1024 + col0 + bj * 128; const u32x4 xw = *(const u32x4*)(x1 + off); float* p = outp + off;
                    const f32x4 v0 = acc[ai][bj][m][0] + (f32x4){bf_lo(xw.x), bf_hi(xw.x), bf_lo(xw.y), bf_hi(xw.y)}, v1 = acc[ai][bj][m][1] + (f32x4){bf_lo(xw.z), bf_hi(xw.z), bf_lo(xw.w), bf_hi(xw.w)};
                    *(f32x4*)p = v0; *(f32x4*)(p + 4) = v1; } }
    }
};

struct EpiDownNorm {
    static constexpr bool PERM = true, AFTER_DRAIN = true;
    const bf16_t* x1; const float* gfin; float* slots; unsigned* cnt; float* outp;
    __device__ __forceinline__ void operator()(const f32x4 (&)[2][2][4][2], const pg8::Unit&, int, int, int, int) const {}
    __device__ __forceinline__ void fused(f32x4 (&acc)[2][2][4][2], const pg8::Unit& u, int wr, int wc, int fr, int fq, PG8_LAS unsigned char* lds, int wid, int lane) const {
        PG8_LAS float* Pt = (PG8_LAS float*)lds;
        PG8_LAS float* St = (PG8_LAS float*)(lds + 4096);
        const int row0 = u.pm * 256 + wr * 64 + fr; const int col0 = u.pn * 256 + wc * 32 + 8 * fq;
#pragma unroll
        for (int ai = 0; ai < 2; ++ai)
#pragma unroll
            for (int m = 0; m < 4; ++m) { const size_t row = row0 + ai * 128 + m * 16; float ss = 0.f;
#pragma unroll
                for (int bj = 0; bj < 2; ++bj) { const u32x4 xw = *(const u32x4*)(x1 + row * 1024 + col0 + bj * 128);
                    const f32x4 v0 = acc[ai][bj][m][0] + (f32x4){bf_lo(xw.x), bf_hi(xw.x), bf_lo(xw.y), bf_hi(xw.y)}, v1 = acc[ai][bj][m][1] + (f32x4){bf_lo(xw.z), bf_hi(xw.z), bf_lo(xw.w), bf_hi(xw.w)};
                    acc[ai][bj][m][0] = v0; acc[ai][bj][m][1] = v1;
                    ss += (v0[0] * v0[0] + v0[1] * v0[1]) + (v0[2] * v0[2] + v0[3] * v0[3]) + (v1[0] * v1[0] + v1[1] * v1[1]) + (v1[2] * v1[2] + v1[3] * v1[3]); }
                ss += __shfl_xor(ss, 16); ss += __shfl_xor(ss, 32);
                if (fq == 0) Pt[(ai * 128 + wr * 64 + m * 16 + fr) * 4 + wc] = ss; }
        asm volatile("s_waitcnt lgkmcnt(0)" ::: "memory"); __builtin_amdgcn_s_barrier(); asm volatile("" ::: "memory");
        const int t = wid * 64 + lane;
        if (t < 256) { const float tot = (Pt[t * 4] + Pt[t * 4 + 1]) + (Pt[t * 4 + 2] + Pt[t * 4 + 3]);
            __hip_atomic_store(slots + ((size_t)(u.pm * 256 + t) * 4 + u.pn), tot, __ATOMIC_RELAXED, __HIP_MEMORY_SCOPE_AGENT); }
        asm volatile("s_waitcnt vmcnt(0)" ::: "memory"); __builtin_amdgcn_s_barrier(); asm volatile("" ::: "memory");
        if (t == 0) { __hip_atomic_fetch_add(cnt + 64 * u.pm, 1u, __ATOMIC_RELAXED, __HIP_MEMORY_SCOPE_AGENT);
            unsigned sp = 0; while (__hip_atomic_load(cnt + 64 * u.pm, __ATOMIC_RELAXED, __HIP_MEMORY_SCOPE_AGENT) < 4u) { __builtin_amdgcn_s_sleep(2); if (++sp > (1u << 22)) break; }
            __builtin_amdgcn_fence(__ATOMIC_ACQUIRE, "agent"); asm volatile("s_waitcnt vmcnt(0)" ::: "memory"); }
        __builtin_amdgcn_s_barrier(); asm volatile("" ::: "memory");
        if (t < 256) { const float* sl = slots + (size_t)(u.pm * 256 + t) * 4;
            const float tot = (__hip_atomic_load(sl, __ATOMIC_RELAXED, __HIP_MEMORY_SCOPE_AGENT) + __hip_atomic_load(sl + 1, __ATOMIC_RELAXED, __HIP_MEMORY_SCOPE_AGENT))
                            + (__hip_atomic_load(sl + 2, __ATOMIC_RELAXED, __HIP_MEMORY_SCOPE_AGENT) + __hip_atomic_load(sl + 3, __ATOMIC_RELAXED, __HIP_MEMORY_SCOPE_AGENT));
            St[t] = rsqrtf(tot * (1.0f / 1024.0f) + EPS); }
        asm volatile("s_waitcnt lgkmcnt(0)" ::: "memory"); __builtin_amdgcn_s_barrier(); asm volatile("" ::: "memory");
        f32x4 gv[2][2];
#pragma unroll
        for (int bj = 0; bj < 2; ++bj) { gv[bj][0] = *(const f32x4*)(gfin + col0 + bj * 128); gv[bj][1] = *(const f32x4*)(gfin + col0 + bj * 128 + 4); }
#pragma unroll
        for (int ai = 0; ai < 2; ++ai)
#pragma unroll
            for (int m = 0; m < 4; ++m) { const int rl = ai * 128 + wr * 64 + m * 16 + fr; const float rstd = St[rl]; const size_t row = (size_t)u.pm * 256 + rl;
#pragma unroll
                for (int bj = 0; bj < 2; ++bj) { float* p = outp + row * 1024 + col0 + bj * 128;
                    *(f32x4*)p = acc[ai][bj][m][0] * rstd * gv[bj][0]; *(f32x4*)(p + 4) = acc[ai][bj][m][1] * rstd * gv[bj][1]; } }
    }
};

__device__ __forceinline__ float wave_sum(float v) {
#pragma unroll
    for (int o = 1; o < 64; o <<= 1) v += __shfl_xor(v, o);
    return v;
}
__device__ __forceinline__ void transpose_item(const float* W, int ldw, int col0, int k0, bf16_t* WT, int K, int row_dst0, const float* kscale, LAS float* scr, int lane) {
    f32x4 v[8];
#pragma unroll
    for (int i = 0; i < 8; ++i) { const int kk = 8 * i + (lane >> 3); v[i] = *(const f32x4*)(W + (size_t)(k0 + kk) * ldw + col0 + (lane & 7) * 4); }
#pragma unroll
    for (int i = 0; i < 8; ++i) { const int kk = 8 * i + (lane >> 3); f32x4 t = v[i]; if (kscale) t = t * kscale[k0 + kk];
        LAS float* d = scr + kk * 33 + (lane & 7) * 4; d[0] = t[0]; d[1] = t[1]; d[2] = t[2]; d[3] = t[3]; }
    LDS_WAIT(); asm volatile("" ::: "memory");
    const int c = lane & 7;
#pragma unroll
    for (int j = 0; j < 4; ++j) { const int n = (lane >> 3) + 8 * j; const LAS float* s = scr + (8 * c) * 33 + n;
        u32x4 o; o.x = cvt_pk_bf16(s[0 * 33], s[1 * 33]); o.y = cvt_pk_bf16(s[2 * 33], s[3 * 33]); o.z = cvt_pk_bf16(s[4 * 33], s[5 * 33]); o.w = cvt_pk_bf16(s[6 * 33], s[7 * 33]);
        *(u32x4*)(WT + (size_t)(row_dst0 + n) * K + k0 + 8 * c) = o; }
    LDS_WAIT(); asm volatile("" ::: "memory");
}
constexpr int WI_IN = 16 * 224, WI_MKV = 16 * 32, WI_BR = 8 * 32, WI_OUT = 16 * 32, WI_UP = 16 * 176, WI_DN = 44 * 32;
constexpr int WI_EARLY = WI_IN + WI_MKV, WI_ALL = WI_IN + WI_MKV + 3 * WI_BR + WI_OUT + WI_UP + WI_DN;
__device__ __forceinline__ void weight_items(LAS unsigned char* lds, const Params& P, int it_begin, int it_end, int gw, int NGW, int wave, int lane) {
    unsigned char* ws = P.ws; unsigned char* dob = (unsigned char*)P.out;
    LAS float* scr = (LAS float*)(lds + wave * 8448);
    constexpr int I_IN = WI_IN, I_MKV = WI_MKV, I_BR = WI_BR, I_OUT = WI_OUT, I_UP = WI_UP;
    for (int it = it_begin + gw; it < it_end; it += NGW) {
        int r = it;
        if (r < I_IN) { const int kb = r / 224, nb = r % 224, n0 = 32 * nb; transpose_item(P.in[3], INW, n0 + (n0 >= 2048 ? 16 : 0), 64 * kb, (bf16_t*)(dob + DO_WINT), 1024, n0, nullptr, scr, lane); continue; } r -= I_IN;
        if (r < I_MKV) { const int kb = r / 32, nb = r % 32; transpose_item(P.in[11], 1024, 32 * nb, 64 * kb, (bf16_t*)(dob + DO_WMEMKVT), 1024, 32 * nb, nullptr, scr, lane); continue; } r -= I_MKV;
        if (r < 3 * I_BR) { const int br = r / I_BR; r -= br * I_BR; const int kb = r / 32, nb = r % 32; transpose_item(P.in[13 + br], 1024, 32 * nb, 64 * kb, (bf16_t*)(ws + WS_WBR + br * MiB), 512, 32 * nb, nullptr, scr, lane); continue; } r -= 3 * I_BR;
        if (r < I_OUT) { const int kb = r / 32, nb = r % 32; transpose_item(P.in[16], 1024, 32 * nb, 64 * kb, (bf16_t*)(ws + WS_WOUT), 1024, 32 * nb, nullptr, scr, lane); continue; } r -= I_OUT;
        if (r < I_UP) { const int kb = r / 176, nb = r % 176; transpose_item(P.in[18], 5632, 32 * nb, 64 * kb, (bf16_t*)(ws + WS_WUP), 1024, 32 * nb, P.in[17], scr, lane); continue; } r -= I_UP;
        { const int kb = r / 32, nb = r % 32; transpose_item(P.in[21], 1024, 32 * nb, 64 * kb, (bf16_t*)(ws + WS_WDOWN), 2816, 32 * nb, nullptr, scr, lane); }
    }
}
__device__ __forceinline__ void p0_prologue(LAS unsigned char* lds, const Params& P, int G) {
    int tid_ = threadIdx.x; asm volatile("" : "+v"(tid_)); const int tid = tid_, lane = tid & 63, wave = tid >> 6;
    const int gw = blockIdx.x * 8 + wave, NGW = G * 8;
    unsigned char* ws = P.ws; unsigned char* dob = (unsigned char*)P.out;
    LAS float* scr = (LAS float*)(lds + wave * 8448);
    LAS float* tab = (LAS float*)(lds + 8 * 8448);
    { const float* win = P.in[3];
      for (int k = tid; k < 1024; k += 512) {
          const f32x4* src = (const f32x4*)(win + (size_t)k * INW + 2048);
#pragma unroll
          for (int q = 0; q < 4; ++q) { const f32x4 v = src[q]; tab[(4 * q + 0) * 1024 + k] = v[0]; tab[(4 * q + 1) * 1024 + k] = v[1]; tab[(4 * q + 2) * 1024 + k] = v[2]; tab[(4 * q + 3) * 1024 + k] = v[3]; } } }
    { float* rss = (float*)(ws + WS_RSS1); for (int i = blockIdx.x * 512 + tid; i < NTOK; i += G * 512) rss[i] = 0.f; }
    weight_items(lds, P, 0, G >= 128 ? WI_EARLY : WI_ALL, gw, NGW, wave, lane);
    __syncthreads();
    {
        const int NR = NTOK + NMEM;
        f32x4 gx[4], gm[4];
#pragma unroll
        for (int j = 0; j < 4; ++j) { gx[j] = ((const f32x4*)P.in[2])[64 * j + lane]; gm[j] = ((const f32x4*)P.in[10])[64 * j + lane]; }
        for (int m0 = gw; m0 < NR; m0 += 2 * NGW) {
            const int m1 = m0 + NGW; const bool has1 = m1 < NR;
            f32x4 va[4], vb[4];
            { const float* xr = m0 < NTOK ? P.in[0] + (size_t)m0 * 1024 : P.in[1] + (size_t)(m0 - NTOK) * 1024;
#pragma unroll
              for (int j = 0; j < 4; ++j) va[j] = ((const f32x4*)xr)[64 * j + lane]; }
            { const int mm = has1 ? m1 : m0; const float* xr = mm < NTOK ? P.in[0] + (size_t)mm * 1024 : P.in[1] + (size_t)(mm - NTOK) * 1024;
#pragma unroll
              for (int j = 0; j < 4; ++j) vb[j] = ((const f32x4*)xr)[64 * j + lane]; }
#pragma unroll
            for (int rr = 0; rr < 2; ++rr) {
                if (rr == 1 && !has1) break;
                const int m = rr ? m1 : m0; const bool is_x = m < NTOK;
                f32x4 v[4];
#pragma unroll
                for (int j = 0; j < 4; ++j) v[j] = rr ? vb[j] : va[j];
                bf16_t* orow = is_x ? (bf16_t*)(dob + DO_H) + (size_t)m * 1024 : (bf16_t*)(dob + DO_MEMN) + (size_t)(m - NTOK) * 1024;
                float s = 0.f;
#pragma unroll
                for (int j = 0; j < 4; ++j) s += (v[j][0] * v[j][0] + v[j][1] * v[j][1]) + (v[j][2] * v[j][2] + v[j][3] * v[j][3]);
                const float rstd = rsqrtf(wave_sum(s) * (1.0f / 1024.0f) + EPS);
#pragma unroll
                for (int j = 0; j < 4; ++j) { v[j] = v[j] * rstd * (is_x ? gx[j] : gm[j]);
                    u32x2 w; w.x = cvt_pk_bf16(v[j][0], v[j][1]); w.y = cvt_pk_bf16(v[j][2], v[j][3]); ((u32x2*)orow)[64 * j + lane] = w; }
                if (is_x) {
                    float a[16];
#pragma unroll
                    for (int gi = 0; gi < 16; ++gi) { float acc = 0.f;
#pragma unroll
                        for (int j = 0; j < 4; ++j) { const f32x4 t = *(const LAS f32x4*)(tab + gi * 1024 + 256 * j + 4 * lane); acc += (v[j][0] * t[0] + v[j][1] * t[1]) + (v[j][2] * t[2] + v[j][3] * t[3]); }
                        a[gi] = acc; }
                    const bool u32_ = (lane & 32) != 0, u16_ = (lane & 16) != 0, u8_ = (lane & 8) != 0, u4_ = (lane & 4) != 0;
                    float b8[8], c4[4], d2[2];
#pragma unroll
                    for (int i = 0; i < 8; ++i) { const float mine = u32_ ? a[i + 8] : a[i], oth = u32_ ? a[i] : a[i + 8]; b8[i] = mine + __shfl_xor(oth, 32); }
#pragma unroll
                    for (int i = 0; i < 4; ++i) { const float mine = u16_ ? b8[i + 4] : b8[i], oth = u16_ ? b8[i] : b8[i + 4]; c4[i] = mine + __shfl_xor(oth, 16); }
#pragma unroll
                    for (int i = 0; i < 2; ++i) { const float mine = u8_ ? c4[i + 2] : c4[i], oth = u8_ ? c4[i] : c4[i + 2]; d2[i] = mine + __shfl_xor(oth, 8); }
                    float e = (u4_ ? d2[1] : d2[0]) + __shfl_xor(u4_ ? d2[0] : d2[1], 4);
                    e += __shfl_xor(e, 2); e += __shfl_xor(e, 1);
                    if ((lane & 3) == 0) ((float*)(ws + WS_GATES))[(size_t)m * 16 + (lane >> 2)] = e;
                }
            }
        }
    }
}

__device__ __forceinline__ void xa_unit(LAS unsigned char* lds, unsigned char* ws, int unit) {
    const int b = unit >> 5, h = (unit >> 3) & 3, qb = unit & 7;
    int tid_ = threadIdx.x; asm volatile("" : "+v"(tid_)); const int tid = tid_, lane = tid & 63, wid = tid >> 6, r32 = lane & 31, hi = lane >> 5;
    const bf16_t* Kg = (const bf16_t*)(ws + WS_MEMK) + (size_t)(b * 256) * 512 + h * 128;
    const bf16_t* Vg = (const bf16_t*)(ws + WS_MEMVT) + (size_t)(b * 512 + h * 128) * 256;
#ifdef XA_TEST_OUT
    bf16_t* XA_OUT = (bf16_t*)(ws + WS_MLO);
#else
    bf16_t* XA_OUT = (bf16_t*)(ws + WS_XAQ);
#endif
    bf16_t* Q = (bf16_t*)(ws + WS_XAQ);
#pragma unroll
    for (int i = 0; i < 8; ++i) { const int idx = tid + 512 * i; const int row = idx >> 4, ch = idx & 15;
        const u32x4 v = *(const u32x4*)(Kg + (size_t)row * 512 + ch * 8); *(LAS u32x4*)(lds + row * XA_K_PITCH + ch * 16) = v; }
#pragma unroll
    for (int i = 0; i < 8; ++i) { const int idx = tid + 512 * i; const int d = idx >> 5, ch = idx & 31;
        const u32x4 v = *(const u32x4*)(Vg + (size_t)d * 256 + ch * 8); *(LAS u32x4*)(lds + XA_VT_OFF + d * XA_VT_PITCH + ch * 16) = v; }
    const size_t qrow = (size_t)b * 2048 + qb * 256 + wid * 32 + r32;
    bf16x8 qf[8];
#pragma unroll
    for (int s = 0; s < 8; ++s) qf[s] = *(const bf16x8*)(Q + qrow * 512 + h * 128 + 16 * s + 8 * hi);
    __syncthreads();
    const float sc = 0.08838834764831845f * LOG2E;
    f32x16 o[4];
#pragma unroll
    for (int d = 0; d < 4; ++d)
#pragma unroll
        for (int r = 0; r < 16; ++r) o[d][r] = 0.f;
    float mrun = -INFINITY, lsum = 0.f;
    for (int kt = 0; kt < 4; ++kt) {
        f32x16 p[2];
#pragma unroll
        for (int blk = 0; blk < 2; ++blk) {
#pragma unroll
            for (int r = 0; r < 16; ++r) p[blk][r] = 0.f;
            const LAS unsigned char* kp = lds + (64 * kt + 32 * blk + r32) * XA_K_PITCH + hi * 16;
#pragma unroll
            for (int s = 0; s < 8; ++s) { const bf16x8 kf = *(const LAS bf16x8*)(kp + s * 32); p[blk] = __builtin_amdgcn_mfma_f32_32x32x16_bf16(kf, qf[s], p[blk], 0, 0, 0); }
        }
        float tmax = p[0][0];
#pragma unroll
        for (int r = 0; r < 16; ++r) { tmax = fmaxf(tmax, p[0][r]); tmax = fmaxf(tmax, p[1][r]); }
        tmax = fmaxf(tmax, __shfl_xor(tmax, 32));
        const float mnew = fmaxf(mrun, tmax * sc);
        const float alpha = fast_exp2(mrun - mnew);
        mrun = mnew;
        float ps = 0.f;
#pragma unroll
        for (int blk = 0; blk < 2; ++blk)
#pragma unroll
            for (int r = 0; r < 16; ++r) { const float e = fast_exp2(p[blk][r] * sc - mnew); p[blk][r] = e; ps += e; }
        lsum = lsum * alpha + ps;
#pragma unroll
        for (int d = 0; d < 4; ++d)
#pragma unroll
            for (int r = 0; r < 16; ++r) o[d][r] *= alpha;
#pragma unroll
        for (int blk = 0; blk < 2; ++blk)
#pragma unroll
            for (int st = 0; st < 2; ++st) {
                union { bf16x8 v; unsigned u[4]; } pb;
#pragma unroll
                for (int q = 0; q < 4; ++q) pb.u[q] = cvt_pk_bf16(p[blk][8 * st + 2 * q], p[blk][8 * st + 2 * q + 1]);
                const int kbase = 64 * kt + 32 * blk + 16 * st;
#pragma unroll
                for (int d = 0; d < 4; ++d) {
                    const LAS unsigned char* vp = lds + XA_VT_OFF + (32 * d + r32) * XA_VT_PITCH + (kbase + 4 * hi) * 2;
                    union { bf16x8 v; s16x4 h[2]; } va; va.h[0] = *(const LAS s16x4*)vp; va.h[1] = *(const LAS s16x4*)(vp + 16);
                    o[d] = __builtin_amdgcn_mfma_f32_32x32x16_bf16(va.v, pb.v, o[d], 0, 0, 0);
                }
            }
    }
    lsum += __shfl_xor(lsum, 32);
    const float inv = 1.0f / lsum;
#ifdef XA_COPY
    {
#pragma unroll
    for (int d = 0; d < 4; ++d)
#pragma unroll
        for (int g = 0; g < 4; ++g) { u32x2 w;
            if (XA_COPY == 1) { union { bf16x8 v; unsigned u[4]; } t; t.v = qf[(d * 4 + g) >> 1]; w.x = t.u[((d * 4 + g) & 1) * 2]; w.y = t.u[((d * 4 + g) & 1) * 2 + 1]; }
            else if (XA_COPY == 2) { w = *(const LAS u32x2*)(lds + (wid * 32 + r32) * XA_K_PITCH + hi * 128 + (d * 4 + g) * 8); }
            else { const int L = wid * 64 + lane; w = *(const LAS u32x2*)(lds + XA_VT_OFF + (L >> 2) * XA_VT_PITCH + (L & 3) * 128 + (d * 4 + g) * 8); }
            *(u32x2*)(XA_OUT + qrow * 512 + h * 128 + 32 * d + 8 * g + 4 * hi) = w; }
    __syncthreads(); return;
    }
#endif
#pragma unroll
    for (int d = 0; d < 4; ++d)
#pragma unroll
        for (int g = 0; g < 4; ++g) { u32x2 w; w.x = cvt_pk_bf16(o[d][4 * g] * inv, o[d][4 * g + 1] * inv); w.y = cvt_pk_bf16(o[d][4 * g + 2] * inv, o[d][4 * g + 3] * inv);
            *(u32x2*)(XA_OUT + qrow * 512 + h * 128 + 32 * d + 8 * g + 4 * hi) = w; }
    __syncthreads();
}

#define LDS_BARRIER() asm volatile("s_waitcnt lgkmcnt(0)\n\ts_barrier" ::: "memory")
constexpr int NA_VT_OFF = 576 * 128, NA_VT_PITCH = 1168, NA2_RPB_OFF = NA_VT_OFF + 64 * NA_VT_PITCH;
__device__ __forceinline__ void na_unit(LAS unsigned char* lds, unsigned char* ws, const float* rpb_g, int unit) {
    const int b = unit >> 7, h = (unit >> 4) & 7, rp = unit & 15;
    int tid_ = threadIdx.x; asm volatile("" : "+v"(tid_)); const int tid = tid_, lane = tid & 63, wid = tid >> 6, l15 = lane & 15, quad = lane >> 4;
    bf16_t* Q = (bf16_t*)(ws + WS_NAQ); const bf16_t* K = (const bf16_t*)(ws + WS_NAK); const bf16_t* VT = (const bf16_t*)(ws + WS_NAVT);
    const int r0 = 2 * rp, rsA = min(max(r0 - 4, 0), 24);
    const int r = r0 + (wid >> 2), j = wid & 3;
    const int c = 16 * j + l15, kc0 = min(max(16 * j - 8, 0), 32), cs = min(max(c - 8, 0), 48);
    const int rs = min(max(r - 4, 0), 24), dr = rs - rsA;
    const size_t qrow = (size_t)b * 2048 + r * 64 + c;
    bf16x8 qf[2];
    qf[0] = *(const bf16x8*)(Q + qrow * 512 + h * 64 + 8 * quad); qf[1] = *(const bf16x8*)(Q + qrow * 512 + h * 64 + 32 + 8 * quad);
#pragma unroll
    for (int i = 0; i < 9; ++i) { const int p = tid + 512 * i; const int tl = p >> 3, ch = p & 7; const int row = min(rsA + (tl >> 6), 31);
        const u32x4 v = *(const u32x4*)(K + ((size_t)b * 2048 + row * 64 + (tl & 63)) * 512 + h * 64 + ch * 8);
        *(LAS u32x4*)(lds + tl * 128 + ((ch ^ (tl & 7)) << 4)) = v; }
#pragma unroll
    for (int i = 0; i < 9; ++i) { const int p = tid + 512 * i; const int d = p / 72, ch = p - d * 72;
        const u32x4 v = *(const u32x4*)(VT + ((size_t)(b * 512 + h * 64 + d)) * 2048 + rsA * 64 + ch * 8);
        *(LAS u32x4*)(lds + NA_VT_OFF + d * NA_VT_PITCH + ch * 16) = v; }
    if (tid < 465) ((LAS float*)(lds + NA2_RPB_OFF))[tid] = rpb_g[h * 465 + tid];
    LDS_BARRIER();
    const LAS float* rpb = (const LAS float*)(lds + NA2_RPB_OFF);
    f32x4 s[8][2];
#pragma unroll
    for (int kr = 0; kr < 8; ++kr)
#pragma unroll
        for (int hf = 0; hf < 2; ++hf) {
            const int tl = (dr + kr) * 64 + kc0 + 16 * hf + l15;
            const bf16x8 k0 = *(const LAS bf16x8*)(lds + tl * 128 + ((quad ^ (tl & 7)) << 4)), k1 = *(const LAS bf16x8*)(lds + tl * 128 + (((4 + quad) ^ (tl & 7)) << 4));
            f32x4 a = {0.f, 0.f, 0.f, 0.f};
            a = __builtin_amdgcn_mfma_f32_16x16x32_bf16(k0, qf[0], a, 0, 0, 0);
            a = __builtin_amdgcn_mfma_f32_16x16x32_bf16(k1, qf[1], a, 0, 0, 0);
            s[kr][hf] = a;
        }
    float mx = -INFINITY;
#pragma unroll
    for (int kr = 0; kr < 8; ++kr)
#pragma unroll
        for (int hf = 0; hf < 2; ++hf)
#pragma unroll
            for (int i = 0; i < 4; ++i) { const int kc = kc0 + 16 * hf + 4 * quad + i; const bool valid = (kc >= cs) && (kc < cs + 16);
                const int bidx = valid ? ((rs + kr - r + 7) * 31 + (kc - c + 15)) : 0;
                const float t = valid ? (s[kr][hf][i] * 0.125f + rpb[bidx]) * LOG2E : -INFINITY;
                s[kr][hf][i] = t; mx = fmaxf(mx, t); }
    mx = fmaxf(mx, __shfl_xor(mx, 16)); mx = fmaxf(mx, __shfl_xor(mx, 32));
    float sum = 0.f;
#pragma unroll
    for (int kr = 0; kr < 8; ++kr)
#pragma unroll
        for (int hf = 0; hf < 2; ++hf)
#pragma unroll
            for (int i = 0; i < 4; ++i) { const float e = fast_exp2(s[kr][hf][i] - mx); s[kr][hf][i] = e; sum += e; }
    sum += __shfl_xor(sum, 16); sum += __shfl_xor(sum, 32);
    const float inv = 1.0f / sum;
    f32x4 o[4];
#pragma unroll
    for (int db = 0; db < 4; ++db) o[db] = (f32x4){0.f, 0.f, 0.f, 0.f};
#pragma unroll
    for (int kr = 0; kr < 8; ++kr) {
        union { bf16x8 v; unsigned u[4]; } pb;
        pb.u[0] = cvt_pk_bf16(s[kr][0][0], s[kr][0][1]); pb.u[1] = cvt_pk_bf16(s[kr][0][2], s[kr][0][3]);
        pb.u[2] = cvt_pk_bf16(s[kr][1][0], s[kr][1][1]); pb.u[3] = cvt_pk_bf16(s[kr][1][2], s[kr][1][3]);
#pragma unroll
        for (int db = 0; db < 4; ++db) {
            const LAS unsigned char* vp = lds + NA_VT_OFF + (16 * db + l15) * NA_VT_PITCH + ((dr + kr) * 64 + kc0 + 4 * quad) * 2;
            union { bf16x8 v; s16x4 hh[2]; } va; va.hh[0] = *(const LAS s16x4*)vp; va.hh[1] = *(const LAS s16x4*)(vp + 32);
            o[db] = __builtin_amdgcn_mfma_f32_16x16x32_bf16(va.v, pb.v, o[db], 0, 0, 0);
        }
    }
#pragma unroll
    for (int db = 0; db < 4; ++db) { u32x2 w; w.x = cvt_pk_bf16(o[db][0] * inv, o[db][1] * inv); w.y = cvt_pk_bf16(o[db][2] * inv, o[db][3] * inv);
        *(u32x2*)(Q + qrow * 512 + h * 64 + 16 * db + 4 * quad) = w; }
    LDS_BARRIER();
}

__device__ __forceinline__ unsigned pack2(float a, float b) { return cvt_pk_bf16(a, b); }
__device__ __forceinline__ int tsw(int row, int pos) { return row * ML_TP + ((((pos >> 3) ^ (row >> 3)) & 7) << 4) + ((pos & 7) << 1); }
#ifndef TIME_PHASE
#define TIME_PHASE -1
#endif
template <int CTRL, int RM, int BMK> __device__ __forceinline__ float dppf(float old, float src) { return __int_as_float(__builtin_amdgcn_update_dpp(__float_as_int(old), __float_as_int(src), CTRL, RM, BMK, false)); }
__device__ __forceinline__ float wave_scan_add(float v) {
    v += dppf<0x111, 0xf, 0xf>(0.f, v); v += dppf<0x112, 0xf, 0xf>(0.f, v); v += dppf<0x114, 0xf, 0xf>(0.f, v); v += dppf<0x118, 0xf, 0xf>(0.f, v);
    v += dppf<0x142, 0xa, 0xf>(0.f, v); v += dppf<0x143, 0xc, 0xf>(0.f, v); return v; }
__device__ __forceinline__ float wave_scan_max(float v) {
    v = fmaxf(v, dppf<0x111, 0xf, 0xf>(-INFINITY, v)); v = fmaxf(v, dppf<0x112, 0xf, 0xf>(-INFINITY, v)); v = fmaxf(v, dppf<0x114, 0xf, 0xf>(-INFINITY, v)); v = fmaxf(v, dppf<0x118, 0xf, 0xf>(-INFINITY, v));
    v = fmaxf(v, dppf<0x142, 0xa, 0xf>(-INFINITY, v)); v = fmaxf(v, dppf<0x143, 0xc, 0xf>(-INFINITY, v)); return v; }
__device__ __forceinline__ float lane63(float v) { return __int_as_float(__builtin_amdgcn_readlane(__float_as_int(v), 63)); }
#define MLT(k) if (TIME_PHASE == 20 + (k)) { const unsigned long long n_ = __builtin_amdgcn_s_memrealtime(); tacc += n_ - tlast; tlast = n_; } else if (TIME_PHASE >= 20 && TIME_PHASE < 24) { tlast = __builtin_amdgcn_s_memrealtime(); }
__device__ __forceinline__ unsigned long long ml_chain(LAS unsigned char* lds, const Params& P, int chain) {
    unsigned long long tacc = 0, tlast = 0;
    const int b = chain >> 3, h = (chain >> 1) & 3, dir = chain & 1;
    int tid_ = threadIdx.x; asm volatile("" : "+v"(tid_)); const int tid = tid_, lane = tid & 63, w = __builtin_amdgcn_readfirstlane(tid >> 6), l15 = lane & 15, quad = lane >> 4;
    unsigned char* ws = P.ws;
    const bf16_t* MLV = (const bf16_t*)(ws + WS_MLV);
    const float* GATES = (const float*)(ws + WS_GATES);
    bf16_t* HDIR = (bf16_t*)((unsigned char*)P.out + (dir ? DO_HBW : DO_HFW));
    LAS float* NV = (LAS float*)(lds + ML_NV); LAS float* NVP = (LAS float*)(lds + ML_CW); LAS float* ROWSUM = (LAS float*)(lds + ML_ROWSUM);
    LAS float* DENI = (LAS float*)(lds + ML_DENI); LAS float* WTS = (LAS float*)(lds + ML_WTS);
    if (tid < 256) NV[tid] = 0.f;
    f32x4 C[8];
#pragma unroll
    for (int e = 0; e < 8; ++e) C[e] = (f32x4){0.f, 0.f, 0.f, 0.f};
    float m_run = -1e30f;
    const float big = P.in[4][dir * 4 + h], bfg = P.in[5][dir * 4 + h];
    const int cgp = tid & 31, rg = tid >> 5; const bool isk = cgp >= 16; const int c8 = (cgp & 15) * 8;
    const bf16_t* qksrc = (const bf16_t*)((const unsigned char*)P.out + (isk ? DO_KC : DO_QC)) + h * 128 + c8;
    const int vcg = tid & 15, vrg = tid >> 4;
    const size_t brow = (size_t)b * 2048;
    struct MLPF { u32x4 raw[4]; u32x4 vraw[2]; float gi, gf; };
    MLPF pfA;
#define ML_ISSUE(pf, cc) do { const int tb_ = dir ? 2048 - 64 * ((cc) + 1) : 64 * (cc); \
        _Pragma("unroll") for (int i_ = 0; i_ < 4; ++i_) { const int t_ = tb_ + 4 * rg + i_; (pf).raw[i_] = *(const u32x4*)(qksrc + (brow + t_) * 512); } \
        _Pragma("unroll") for (int i_ = 0; i_ < 2; ++i_) { const int t_ = tb_ + 2 * vrg + i_; (pf).vraw[i_] = *(const u32x4*)(MLV + (brow + t_) * 512 + h * 128 + vcg * 8); } \
        { const int t_ = dir ? tb_ + 63 - lane : tb_ + lane; (pf).gi = GATES[(brow + t_) * 16 + (dir * 2) * 4 + h]; (pf).gf = GATES[(brow + t_) * 16 + (dir * 2 + 1) * 4 + h]; } } while (0)
    ML_ISSUE(pfA, 0);
    __syncthreads();
    {
      for (int c = 0; c < 32; ++c) {
        MLPF& pf = pfA;
        u32x4 raw[4], vraw[2];
#pragma unroll
        for (int i_ = 0; i_ < 4; ++i_) raw[i_] = pf.raw[i_];
        vraw[0] = pf.vraw[0]; vraw[1] = pf.vraw[1];
        const float gi_raw = pf.gi, gf_raw = pf.gf;
        const int tb = dir ? 2048 - 64 * (c + 1) : 64 * c; const int par = c & 1;
        MLT(3)
        const float gi = gi_raw + big, gf = gf_raw + bfg;
        const float lf = fminf(gf, 0.f) - __logf(1.0f + fast_exp(-fabsf(gf)));
        const float a = wave_scan_add(lf);
        const float g = lane63(a);
        const float u = gi - a; const float pm = wave_scan_max(u);
        const float mj = a + fmaxf(m_run, pm);
        const float inter_w = fast_exp(a + m_run - mj);
        const float pm63 = lane63(pm); const float m_new = fmaxf(g + m_run, g + pm63);
        const float decay = fast_exp(g + m_run - m_new);
        const float wt = fast_exp(g + u - m_new);
        const float emj = fast_exp(-mj);
        MLT(0)
        if (w == 0) { WTS[lane] = wt; }
        {
            LAS unsigned char* rm = lds + (isk ? ML_KS : ML_QS);
#pragma unroll
            for (int i = 0; i < 4; ++i) { const int p = dir ? 63 - (4 * rg + i) : 4 * rg + i; *(LAS u32x4*)(rm + p * ML_QP + c8 * 2) = raw[i]; }
            if (isk) {
#pragma unroll
                for (int cp = 0; cp < 4; ++cp) {
                    const unsigned t0 = cp == 0 ? raw[0].x : cp == 1 ? raw[0].y : cp == 2 ? raw[0].z : raw[0].w, t1 = cp == 0 ? raw[1].x : cp == 1 ? raw[1].y : cp == 2 ? raw[1].z : raw[1].w;
                    const unsigned t2 = cp == 0 ? raw[2].x : cp == 1 ? raw[2].y : cp == 2 ? raw[2].z : raw[2].w, t3 = cp == 0 ? raw[3].x : cp == 1 ? raw[3].y : cp == 2 ? raw[3].z : raw[3].w;
                    u32x2 lo, hi;
                    if (dir) { lo.x = (t3 & 0xffffu) | (t2 << 16); lo.y = (t1 & 0xffffu) | (t0 << 16); hi.x = (t3 >> 16) | (t2 & 0xffff0000u); hi.y = (t1 >> 16) | (t0 & 0xffff0000u); }
                    else { lo.x = (t0 & 0xffffu) | (t1 << 16); lo.y = (t2 & 0xffffu) | (t3 << 16); hi.x = (t0 >> 16) | (t1 & 0xffff0000u); hi.y = (t2 >> 16) | (t3 & 0xffff0000u); }
                    const int ppos = dir ? 60 - 4 * rg : 4 * rg;
                    *(LAS u32x2*)(lds + ML_KT + tsw(c8 + 2 * cp, ppos)) = lo; *(LAS u32x2*)(lds + ML_KT + tsw(c8 + 2 * cp + 1, ppos)) = hi; }
            }
        }
        {
            const int p0 = dir ? 63 - 2 * vrg : 2 * vrg, p1 = dir ? 62 - 2 * vrg : 2 * vrg + 1;
            const float wt0 = __shfl(wt, p0), wt1 = __shfl(wt, p1);
            float v0[8], v1[8];
            v0[0] = bf_lo(vraw[0].x); v0[1] = bf_hi(vraw[0].x); v0[2] = bf_lo(vraw[0].y); v0[3] = bf_hi(vraw[0].y); v0[4] = bf_lo(vraw[0].z); v0[5] = bf_hi(vraw[0].z); v0[6] = bf_lo(vraw[0].w); v0[7] = bf_hi(vraw[0].w);
            v1[0] = bf_lo(vraw[1].x); v1[1] = bf_hi(vraw[1].x); v1[2] = bf_lo(vraw[1].y); v1[3] = bf_hi(vraw[1].y); v1[4] = bf_lo(vraw[1].z); v1[5] = bf_hi(vraw[1].z); v1[6] = bf_lo(vraw[1].w); v1[7] = bf_hi(vraw[1].w);
            const int pw = dir ? p1 : p0;
#pragma unroll
            for (int ch = 0; ch < 8; ++ch) { const int d = vcg * 8 + ch;
                const unsigned a_ = dir ? pack2(v1[ch], v0[ch]) : pack2(v0[ch], v1[ch]);
                const unsigned b_ = dir ? pack2(v1[ch] * wt1, v0[ch] * wt0) : pack2(v0[ch] * wt0, v1[ch] * wt1);
                *(LAS unsigned*)(lds + ML_VT + tsw(d, pw)) = a_; *(LAS unsigned*)(lds + ML_WVT + tsw(d, pw)) = b_; }
        }
        if (c + 1 < 32) ML_ISSUE(pf, c + 1);
        LDS_BARRIER();
        MLT(1)
#pragma unroll
        for (int bb2 = 0; bb2 < 2; ++bb2) {
            const int id = 2 * w + bb2, jb = id >> 2, sb = id & 3; const int j = 16 * jb + l15;
            if (sb <= jb) {
                f32x4 sacc = {0.f, 0.f, 0.f, 0.f};
#pragma unroll
                for (int st = 0; st < 4; ++st) { const bf16x8 kf = *(const LAS bf16x8*)(lds + ML_KS + (16 * sb + l15) * ML_QP + (32 * st + 8 * quad) * 2);
                    const bf16x8 qf = *(const LAS bf16x8*)(lds + ML_QS + j * ML_QP + (32 * st + 8 * quad) * 2);
                    sacc = __builtin_amdgcn_mfma_f32_16x16x32_bf16(kf, qf, sacc, 0, 0, 0); }
                const float aj = __shfl(a, j), mjj = __shfl(mj, j);
                float pv[4]; float rsum = 0.f;
#pragma unroll
                for (int i = 0; i < 4; ++i) { const int sidx = 16 * sb + 4 * quad + i; const float us = __shfl(u, sidx);
                    const float e = fast_exp(fminf(aj + us - mjj, 0.f)) * sacc[i]; pv[i] = (sidx <= j) ? e : 0.f; rsum += pv[i]; }
                rsum += __shfl_xor(rsum, 16); rsum += __shfl_xor(rsum, 32);
                if (quad == 0) ROWSUM[sb * 64 + j] = rsum;
                u32x2 wv; wv.x = pack2(pv[0], pv[1]); wv.y = pack2(pv[2], pv[3]);
                *(LAS u32x2*)(lds + ML_PS + j * ML_TP + (16 * sb + 4 * quad) * 2) = wv;
            } else {
                *(LAS u32x2*)(lds + ML_PS + j * ML_TP + (16 * sb + 4 * quad) * 2) = (u32x2){0u, 0u}; if (quad == 0) ROWSUM[sb * 64 + j] = 0.f;
            }
        }
        {
            const int j = tid >> 3, eo = (tid & 7) * 16;
            const u32x4 q0 = *(const LAS u32x4*)(lds + ML_QS + j * ML_QP + eo * 2), q1 = *(const LAS u32x4*)(lds + ML_QS + j * ML_QP + eo * 2 + 16);
            const LAS float* nv = NV + par * 128 + eo;
            const f32x4 n0 = *(const LAS f32x4*)(nv), n1 = *(const LAS f32x4*)(nv + 4), n2 = *(const LAS f32x4*)(nv + 8), n3 = *(const LAS f32x4*)(nv + 12);
            float s = bf_lo(q0.x) * n0[0] + bf_hi(q0.x) * n0[1] + bf_lo(q0.y) * n0[2] + bf_hi(q0.y) * n0[3] + bf_lo(q0.z) * n1[0] + bf_hi(q0.z) * n1[1] + bf_lo(q0.w) * n1[2] + bf_hi(q0.w) * n1[3]
                    + bf_lo(q1.x) * n2[0] + bf_hi(q1.x) * n2[1] + bf_lo(q1.y) * n2[2] + bf_hi(q1.y) * n2[3] + bf_lo(q1.z) * n3[0] + bf_hi(q1.z) * n3[1] + bf_lo(q1.w) * n3[2] + bf_hi(q1.w) * n3[3];
            s += __shfl_xor(s, 1); s += __shfl_xor(s, 2); s += __shfl_xor(s, 4);
            if ((tid & 7) == 0) DENI[j] = s;
        }
        f32x4 acc[4];
#pragma unroll
        for (int t4 = 0; t4 < 4; ++t4) acc[t4] = (f32x4){0.f, 0.f, 0.f, 0.f};
#pragma unroll
        for (int st = 0; st < 4; ++st) {
            union { bf16x8 v; unsigned uu[4]; } ca;
            ca.uu[0] = pack2(C[2 * st][0], C[2 * st][1]); ca.uu[1] = pack2(C[2 * st][2], C[2 * st][3]); ca.uu[2] = pack2(C[2 * st + 1][0], C[2 * st + 1][1]); ca.uu[3] = pack2(C[2 * st + 1][2], C[2 * st + 1][3]);
#pragma unroll
            for (int t4 = 0; t4 < 4; ++t4) { const LAS unsigned char* qp = lds + ML_QS + (16 * t4 + l15) * ML_QP + (32 * st + 4 * quad) * 2;
                union { bf16x8 v; s16x4 hh[2]; } qb; qb.hh[0] = *(const LAS s16x4*)qp; qb.hh[1] = *(const LAS s16x4*)(qp + 32);
                acc[t4] = __builtin_amdgcn_mfma_f32_16x16x32_bf16(ca.v, qb.v, acc[t4], 0, 0, 0); }
        }
        { const int e = tid & 127, qq = tid >> 7; float s = 0.f;
#pragma unroll
            for (int q = 0; q < 2; ++q) { const int pos = 16 * qq + 8 * q; const u32x4 kv = *(const LAS u32x4*)(lds + ML_KT + tsw(e, pos)); const f32x4 wa = *(const LAS f32x4*)(WTS + pos), wb = *(const LAS f32x4*)(WTS + pos + 4);
                s += bf_lo(kv.x) * wa[0] + bf_hi(kv.x) * wa[1] + bf_lo(kv.y) * wa[2] + bf_hi(kv.y) * wa[3] + bf_lo(kv.z) * wb[0] + bf_hi(kv.z) * wb[1] + bf_lo(kv.w) * wb[2] + bf_hi(kv.w) * wb[3]; }
            NVP[qq * 128 + e] = s; }
#pragma unroll
        for (int eb = 0; eb < 8; ++eb) { C[eb] = C[eb] * decay;
#pragma unroll
            for (int ks = 0; ks < 2; ++ks) { const bf16x8 ka = *(const LAS bf16x8*)(lds + ML_KT + tsw(16 * eb + l15, 32 * ks + 8 * quad));
                const bf16x8 vb = *(const LAS bf16x8*)(lds + ML_WVT + tsw(16 * w + l15, 32 * ks + 8 * quad));
                C[eb] = __builtin_amdgcn_mfma_f32_16x16x32_bf16(ka, vb, C[eb], 0, 0, 0); } }
        LDS_BARRIER();
        MLT(2)
        if (tid < 128) NV[(par ^ 1) * 128 + tid] = decay * NV[par * 128 + tid] + ((NVP[tid] + NVP[128 + tid]) + (NVP[256 + tid] + NVP[384 + tid]));
#pragma unroll
        for (int t4 = 0; t4 < 4; ++t4) { const int tp = 16 * t4 + l15; const float iw = __shfl(inter_w, tp); const float em = __shfl(emj, tp);
            f32x4 r = acc[t4] * iw;
#pragma unroll
            for (int ks = 0; ks < 2; ++ks) { const bf16x8 va = *(const LAS bf16x8*)(lds + ML_VT + tsw(16 * w + l15, 32 * ks + 8 * quad));
                const bf16x8 pb = *(const LAS bf16x8*)(lds + ML_PS + tp * ML_TP + (32 * ks + 8 * quad) * 2);
                r = __builtin_amdgcn_mfma_f32_16x16x32_bf16(va, pb, r, 0, 0, 0); }
            const float den = ((ROWSUM[tp] + ROWSUM[64 + tp]) + (ROWSUM[128 + tp] + ROWSUM[192 + tp])) + iw * DENI[tp]; const float inv = 1.0f / fmaxf(fabsf(den), em);
            const int t = dir ? tb + 63 - tp : tb + tp;
            { const f32x4 rr = r * inv; u32x2 ov; ov.x = pack2(rr[0], rr[1]); ov.y = pack2(rr[2], rr[3]); *(u32x2*)(HDIR + (brow + t) * 512 + h * 128 + 16 * w + 4 * quad) = ov; } }
        m_run = m_new;
        LDS_BARRIER();
      }
    }
#undef ML_ISSUE
    return tacc;
}

__device__ __forceinline__ void unpack8(const u32x4 v, float* f) { f[0] = bf_lo(v.x); f[1] = bf_hi(v.x); f[2] = bf_lo(v.y); f[3] = bf_hi(v.y); f[4] = bf_lo(v.z); f[5] = bf_hi(v.z); f[6] = bf_lo(v.w); f[7] = bf_hi(v.w); }
__device__ __forceinline__ void p2b_combine(const Params& P, int G) {
    int tid_ = threadIdx.x; asm volatile("" : "+v"(tid_)); const int tid = tid_, lane = tid & 63, wave = tid >> 6; const int gw = blockIdx.x * 8 + wave, NGW = G * 8;
    const bf16_t* HF = (const bf16_t*)((unsigned char*)P.out + DO_HFW); const bf16_t* HB = (const bf16_t*)((unsigned char*)P.out + DO_HBW);
    bf16_t* O = (bf16_t*)(P.ws + WS_MLO); const float* ng = P.in[8];
    float gg[8]; { const f32x4 g0 = *(const f32x4*)(ng + 8 * lane), g1 = *(const f32x4*)(ng + 8 * lane + 4); gg[0] = g0[0]; gg[1] = g0[1]; gg[2] = g0[2]; gg[3] = g0[3]; gg[4] = g1[0]; gg[5] = g1[1]; gg[6] = g1[2]; gg[7] = g1[3]; }
    for (int row = gw; row < NTOK; row += 2 * NGW) {
        const int row2 = row + NGW; const bool has2 = row2 < NTOK;
        const size_t off = (size_t)row * 512 + 8 * lane, off2 = (size_t)(has2 ? row2 : row) * 512 + 8 * lane;
        const u32x4 fa = *(const u32x4*)(HF + off), fb = *(const u32x4*)(HB + off), fo = *(const u32x4*)(O + off);
        const u32x4 fa2 = *(const u32x4*)(HF + off2), fb2 = *(const u32x4*)(HB + off2), fo2 = *(const u32x4*)(O + off2);
#pragma unroll
        for (int rr = 0; rr < 2; ++rr) {
            float a[8], bb[8], o[8]; unpack8(rr ? fa2 : fa, a); unpack8(rr ? fb2 : fb, bb); unpack8(rr ? fo2 : fo, o);
            float ss = 0.f;
#pragma unroll
            for (int i = 0; i < 8; ++i) { a[i] += bb[i]; ss += a[i] * a[i]; }
            ss += __shfl_xor(ss, 1); ss += __shfl_xor(ss, 2); ss += __shfl_xor(ss, 4); ss += __shfl_xor(ss, 8);
            const float rstd = rsqrtf(ss * (1.0f / 128.0f) + EPS);
#pragma unroll
            for (int i = 0; i < 8; ++i) a[i] = a[i] * rstd * gg[i] * sigmoidf_(o[i]);
            u32x4 wv; wv.x = pack2(a[0], a[1]); wv.y = pack2(a[2], a[3]); wv.z = pack2(a[4], a[5]); wv.w = pack2(a[6], a[7]);
            if (rr == 0 || has2) *(u32x4*)(O + (rr ? off2 : off)) = wv;
        }
    }
}
__device__ __forceinline__ void p1b_conv(const Params& P, int G) {
    const bf16_t* MQ = (const bf16_t*)(P.ws + WS_MLQ); const bf16_t* MK = (const bf16_t*)(P.ws + WS_MLK);
    bf16_t* QC = (bf16_t*)((unsigned char*)P.out + DO_QC); bf16_t* KC = (bf16_t*)((unsigned char*)P.out + DO_KC);
    const float* cw = P.in[6]; const float* cb = P.in[7];
    const int nb0 = G >= 64 ? 32 : 0; if ((int)blockIdx.x < nb0) return;
    const int nth = (G - nb0) * 512;
    for (int task = ((int)blockIdx.x - nb0) * 512 + threadIdx.x; task < 2048 * 128; task += nth) {
        const int rgid = task >> 7, cgid = task & 127; const int row0 = 8 * rgid, ch0 = 8 * cgid; const int sp0 = row0 & 2047;
        const bool isk = ch0 >= 512; const float qs = isk ? 1.0f : 0.08838834764831845f;
        float w0[8], w1[8], w2[8], bb[8];
#pragma unroll
        for (int q = 0; q < 2; ++q) { const f32x4 t0 = *(const f32x4*)(cw + ch0 + 4 * q), t1 = *(const f32x4*)(cw + 1024 + ch0 + 4 * q), t2 = *(const f32x4*)(cw + 2048 + ch0 + 4 * q), t3 = *(const f32x4*)(cb + ch0 + 4 * q);
#pragma unroll
            for (int i = 0; i < 4; ++i) { w0[4 * q + i] = t0[i]; w1[4 * q + i] = t1[i]; w2[4 * q + i] = t2[i]; bb[4 * q + i] = t3[i]; } }
        const bf16_t* ap = (isk ? MK + (ch0 - 512) : MQ + ch0) + (size_t)row0 * 512; bf16_t* op = (isk ? KC + (ch0 - 512) : QC + ch0) + (size_t)row0 * 512;
        u32x4 rw[10];
#pragma unroll
        for (int i = 0; i < 10; ++i) { const int sp = sp0 - 1 + i; rw[i] = (sp >= 0 && sp < 2048) ? *(const u32x4*)(ap + (ptrdiff_t)(i - 1) * 512) : (u32x4){0u, 0u, 0u, 0u}; }
        float prev[8], cur[8], nxt[8]; unpack8(rw[0], prev); unpack8(rw[1], cur);
#pragma unroll
        for (int i = 0; i < 8; ++i) {
            unpack8(rw[i + 2], nxt);
            float o[8];
#pragma unroll
            for (int q = 0; q < 8; ++q) { const float y = w0[q] * prev[q] + w1[q] * cur[q] + w2[q] * nxt[q] + bb[q]; o[q] = y * sigmoidf_(y) * qs; prev[q] = cur[q]; cur[q] = nxt[q]; }
            u32x4 wv; wv.x = pack2(o[0], o[1]); wv.y = pack2(o[2], o[3]); wv.z = pack2(o[4], o[5]); wv.w = pack2(o[6], o[7]);
            *(u32x4*)(op + (size_t)i * 512) = wv;
        }
    }
}
__device__ __forceinline__ void p5b_glu(const Params& P, int G) {
    const bf16_t* A = (const bf16_t*)(P.ws + WS_ABUF); bf16_t* U = (bf16_t*)(P.ws + WS_UBUF);
    const float* cw = P.in[19]; const float* cb = P.in[20];
    const int nth = G * 512;
    for (int task = blockIdx.x * 512 + threadIdx.x; task < 2048 * 352; task += nth) {
        const int rgid = task / 352, cgid = task - rgid * 352; const int row0 = 8 * rgid, ch0 = 8 * cgid; const int sp0 = row0 & 2047;
        float w0[8], w1[8], w2[8], bb[8];
#pragma unroll
        for (int q = 0; q < 2; ++q) { const f32x4 t0 = *(const f32x4*)(cw + ch0 + 4 * q), t1 = *(const f32x4*)(cw + 2816 + ch0 + 4 * q), t2 = *(const f32x4*)(cw + 5632 + ch0 + 4 * q), t3 = *(const f32x4*)(cb + ch0 + 4 * q);
#pragma unroll
            for (int i = 0; i < 4; ++i) { w0[4 * q + i] = t0[i]; w1[4 * q + i] = t1[i]; w2[4 * q + i] = t2[i]; bb[4 * q + i] = t3[i]; } }
        const bf16_t* ap = A + (size_t)row0 * 2816 + ch0; bf16_t* up = U + (size_t)row0 * 2816 + ch0;
        u32x4 ra[10], ru[8];
#pragma unroll
        for (int i = 0; i < 10; ++i) { const int sp = sp0 - 1 + i; ra[i] = (sp >= 0 && sp < 2048) ? *(const u32x4*)(ap + (ptrdiff_t)(i - 1) * 2816) : (u32x4){0u, 0u, 0u, 0u}; }
#pragma unroll
        for (int i = 0; i < 8; ++i) ru[i] = *(const u32x4*)(up + (size_t)i * 2816);
        float prev[8], cur[8], nxt[8]; unpack8(ra[0], prev); unpack8(ra[1], cur);
#pragma unroll
        for (int i = 0; i < 8; ++i) {
            unpack8(ra[i + 2], nxt);
            float uu[8]; unpack8(ru[i], uu);
            float o[8];
#pragma unroll
            for (int q = 0; q < 8; ++q) { const float y = w0[q] * prev[q] + w1[q] * cur[q] + w2[q] * nxt[q] + bb[q];
                const float z = 1.5957691216057308f * (y + 0.044715f * y * y * y);
                o[q] = y * sigmoidf_(z) * uu[q]; prev[q] = cur[q]; cur[q] = nxt[q]; }
            u32x4 wv; wv.x = pack2(o[0], o[1]); wv.y = pack2(o[2], o[3]); wv.z = pack2(o[4], o[5]); wv.w = pack2(o[6], o[7]);
            *(u32x4*)(up + (size_t)i * 2816) = wv;
        }
    }
}
__device__ __forceinline__ void p7_final(const Params& P, int G) {
    int tid_ = threadIdx.x; asm volatile("" : "+v"(tid_)); const int tid = tid_, lane = tid & 63, wave = tid >> 6; const int gw = blockIdx.x * 8 + wave, NGW = G * 8;
    const float* gv = P.in[22];
    for (int m = gw; m < NTOK; m += NGW) {
        f32x4* row = (f32x4*)(P.out + (size_t)m * 1024);
        f32x4 v[4]; float s = 0.f;
#pragma unroll
        for (int j = 0; j < 4; ++j) { v[j] = row[64 * j + lane]; s += (v[j][0] * v[j][0] + v[j][1] * v[j][1]) + (v[j][2] * v[j][2] + v[j][3] * v[j][3]); }
        const float rstd = rsqrtf(wave_sum(s) * (1.0f / 1024.0f) + EPS);
#pragma unroll
        for (int j = 0; j < 4; ++j) { const f32x4 g4 = ((const f32x4*)gv)[64 * j + lane]; row[64 * j + lane] = v[j] * rstd * g4; }
    }
}


#define XB_TMO      128
#define XB_XCNT(j)  (256  + 64 * (j))
#define XB_XSUB(j)  (1280 + 64 * (j))
#define XB_XGEN(j)  (2304 + 64 * (j))
#define XB_TOP      3328
#define XB_TOPGEN   3392
#define XCD_BAR_WORDS 3456
#define XB_SPIN_CAP (1u << 18)

__device__ __forceinline__ unsigned xb_ld(unsigned* p)              { return __hip_atomic_load(p, __ATOMIC_RELAXED, __HIP_MEMORY_SCOPE_AGENT); }
__device__ __forceinline__ unsigned xb_add(unsigned* p, unsigned v) { return __hip_atomic_fetch_add(p, v, __ATOMIC_RELAXED, __HIP_MEMORY_SCOPE_AGENT); }
__device__ __forceinline__ unsigned xb_xcc_id() { return (unsigned)__builtin_amdgcn_s_getreg((3 << 11) | 20) & 0xFu; }
#define XB_SPIN(cond, bar) do { unsigned _sp = 0; while (cond) { __builtin_amdgcn_s_sleep(1); \
    if ((++_sp & 255u) == 0u) { if (xb_ld(&(bar)[XB_TMO])) break; if (_sp > XB_SPIN_CAP) { atomicAdd(&(bar)[XB_TMO], 1u); break; } } } } while (0)

struct XcdBarrier {
    unsigned* bar; unsigned x;
    volatile LAS unsigned* st;
};

__device__ __forceinline__ XcdBarrier xcd_barrier_post(unsigned* bar, volatile LAS unsigned* st) {
    XcdBarrier b; b.bar = bar; b.x = xb_xcc_id(); b.st = st;
    if (threadIdx.x == 0) (void)xb_add(&bar[XB_XCNT(b.x)], 1u);
    return b;
}
__device__ __forceinline__ void xcd_barrier_complete(unsigned* bar, unsigned x, unsigned& nloc, unsigned& nx) {
    const unsigned G = gridDim.x * gridDim.y * gridDim.z;
    unsigned sum, cnt, mine, sp = 0u;
    for (;;) {
        sum = 0u; cnt = 0u; mine = 0u;
#pragma unroll
        for (unsigned j = 0; j < 16; ++j) { const unsigned c = xb_ld(&bar[XB_XCNT(j)]); sum += c; cnt += (c > 0u) ? 1u : 0u; mine = (j == x) ? c : mine; }
        if (sum == G) break;
        __builtin_amdgcn_s_sleep(1);
        if ((++sp & 255u) == 0u) { if (xb_ld(&bar[XB_TMO])) break; if (sp > XB_SPIN_CAP) { atomicAdd(&bar[XB_TMO], 1u); break; } }
    }
    nloc = mine > 0u ? mine : 1u; nx = cnt > 0u ? cnt : 1u;
}

__device__ __forceinline__ void xcd_barrier(const XcdBarrier& b) {
    asm volatile("s_waitcnt vmcnt(0)" ::: "memory");
    __syncthreads();
    if (threadIdx.x == 0) {
        unsigned* bar = b.bar;
        __builtin_amdgcn_s_waitcnt(0);
        unsigned nloc = b.st[0], nx = b.st[1];
        if (nloc == 0u) { xcd_barrier_complete(bar, b.x, nloc, nx); b.st[0] = nloc; b.st[1] = nx; }
        const unsigned old = xb_add(&bar[XB_XSUB(b.x)], 1u);
        const unsigned gen = old / nloc;
        if (old + 1u == (gen + 1u) * nloc) {
            __builtin_amdgcn_fence(__ATOMIC_RELEASE, "agent");
            asm volatile("s_waitcnt vmcnt(0)" ::: "memory");
            const unsigned og = xb_add(&bar[XB_TOP], 1u);
            const unsigned tg = og / nx;
            if (og + 1u == (tg + 1u) * nx) xb_add(&bar[XB_TOPGEN], 1u);
            else XB_SPIN(xb_ld(&bar[XB_TOPGEN]) == tg, bar);
            __builtin_amdgcn_fence(__ATOMIC_ACQUIRE, "agent");
            xb_add(&bar[XB_XGEN(b.x)], 1u);
            asm volatile("s_waitcnt vmcnt(0)" ::: "memory");
        } else {
            XB_SPIN(xb_ld(&bar[XB_XGEN(b.x)]) == gen, bar);
            __builtin_amdgcn_fence(__ATOMIC_ACQUIRE, "agent");
            asm volatile("s_waitcnt vmcnt(0)" ::: "memory");
        }
    }
    __syncthreads();
}

#ifndef DBG_CUT
#define DBG_CUT 0
#endif
#ifndef DBG_NOOUT
#define DBG_NOOUT 0
#endif
__device__ __forceinline__ void dbg_dump(const Params& P, int G) {
    const unsigned short* w16 = (const unsigned short*)P.ws; unsigned* o = (unsigned*)P.out;
    for (size_t i = (size_t)blockIdx.x * 512 + threadIdx.x; i < (size_t)NTOK * 1024; i += (size_t)G * 512) {
        const unsigned ob = (DBG_CUT >= 2 && !DBG_NOOUT) ? o[i] : 0u; float s = (float)(ob & 0xffffu) + (float)(ob >> 16);
        for (int k = 0; k < 8; ++k) s += (float)w16[i + (size_t)k * NTOK * 1024];
        P.out[i] = s; }
}
#define GRID_SYNC() xcd_barrier(xbar)
#ifndef TIME_PHASE
#define TIME_PHASE -1
#endif
#define TSTART(n) if (TIME_PHASE == (n)) tt0 = __builtin_amdgcn_s_memrealtime();
#define TEND(n) if (TIME_PHASE == (n)) tt1 = __builtin_amdgcn_s_memrealtime();
#define CUT(n) if (DBG_CUT == (n)) { GRID_SYNC(); dbg_dump(P, G); return; }
__device__ __forceinline__ void sub_barrier(unsigned* cnt, unsigned n) {
    asm volatile("s_waitcnt vmcnt(0)" ::: "memory"); __syncthreads();
    if (threadIdx.x == 0) {
        asm volatile("buffer_wbl2 sc1\n\ts_waitcnt vmcnt(0)" ::: "memory");
        __hip_atomic_fetch_add(cnt, 1u, __ATOMIC_RELAXED, __HIP_MEMORY_SCOPE_AGENT);
        unsigned sp = 0; while (__hip_atomic_load(cnt, __ATOMIC_RELAXED, __HIP_MEMORY_SCOPE_AGENT) < n) { __builtin_amdgcn_s_sleep(4); if (++sp > (1u << 22)) break; }
        __builtin_amdgcn_fence(__ATOMIC_ACQUIRE, "agent"); asm volatile("s_waitcnt vmcnt(0)" ::: "memory");
    }
    __syncthreads();
}
#ifndef PH_LAST
#define PH_LAST 99
#endif
__global__ void __launch_bounds__(512, 2) mega(Params P) {
    extern __shared__ __attribute__((aligned(16))) unsigned char smem[];
    LAS unsigned char* lds = (LAS unsigned char*)smem;
    cg::grid_group grid = cg::this_grid();
    const int G = gridDim.x, bid = blockIdx.x;
    unsigned char* ws = P.ws; unsigned char* dob = (unsigned char*)P.out;
#ifndef PHMASK
#define PHMASK 0xFFFF
#endif
#define PH(n) if ((PHMASK >> (n)) & 1)
    unsigned long long tt0 = 0, tt1 = 0;
    if (threadIdx.x < 2) ((LAS unsigned*)(lds + LDS_XB_OFF))[threadIdx.x] = 0u;
    __syncthreads();
    XcdBarrier xbar = xcd_barrier_post((unsigned*)(ws + WS_XBAR), (volatile LAS unsigned*)(lds + LDS_XB_OFF));
    if (P.ws == nullptr) grid.sync();
    TSTART(0)
    PH(0) p0_prologue(lds, P, G);
    GRID_SYNC();
    TEND(0) TSTART(1)
    PH(1) { pg8::Gemm g{(const bf16_t*)(dob + DO_H), (const bf16_t*)(dob + DO_WINT), NTOK, INW_P, 1024}; pg8::StaticOrder S; S.init(NTOK, INW_P, G, bid);
      EpiProj E{ws, P.in[12], lds}; pg8::gemm_phase<EpiProj, pg8::StaticOrder, true, true>(lds, g, S, E); }
    GRID_SYNC();
    TEND(1) TSTART(2)
    CUT(1)
    PH(2) { pg8::Gemm g{(const bf16_t*)(dob + DO_MEMN), (const bf16_t*)(dob + DO_WMEMKVT), NMEM, 1024, 1024}; pg8::StaticOrder S; S.init(NMEM, 1024, G, bid);
      EpiMemKV E{ws, lds}; pg8::gemm_phase<EpiMemKV, pg8::StaticOrder, true, true>(lds, g, S, E); }
    p1b_conv(P, G);
    GRID_SYNC();
    { if (TIME_PHASE == 10 || TIME_PHASE == 11) tt0 = __builtin_amdgcn_s_memrealtime();
      if (G >= 128) {
          if (bid < 64) { PH(3) { const unsigned long long r_ = ml_chain(lds, P, bid); if (TIME_PHASE >= 20 && TIME_PHASE < 24) { tt0 = 0; tt1 = r_; } } }
          else { { const int wv_ = (int)(threadIdx.x >> 6); weight_items(lds, P, WI_EARLY, WI_ALL, (bid - 64) * 8 + wv_, (G - 64) * 8, wv_, (int)(threadIdx.x & 63)); __syncthreads(); }
              for (int u = bid - 64; u < 1280; u += G - 64) { if (u < 1024) { PH(4) na_unit(lds, ws, P.in[9], u); } else { PH(5) xa_unit(lds, ws, u - 1024); } }
              sub_barrier((unsigned*)(ws + WS_SUBCNT), (unsigned)(G - 64));
              pg8::Gemm g{(const bf16_t*)(ws + WS_MLO), (const bf16_t*)(ws + WS_WBR), 3 * NTOK, 3 * 1024, 512}; BranchOrder S; S.init(G, bid, 2, G - 64, bid - 64);
              EpiBranchAcc E{(bf16_t*)(ws + WS_G), (bf16_t*)(ws + WS_MERGED)};
              pg8::gemm_phase<EpiBranchAcc, BranchOrder, true, true>(lds, g, S, E); }
      } else {
          for (int u = bid; u < 1344; u += G) { if (u < 64) { PH(3) (void)ml_chain(lds, P, u); } else if (u < 1088) { PH(4) na_unit(lds, ws, P.in[9], u - 64); } else { PH(5) xa_unit(lds, ws, u - 1088); } }
      } }
    if ((TIME_PHASE == 10 && bid < 64) || (TIME_PHASE == 11 && bid >= 64)) tt1 = __builtin_amdgcn_s_memrealtime(); else if (TIME_PHASE == 10 || TIME_PHASE == 11) tt1 = tt0;
    GRID_SYNC();
    TEND(2) TSTART(3)
    PH(6) p2b_combine(P, G);
    GRID_SYNC();
    TEND(3) TSTART(4)
    CUT(2)
    PH(7) {
      pg8::Gemm g{(const bf16_t*)(ws + WS_MLO), (const bf16_t*)(ws + WS_WBR), 3 * NTOK, 3 * 1024, 512}; BranchOrder S; S.init(G, bid, G >= 128 ? 0 : 1, 0, 0);
      EpiBranchAcc E{(bf16_t*)(ws + WS_G), (bf16_t*)(ws + WS_MERGED)};
      pg8::gemm_phase<EpiBranchAcc, BranchOrder, true, true>(lds, g, S, E); }
    GRID_SYNC();
    TEND(4) TSTART(5)
    CUT(3)
    PH(8) { pg8::Gemm g{(const bf16_t*)(ws + WS_MERGED), (const bf16_t*)(ws + WS_WOUT), NTOK, 1024, 1024}; pg8::StaticOrder S; S.init(NTOK, 1024, G, bid);
      EpiOut E{P.in[0], P.out, (bf16_t*)(ws + WS_X1B), (float*)(ws + WS_RSS1)}; pg8::gemm_phase<EpiOut, pg8::StaticOrder, true, true>(lds, g, S, E); }
    GRID_SYNC();
    TEND(5) TSTART(6)
    CUT(4)
    PH(9) { pg8::Gemm g{(const bf16_t*)(ws + WS_X1B), (const bf16_t*)(ws + WS_WUP), NTOK, DFF, 1024}; pg8::StaticOrder S; S.init(NTOK, DFF, G, bid);
      EpiUp E{(const float*)(ws + WS_RSS1), (bf16_t*)(ws + WS_ABUF), (bf16_t*)(ws + WS_UBUF)}; pg8::gemm_phase<EpiUp, pg8::StaticOrder, true, true>(lds, g, S, E); }
    GRID_SYNC();
    TEND(6) TSTART(7)
    CUT(5)
    PH(10) { pg8::Gemm g{(const bf16_t*)(ws + WS_X1B), (const bf16_t*)(ws + WS_WUP) + (size_t)DFF * 1024, NTOK, DFF, 1024}; pg8::StaticOrder S; S.init(NTOK, DFF, G, bid);
      EpiUpGlu E{(const float*)(ws + WS_RSS1), (const bf16_t*)(ws + WS_ABUF), (bf16_t*)(ws + WS_UBUF), P.in[19], P.in[20]}; pg8::gemm_phase<EpiUpGlu, pg8::StaticOrder, true, true>(lds, g, S, E); }
    GRID_SYNC();
    TEND(7) TSTART(8)
    CUT(6)
    PH(11) { pg8::Gemm g{(const bf16_t*)(ws + WS_UBUF), (const bf16_t*)(ws + WS_WDOWN), NTOK, 1024, DFF}; pg8::StaticOrder S; S.init(NTOK, 1024, G, bid);
      if (G == 256) { EpiDownNorm E{(const bf16_t*)(ws + WS_X1B), P.in[22], (float*)(ws + WS_SLOTS), (unsigned*)(ws + WS_PCNT), P.out}; pg8::gemm_phase<EpiDownNorm, pg8::StaticOrder, false, true>(lds, g, S, E); }
      else { EpiDown E{(const bf16_t*)(ws + WS_X1B), P.out}; pg8::gemm_phase<EpiDown, pg8::StaticOrder, true, true>(lds, g, S, E); } }
    if (G != 256) { GRID_SYNC(); p7_final(P, G); }
    TEND(9)
#ifdef EXTRA_SYNCS
    for (int i_ = 0; i_ < EXTRA_SYNCS; ++i_) GRID_SYNC();
#endif
    if (TIME_PHASE >= 0) { const unsigned long long ts = __builtin_amdgcn_s_memrealtime(); while (__builtin_amdgcn_s_memrealtime() - ts < (tt1 - tt0)) __builtin_amdgcn_s_sleep(8); }
}

extern "C" void kernel_launch(void* const* d_in, const int* in_sizes, int n_in, void* d_out, int out_size, void* d_ws, size_t ws_size, hipStream_t stream) {
    static int grid = 0;
    if (grid == 0) {
        if (n_in != 23 || out_size != NTOK * DM || ws_size < WS_NEED) { fprintf(stderr, "kernel_launch: unexpected shapes (n_in %d out %d ws %zu)\n", n_in, out_size, ws_size); grid = -1; return; }
        int dev = 0, cus = 0, per_cu = 0;
        hipGetDevice(&dev); hipDeviceGetAttribute(&cus, hipDeviceAttributeMultiprocessorCount, dev);
        hipFuncSetAttribute((const void*)mega, hipFuncAttributeMaxDynamicSharedMemorySize, LDS_BYTES);
        hipOccupancyMaxActiveBlocksPerMultiprocessor(&per_cu, (const void*)mega, 512, LDS_BYTES);
        if (per_cu < 1) { fprintf(stderr, "kernel_launch: occupancy query says %d blocks per CU\n", per_cu); per_cu = 1; }
        grid = cus * 1;
        (void)hipGetLastError();
    }
    if (grid < 0) return;
    Params p{};
    for (int i = 0; i < 23; ++i) p.in[i] = (const float*)d_in[i];
    p.out = (float*)d_out; p.ws = (unsigned char*)d_ws;
    (void)hipMemsetAsync((char*)d_ws + WS_XBAR, 0, WS_CTLBYTES, stream);
    void* args[] = {&p};
    hipError_t e = hipLaunchCooperativeKernel((const void*)mega, dim3(grid), dim3(512), args, LDS_BYTES, stream);
    if (e != hipSuccess) fprintf(stderr, "cooperative launch failed: %s (grid %d)\n", hipGetErrorString(e), grid);
}
```

```cpp
#include <hip/hip_runtime.h>
#include <hip/hip_cooperative_groups.h>
#include <cstdio>
#include <cstdint>
namespace cg = cooperative_groups;

#define LAS __attribute__((address_space(3)))
typedef unsigned short bf16_t;
typedef short bf16x8 __attribute__((ext_vector_type(8)));
typedef short s16x4 __attribute__((ext_vector_type(4)));
typedef float f32x4 __attribute__((ext_vector_type(4)));
typedef float f32x16 __attribute__((ext_vector_type(16)));
typedef unsigned u32x4 __attribute__((ext_vector_type(4)));
typedef unsigned u32x2 __attribute__((ext_vector_type(2)));

typedef float f32x2_t __attribute__((ext_vector_type(2))); typedef __bf16 bf16x2_t __attribute__((ext_vector_type(2)));
__device__ __forceinline__ unsigned cvt_pk_bf16(float lo, float hi) { f32x2_t v = {lo, hi}; bf16x2_t b = __builtin_convertvector(v, bf16x2_t); return __builtin_bit_cast(unsigned, b); }
__device__ __forceinline__ float bf_lo(unsigned w) { return __uint_as_float(w << 16); }
__device__ __forceinline__ float bf_hi(unsigned w) { return __uint_as_float(w & 0xffff0000u); }
__device__ __forceinline__ float fast_exp2(float x) { return __builtin_amdgcn_exp2f(x); }
__device__ __forceinline__ float fast_exp(float x) { return __builtin_amdgcn_exp2f(x * 1.4426950408889634f); }
__device__ __forceinline__ float fast_rcp(float x) { return __builtin_amdgcn_rcpf(x); }
__device__ __forceinline__ float sigmoidf_(float x) { return fast_rcp(1.0f + fast_exp(-x)); }
#define LDS_WAIT() asm volatile("s_waitcnt lgkmcnt(0)" ::: "memory")

namespace pg8 {
#define PG8_LAS __attribute__((address_space(3)))
constexpr int BM = 256, BK = 64, HALF = 128, HTB = HALF * BK * 2, STAGE_BYTES = 8 * HTB, NXCD = 8, WGM = 8;
__host__ __device__ __forceinline__ int lds_byte(int r, int c) { const int st = (r >> 4) * 2 + (c >> 5), rr = r & 15, cc = c & 31, ob = rr * 64 + cc * 2; return st * 1024 + (ob ^ (((ob >> 9) & 1) << 5)); }
__host__ __device__ __forceinline__ void stage_rc(int b, int& R, int& C) { const int st = b / 1024, sb = b % 1024, swz = sb ^ (((sb >> 9) & 1) << 5); R = (st >> 1) * 16 + swz / 64; C = (st & 1) * 32 + (swz % 64) / 2; }
__host__ __device__ __forceinline__ int perm32(int rho) { const int n = rho >> 4, i = rho & 15; return 8 * (i >> 2) + 4 * n + (i & 3); }
struct Unit { int pm, pn; };
struct Gemm { const bf16_t* A; const bf16_t* Bt; int M, N, K; };
struct StaticOrder {
    int nM, nN, nwg, G, c;
    __host__ __device__ void init(int M, int N, int G_, int c_) { nM = M / BM; nN = N / BM; nwg = nM * nN; G = G_; c = c_; }
    __host__ __device__ bool next(int i, Unit& u) const {
        const long L = (long)i * G + c; if (L >= nwg) return false;
        int wgid = (int)L; { const int q = nwg / NXCD, r = nwg % NXCD, xcd = wgid % NXCD, off = wgid / NXCD; wgid = (xcd < r ? xcd * (q + 1) : r * (q + 1) + (xcd - r) * q) + off; }
        const int nig = WGM * nN, gid = wgid / nig, fm = gid * WGM, gsz = (nM - fm) < WGM ? (nM - fm) : WGM;
        u.pm = fm + ((wgid % nig) % gsz); u.pn = (wgid % nig) / gsz; return true;
    }
    __device__ __forceinline__ void a_ready(const Unit&) const {}
    __device__ __forceinline__ void done(const Unit&) const {}
};
template <class Epi, class Sched, bool ALIGN_EPI = false, bool SP2 = false>
__device__ __forceinline__ void gemm_phase(PG8_LAS unsigned char* lds, const Gemm g, const Sched& S, const Epi& E) {
    int tid_ = threadIdx.x; asm volatile("" : "+v"(tid_));
    const int tid = tid_, wid = __builtin_amdgcn_readfirstlane(tid >> 6), lane = tid & 63, wr = wid >> 2, wc = wid & 3, fr = lane & 15, fq = lane >> 4;
    const int K = g.K, nt = K / BK;
    unsigned voffA[2], voffB[2];
#pragma unroll
    for (int i = 0; i < 2; ++i) { int R, C; stage_rc(tid * 16 + i * 8192, R, C); const int Rb = Epi::PERM ? ((R & ~31) + perm32(R & 31)) : R;
        voffA[i] = (unsigned)(R * K + C) * 2u; voffB[i] = (unsigned)(Rb * K + C) * 2u; }
    const size_t kstep = (size_t)(BK * 2);
    const size_t hstep = (size_t)HALF * K * 2;
    const size_t tstep = 2 * hstep;
    const unsigned ldsw = (unsigned)wid * 1024u;
    const int aoff = lds_byte(wr * 64 + fr, fq * 8), boff = lds_byte(wc * 32 + fr, fq * 8);
#define PG8_SA(b, h) (((b) * 2 + (h)) * HTB)
#define PG8_SB(b, h) ((4 + (b) * 2 + (h)) * HTB)
#define PG8_STAGE(bufoff, gbase, voff) do { _Pragma("unroll") for (int _i = 0; _i < 2; ++_i) \
        __builtin_amdgcn_global_load_lds((const unsigned*)((const char*)(gbase) + (voff)[_i]), (PG8_LAS unsigned*)(lds + (bufoff) + ldsw + _i * 8192), 16, 0, 0); } while (0)
#define PG8_LDA(dst, b, h) do { _Pragma("unroll") for (int m = 0; m < 4; ++m) _Pragma("unroll") for (int k = 0; k < 2; ++k) dst[m][k] = *(const PG8_LAS bf16x8*)(lds + PG8_SA(b, h) + aoff + m * 2048 + k * 1024); } while (0)
#define PG8_LDB(dst, b, h) do { _Pragma("unroll") for (int n = 0; n < 2; ++n) _Pragma("unroll") for (int k = 0; k < 2; ++k) dst[n][k] = *(const PG8_LAS bf16x8*)(lds + PG8_SB(b, h) + boff + n * 2048 + k * 1024); } while (0)
#define PG8_MMA(ai, bj, At, Bt) do { __builtin_amdgcn_s_setprio(1); _Pragma("unroll") for (int m = 0; m < 4; ++m) _Pragma("unroll") for (int n = 0; n < 2; ++n) _Pragma("unroll") for (int k = 0; k < 2; ++k) \
        acc[ai][bj][m][n] = __builtin_amdgcn_mfma_f32_16x16x32_bf16(Bt[n][k], At[m][k], acc[ai][bj][m][n], 0, 0, 0); __builtin_amdgcn_s_setprio(0); } while (0)
#define PG8_WAIT_V(n) asm volatile("s_waitcnt vmcnt(" #n ")" ::: "memory")
#define PG8_WAIT_L(n) asm volatile("s_waitcnt lgkmcnt(" #n ")" ::: "memory")
#define PG8_BAR __builtin_amdgcn_s_barrier()
#define PG8_SCHED __builtin_amdgcn_sched_barrier(0)
    Unit cur, nxt; int ui = 0;
    if (!S.next(0, cur)) return;
    f32x4 acc[2][2][4][2];
#pragma unroll
    for (int a = 0; a < 2; ++a)
#pragma unroll
        for (int b = 0; b < 2; ++b)
#pragma unroll
            for (int m = 0; m < 4; ++m)
#pragma unroll
                for (int n = 0; n < 2; ++n) acc[a][b][m][n] = (f32x4){0.f, 0.f, 0.f, 0.f};
    bf16x8 At[4][2], B0[2][2], B1[2][2];
    const char* cA = (const char*)g.A + (size_t)cur.pm * tstep; const char* cB = (const char*)g.Bt + (size_t)cur.pn * tstep;
    S.a_ready(cur);
    if constexpr (SP2) {
        PG8_STAGE(PG8_SB(0, 0), cB, voffB); PG8_STAGE(PG8_SB(0, 1), cB + hstep, voffB); PG8_STAGE(PG8_SA(0, 0), cA, voffA); PG8_STAGE(PG8_SA(0, 1), cA + hstep, voffA);
        if (wr == 1) PG8_BAR;
        PG8_WAIT_V(2); PG8_BAR;
        PG8_STAGE(PG8_SB(1, 0), cB + kstep, voffB); PG8_STAGE(PG8_SA(1, 0), cA + kstep, voffA); PG8_STAGE(PG8_SB(1, 1), cB + hstep + kstep, voffB);
        PG8_WAIT_V(6); PG8_BAR;
    } else {
        PG8_STAGE(PG8_SB(0, 0), cB, voffB); PG8_STAGE(PG8_SA(0, 0), cA, voffA); PG8_STAGE(PG8_SB(0, 1), cB + hstep, voffB); PG8_STAGE(PG8_SA(0, 1), cA + hstep, voffA);
        if (wr == 1) PG8_BAR;
        PG8_WAIT_V(4); PG8_BAR;
        PG8_STAGE(PG8_SB(1, 0), cB + kstep, voffB); PG8_STAGE(PG8_SA(1, 0), cA + kstep, voffA); PG8_STAGE(PG8_SB(1, 1), cB + hstep + kstep, voffB);
        PG8_WAIT_V(6); PG8_BAR;
    }
    for (;;) {
        const bool has_next = S.next(ui + 1, nxt);
        const char* nA = has_next ? (const char*)g.A + (size_t)nxt.pm * tstep : cA; const char* nB = has_next ? (const char*)g.Bt + (size_t)nxt.pn * tstep : cB;
        for (int t = 0; t < nt; t += 2) {
            const bool last = (t == nt - 2);
            const char* a1 = cA + (size_t)(t + 1) * kstep;
            const char* a2 = last ? nA : cA + (size_t)(t + 2) * kstep; const char* b2 = last ? nB : cB + (size_t)(t + 2) * kstep;
            const char* a3 = a2 + kstep; const char* b3 = b2 + kstep;
            if (last && has_next) S.a_ready(nxt);
            if constexpr (SP2) {
            PG8_LDB(B0, 0, 0); PG8_LDB(B1, 0, 1); PG8_SCHED; PG8_LDA(At, 0, 0); PG8_STAGE(PG8_SA(1, 1), a1 + hstep, voffA);
            PG8_WAIT_V(8); PG8_WAIT_L(0); PG8_BAR; PG8_MMA(0, 0, At, B0); PG8_MMA(0, 1, At, B1); PG8_BAR; PG8_SCHED;
            PG8_LDA(At, 0, 1); PG8_STAGE(PG8_SB(0, 0), b2, voffB); PG8_STAGE(PG8_SB(0, 1), b2 + hstep, voffB); PG8_STAGE(PG8_SA(0, 0), a2, voffA);
            PG8_WAIT_V(8); PG8_WAIT_L(0); PG8_BAR; PG8_MMA(1, 0, At, B0); PG8_MMA(1, 1, At, B1); PG8_BAR; PG8_SCHED;
            PG8_LDB(B0, 1, 0); PG8_LDB(B1, 1, 1); PG8_SCHED; PG8_LDA(At, 1, 0); PG8_STAGE(PG8_SA(0, 1), a2 + hstep, voffA);
            PG8_WAIT_V(8); PG8_WAIT_L(0); PG8_BAR; PG8_MMA(0, 0, At, B0); PG8_MMA(0, 1, At, B1); PG8_BAR; PG8_SCHED;
            PG8_LDA(At, 1, 1); PG8_STAGE(PG8_SB(1, 0), b3, voffB); PG8_STAGE(PG8_SB(1, 1), b3 + hstep, voffB); PG8_STAGE(PG8_SA(1, 0), a3, voffA);
            PG8_WAIT_V(8); PG8_WAIT_L(0); PG8_BAR; PG8_MMA(1, 0, At, B0); PG8_MMA(1, 1, At, B1); PG8_BAR; PG8_SCHED;
            } else {
            PG8_LDB(B0, 0, 0); PG8_SCHED; PG8_LDA(At, 0, 0); PG8_STAGE(PG8_SA(1, 1), a1 + hstep, voffA);
            PG8_WAIT_L(8); PG8_BAR; PG8_WAIT_L(0); PG8_MMA(0, 0, At, B0); PG8_BAR; PG8_SCHED;
            PG8_LDB(B1, 0, 1); PG8_STAGE(PG8_SB(0, 0), b2, voffB);
            PG8_BAR; PG8_WAIT_L(0); PG8_MMA(0, 1, At, B1); PG8_BAR;
            PG8_LDA(At, 0, 1); PG8_STAGE(PG8_SA(0, 0), a2, voffA);
            PG8_BAR; PG8_WAIT_L(0); PG8_MMA(1, 0, At, B0); PG8_BAR; PG8_SCHED;
            PG8_STAGE(PG8_SB(0, 1), b2 + hstep, voffB);
            PG8_WAIT_V(6); PG8_BAR; PG8_MMA(1, 1, At, B1); PG8_BAR;
            PG8_LDB(B0, 1, 0); PG8_SCHED; PG8_LDA(At, 1, 0); PG8_STAGE(PG8_SA(0, 1), a2 + hstep, voffA);
            PG8_WAIT_L(8); PG8_BAR; PG8_WAIT_L(0); PG8_MMA(0, 0, At, B0); PG8_BAR; PG8_SCHED;
            PG8_LDB(B1, 1, 1); PG8_STAGE(PG8_SB(1, 0), b3, voffB);
            PG8_BAR; PG8_WAIT_L(0); PG8_MMA(0, 1, At, B1); PG8_BAR;
            PG8_LDA(At, 1, 1); PG8_STAGE(PG8_SA(1, 0), a3, voffA);
            PG8_BAR; PG8_WAIT_L(0); PG8_MMA(1, 0, At, B0); PG8_BAR; PG8_SCHED;
            PG8_STAGE(PG8_SB(1, 1), b3 + hstep, voffB);
            PG8_WAIT_V(6); PG8_BAR; PG8_MMA(1, 1, At, B1); PG8_BAR;
            }
        }
        if constexpr (ALIGN_EPI) { if (wr == 0) PG8_BAR; }
        if constexpr (!Epi::AFTER_DRAIN) { E(acc, cur, wr, wc, fr, fq); S.done(cur); }
        if (!has_next) break;
#pragma unroll
        for (int a = 0; a < 2; ++a)
#pragma unroll
            for (int b = 0; b < 2; ++b)
#pragma unroll
                for (int m = 0; m < 4; ++m)
#pragma unroll
                    for (int n = 0; n < 2; ++n) acc[a][b][m][n] = (f32x4){0.f, 0.f, 0.f, 0.f};
        cur = nxt; cA = nA; cB = nB; ++ui;
        if constexpr (ALIGN_EPI) { if (wr == 1) PG8_BAR; }
    }
    PG8_WAIT_V(0);
    if constexpr (!ALIGN_EPI) { if (wr == 0) PG8_BAR; }
    PG8_BAR;
    if constexpr (Epi::AFTER_DRAIN) { E.fused(acc, cur, wr, wc, fr, fq, lds, wid, lane); S.done(cur); }
#undef PG8_SA
#undef PG8_SB
#undef PG8_STAGE
#undef PG8_LDA
#undef PG8_LDB
#undef PG8_MMA
#undef PG8_WAIT_V
#undef PG8_WAIT_L
#undef PG8_BAR
#undef PG8_SCHED
}
}

constexpr int NTOK = 16384, DM = 1024, SEQ = 2048, NBATCH = 8, MEMLEN = 256, NMEM = NBATCH * MEMLEN, DFF = 2816;
constexpr int INW = 7184, INW_P = 7168;
constexpr float EPS = 1e-6f;
constexpr float LOG2E = 1.4426950408889634f;
constexpr size_t MiB = 1u << 20;
constexpr size_t WS_MLQ = 0, WS_MLK = 16 * MiB, WS_MLV = 32 * MiB, WS_MLO = 48 * MiB, WS_NAQ = 64 * MiB, WS_XAQ = 80 * MiB, WS_NAK = 96 * MiB, WS_NAVT = 112 * MiB, WS_G = 128 * MiB;
constexpr size_t WS_WBR = 224 * MiB, WS_WOUT = 227 * MiB, WS_WUP = 229 * MiB, WS_WDOWN = 240 * MiB, WS_MEMK = 246 * MiB, WS_MEMVT = 248 * MiB, WS_GATES = 250 * MiB, WS_RSS1 = 251 * MiB;
constexpr size_t WS_XBAR = 251 * MiB + 131072;
constexpr size_t WS_PCNT = WS_XBAR + 16384, WS_SUBCNT = WS_XBAR + 32768, WS_CTLBYTES = 32768 + 1024, WS_SLOTS = 251 * MiB + 262144;
constexpr size_t WS_NEED = 252 * MiB;
constexpr size_t WS_TMP = 0, WS_MERGED = WS_NAK, WS_X1B = 0, WS_UBUF = 32 * MiB, WS_ABUF = WS_G;
constexpr size_t DO_H = 0, DO_WINT = 32 * MiB, DO_WMEMKVT = 46 * MiB, DO_MEMN = 48 * MiB, DO_QC = 0, DO_KC = 16 * MiB, DO_HFW = 32 * MiB, DO_HBW = 48 * MiB;
constexpr int LDS_BYTES = 155648;
constexpr int XA_K_PITCH = 272, XA_VT_PITCH = 528, XA_VT_OFF = 256 * XA_K_PITCH;
constexpr int NA_RPB_OFF = 140000;
constexpr int LDS_XB_OFF = 155136;
constexpr int ML_QP = 272, ML_TP = 144;
constexpr int ML_QS = 0, ML_KS = ML_QS + 64 * ML_QP, ML_KT = ML_KS + 64 * ML_QP, ML_VT = ML_KT + 128 * ML_TP, ML_WVT = ML_VT + 128 * ML_TP, ML_PS = ML_WVT + 128 * ML_TP;
constexpr int ML_NV = ML_PS + 64 * ML_TP, ML_ROWSUM = ML_NV + 2 * 128 * 4, ML_DENI = ML_ROWSUM + 1024, ML_WTS = ML_DENI + 256, ML_CW = ML_WTS + 256, ML_END = ML_CW + 4 * 256 * 4;
static_assert(ML_END <= LDS_BYTES, "mlstm lds");

struct Params { const float* in[23]; float* out; unsigned char* ws; };

constexpr int TR_LDS_OFF = 131072, TR_PITCH = 48, TR_WAVE_BYTES = 32 * TR_PITCH;
__device__ __forceinline__ u32x4 tr16x32(PG8_LAS unsigned char* patch, int fr, int fq, int lane, const f32x4 v0, const f32x4 v1) {
    const unsigned w0 = cvt_pk_bf16(v0[0], v0[1]), w1 = cvt_pk_bf16(v0[2], v0[3]), w2 = cvt_pk_bf16(v1[0], v1[1]), w3 = cvt_pk_bf16(v1[2], v1[3]);
    PG8_LAS unsigned short* p = (PG8_LAS unsigned short*)(patch + (8 * fq) * TR_PITCH + fr * 2);
    p[0 * (TR_PITCH / 2)] = (unsigned short)w0; p[1 * (TR_PITCH / 2)] = (unsigned short)(w0 >> 16); p[2 * (TR_PITCH / 2)] = (unsigned short)w1; p[3 * (TR_PITCH / 2)] = (unsigned short)(w1 >> 16);
    p[4 * (TR_PITCH / 2)] = (unsigned short)w2; p[5 * (TR_PITCH / 2)] = (unsigned short)(w2 >> 16); p[6 * (TR_PITCH / 2)] = (unsigned short)w3; p[7 * (TR_PITCH / 2)] = (unsigned short)(w3 >> 16);
    asm volatile("s_waitcnt lgkmcnt(0)" ::: "memory");
    const u32x4 r = *(const PG8_LAS u32x4*)(patch + (lane >> 1) * TR_PITCH + (lane & 1) * 16);
    asm volatile("s_waitcnt lgkmcnt(0)" ::: "memory");
    return r;
}

struct EpiProj {
    static constexpr bool PERM = true, AFTER_DRAIN = false;
    unsigned char* ws; const float* bmerge; PG8_LAS unsigned char* lds;
    __device__ __forceinline__ void operator()(const f32x4 (&acc)[2][2][4][2], const pg8::Unit& u, int wr, int wc, int fr, int fq) const {
        const int row0 = u.pm * 256 + wr * 64 + fr; const int pn = u.pn; const int cl = wc * 32 + 8 * fq;
        if (pn >= 16) {
            bf16_t* G = (bf16_t*)(ws + WS_G); const int cg0 = (pn - 16) * 256 + cl;
            f32x4 bv[2][2];
#pragma unroll
            for (int bj = 0; bj < 2; ++bj)
#pragma unroll
                for (int n = 0; n < 2; ++n) bv[bj][n] = *(const f32x4*)(bmerge + cg0 + bj * 128 + 4 * n);
#pragma unroll
            for (int ai = 0; ai < 2; ++ai)
#pragma unroll
                for (int m = 0; m < 4; ++m) { const size_t row = row0 + ai * 128 + m * 16;
#pragma unroll
                    for (int bj = 0; bj < 2; ++bj) { const f32x4 v0 = acc[ai][bj][m][0] + bv[bj][0], v1 = acc[ai][bj][m][1] + bv[bj][1];
                        u32x4 w; w.x = cvt_pk_bf16(v0[0], v0[1]); w.y = cvt_pk_bf16(v0[2], v0[3]);
                        w.z = cvt_pk_bf16(v1[0], v1[1]); w.w = cvt_pk_bf16(v1[2], v1[3]);
                        *(u32x4*)(G + row * 3072 + cg0 + bj * 128) = w; } }
        } else {
            const int bi = pn >> 1, coff = (pn & 1) * 256 + cl;
            if (bi == 6) {
                bf16_t* VT = (bf16_t*)(ws + WS_NAVT);
                const int lane = fq * 16 + fr; PG8_LAS unsigned char* patch = lds + TR_LDS_OFF + (wr * 4 + wc) * TR_WAVE_BYTES;
#pragma unroll
                for (int ai = 0; ai < 2; ++ai)
#pragma unroll
                    for (int m = 0; m < 4; ++m) { const int rowb = u.pm * 256 + wr * 64 + ai * 128 + m * 16; const int b = rowb >> 11, tok0 = rowb & 2047;
#pragma unroll
                        for (int bj = 0; bj < 2; ++bj) { const u32x4 r = tr16x32(patch, fr, fq, lane, acc[ai][bj][m][0], acc[ai][bj][m][1]);
                            const int col = (pn & 1) * 256 + bj * 128 + wc * 32 + (lane >> 1);
                            *(u32x4*)(VT + ((size_t)(b * 512 + col)) * 2048 + tok0 + (lane & 1) * 8) = r; } }
            } else {
                const size_t boff = bi == 0 ? WS_MLQ : bi == 1 ? WS_MLK : bi == 2 ? WS_MLV : bi == 3 ? WS_MLO : bi == 4 ? WS_NAQ : bi == 5 ? WS_NAK : WS_XAQ;
                bf16_t* O = (bf16_t*)(ws + boff);
#pragma unroll
                for (int ai = 0; ai < 2; ++ai)
#pragma unroll
                    for (int m = 0; m < 4; ++m) { const size_t row = row0 + ai * 128 + m * 16;
#pragma unroll
                        for (int bj = 0; bj < 2; ++bj) { const f32x4 v0 = acc[ai][bj][m][0], v1 = acc[ai][bj][m][1];
                            u32x4 w; w.x = cvt_pk_bf16(v0[0], v0[1]); w.y = cvt_pk_bf16(v0[2], v0[3]); w.z = cvt_pk_bf16(v1[0], v1[1]); w.w = cvt_pk_bf16(v1[2], v1[3]);
                            *(u32x4*)(O + row * 512 + coff + bj * 128) = w; } }
            }
        }
    }
};
struct EpiMemKV {
    static constexpr bool PERM = true, AFTER_DRAIN = false;
    unsigned char* ws; PG8_LAS unsigned char* lds;
    __device__ __forceinline__ void operator()(const f32x4 (&acc)[2][2][4][2], const pg8::Unit& u, int wr, int wc, int fr, int fq) const {
        const int row0 = u.pm * 256 + wr * 64 + fr; const int pn = u.pn; const int coff = (pn & 1) * 256 + wc * 32 + 8 * fq;
        if (pn < 2) { bf16_t* O = (bf16_t*)(ws + WS_MEMK);
#pragma unroll
            for (int ai = 0; ai < 2; ++ai)
#pragma unroll
                for (int m = 0; m < 4; ++m) { const size_t row = row0 + ai * 128 + m * 16;
#pragma unroll
                    for (int bj = 0; bj < 2; ++bj) { const f32x4 v0 = acc[ai][bj][m][0], v1 = acc[ai][bj][m][1];
                        u32x4 w; w.x = cvt_pk_bf16(v0[0], v0[1]); w.y = cvt_pk_bf16(v0[2], v0[3]); w.z = cvt_pk_bf16(v1[0], v1[1]); w.w = cvt_pk_bf16(v1[2], v1[3]);
                        *(u32x4*)(O + row * 512 + coff + bj * 128) = w; } }
        } else { bf16_t* VT = (bf16_t*)(ws + WS_MEMVT);
            const int lane = fq * 16 + fr; PG8_LAS unsigned char* patch = lds + TR_LDS_OFF + (wr * 4 + wc) * TR_WAVE_BYTES;
#pragma unroll
            for (int ai = 0; ai < 2; ++ai)
#pragma unroll
                for (int m = 0; m < 4; ++m) { const int rowb = u.pm * 256 + wr * 64 + ai * 128 + m * 16; const int b = rowb >> 8, mm0 = rowb & 255;
#pragma unroll
                    for (int bj = 0; bj < 2; ++bj) { const u32x4 r = tr16x32(patch, fr, fq, lane, acc[ai][bj][m][0], acc[ai][bj][m][1]);
                        const int col = (pn & 1) * 256 + bj * 128 + wc * 32 + (lane >> 1);
                        *(u32x4*)(VT + ((size_t)(b * 512 + col)) * 256 + mm0 + (lane & 1) * 8) = r; } }
        }
    }
};
template <int MODE> struct EpiBranch {
    static constexpr bool PERM = true, AFTER_DRAIN = false;
    const bf16_t* G; float* tmp; bf16_t* merged; int br;
    __device__ __forceinline__ void operator()(const f32x4 (&acc)[2][2][4][2], const pg8::Unit& u, int wr, int wc, int fr, int fq) const {
        const int row0 = u.pm * 256 + wr * 64 + fr; const int col0 = u.pn * 256 + wc * 32 + 8 * fq;
#pragma unroll
        for (int ai = 0; ai < 2; ++ai)
#pragma unroll
            for (int m = 0; m < 4; ++m) { const size_t row = row0 + ai * 128 + m * 16;
#pragma unroll
                for (int bj = 0; bj < 2; ++bj) { const int col = col0 + bj * 128;
                    const u32x4 gw = *(const u32x4*)(G + row * 3072 + br * 1024 + col);
                    f32x4 v0 = acc[ai][bj][m][0], v1 = acc[ai][bj][m][1];
                    v0[0] *= bf_lo(gw.x); v0[1] *= bf_hi(gw.x); v0[2] *= bf_lo(gw.y); v0[3] *= bf_hi(gw.y);
                    v1[0] *= bf_lo(gw.z); v1[1] *= bf_hi(gw.z); v1[2] *= bf_lo(gw.w); v1[3] *= bf_hi(gw.w);
                    float* tp = tmp + row * 1024 + col;
                    if (MODE >= 1) { v0 += *(const f32x4*)tp; v1 += *(const f32x4*)(tp + 4); }
                    if (MODE <= 1) { *(f32x4*)tp = v0; *(f32x4*)(tp + 4) = v1; }
                    else { u32x4 w; w.x = cvt_pk_bf16(v0[0], v0[1]); w.y = cvt_pk_bf16(v0[2], v0[3]); w.z = cvt_pk_bf16(v1[0], v1[1]); w.w = cvt_pk_bf16(v1[2], v1[3]);
                        *(u32x4*)(merged + row * 1024 + col) = w; } } }
    }
};
struct BranchOrder {
    int G, c, mode, nblk, x;
    __host__ __device__ void init(int G_, int c_, int mode_, int nblk_, int x_) { G = G_; c = c_; mode = mode_; nblk = nblk_; x = x_; }
    __host__ __device__ bool next(int i, pg8::Unit& u) const {
        pg8::StaticOrder base; pg8::Unit t; int br;
        if (mode == 2) { const int q = x + i * nblk; if (q >= 512) return false; br = 1 + (q & 1); base.init(NTOK, 1024, 256, q >> 1); if (!base.next(0, t)) return false; }
        else { if (i >= (mode == 0 ? 1 : 3)) return false; br = mode == 0 ? 0 : (i == 2 ? 0 : i + 1); base.init(NTOK, 1024, G, c); if (!base.next(0, t)) return false; }
        u.pm = br * 64 + t.pm; u.pn = br * 4 + t.pn; return true;
    }
    __device__ __forceinline__ void a_ready(const pg8::Unit&) const {}
    __device__ __forceinline__ void done(const pg8::Unit&) const {}
};
struct EpiBranchAcc {
    static constexpr bool PERM = true, AFTER_DRAIN = false;
    bf16_t* G; bf16_t* merged;
    __device__ __forceinline__ void operator()(const f32x4 (&acc)[2][2][4][2], const pg8::Unit& u, int wr, int wc, int fr, int fq) const {
        const int br = u.pm >> 6, pm = u.pm & 63, pn = u.pn & 3;
        const int row0 = pm * 256 + wr * 64 + fr; const int col0 = pn * 256 + wc * 32 + 8 * fq;
#pragma unroll
        for (int ai = 0; ai < 2; ++ai)
#pragma unroll
          for (int mh = 0; mh < 2; ++mh) {
            u32x4 gw[2][2], p1[2][2], p2[2][2];
#pragma unroll
            for (int mm = 0; mm < 2; ++mm)
#pragma unroll
                for (int bj = 0; bj < 2; ++bj) { const size_t row = row0 + ai * 128 + (2 * mh + mm) * 16; const bf16_t* gp = G + row * 3072 + br * 1024 + col0 + bj * 128;
                    gw[mm][bj] = *(const u32x4*)gp;
                    if (br == 0) { p1[mm][bj] = *(const u32x4*)(gp + 1024); p2[mm][bj] = *(const u32x4*)(gp + 2048); } }
#pragma unroll
            for (int mm = 0; mm < 2; ++mm)
#pragma unroll
                for (int bj = 0; bj < 2; ++bj) { const int m = 2 * mh + mm; const size_t row = row0 + ai * 128 + m * 16; const int col = col0 + bj * 128;
                    const u32x4 g = gw[mm][bj];
                    f32x4 v0 = acc[ai][bj][m][0], v1 = acc[ai][bj][m][1];
                    v0[0] *= sigmoidf_(bf_lo(g.x)); v0[1] *= sigmoidf_(bf_hi(g.x)); v0[2] *= sigmoidf_(bf_lo(g.y)); v0[3] *= sigmoidf_(bf_hi(g.y));
                    v1[0] *= sigmoidf_(bf_lo(g.z)); v1[1] *= sigmoidf_(bf_hi(g.z)); v1[2] *= sigmoidf_(bf_lo(g.w)); v1[3] *= sigmoidf_(bf_hi(g.w));
                    if (br != 0) { u32x4 w; w.x = cvt_pk_bf16(v0[0], v0[1]); w.y = cvt_pk_bf16(v0[2], v0[3]); w.z = cvt_pk_bf16(v1[0], v1[1]); w.w = cvt_pk_bf16(v1[2], v1[3]);
                        *(u32x4*)(G + row * 3072 + br * 1024 + col) = w; }
                    else { const u32x4 q1 = p1[mm][bj], q2 = p2[mm][bj];
                        v0[0] += bf_lo(q1.x) + bf_lo(q2.x); v0[1] += bf_hi(q1.x) + bf_hi(q2.x); v0[2] += bf_lo(q1.y) + bf_lo(q2.y); v0[3] += bf_hi(q1.y) + bf_hi(q2.y);
                        v1[0] += bf_lo(q1.z) + bf_lo(q2.z); v1[1] += bf_hi(q1.z) + bf_hi(q2.z); v1[2] += bf_lo(q1.w) + bf_lo(q2.w); v1[3] += bf_hi(q1.w) + bf_hi(q2.w);
                        u32x4 w; w.x = cvt_pk_bf16(v0[0], v0[1]); w.y = cvt_pk_bf16(v0[2], v0[3]); w.z = cvt_pk_bf16(v1[0], v1[1]); w.w = cvt_pk_bf16(v1[2], v1[3]);
                        *(u32x4*)(merged + row * 1024 + col) = w; } }
          }
    }
};
struct EpiOut {
    static constexpr bool PERM = true, AFTER_DRAIN = false;
    const float* x; float* x1; bf16_t* x1b; float* rss;
    __device__ __forceinline__ void operator()(const f32x4 (&acc)[2][2][4][2], const pg8::Unit& u, int wr, int wc, int fr, int fq) const {
        const int row0 = u.pm * 256 + wr * 64 + fr; const int col0 = u.pn * 256 + wc * 32 + 8 * fq;
#pragma unroll
        for (int ai = 0; ai < 2; ++ai)
#pragma unroll
          for (int mh = 0; mh < 2; ++mh) {
            f32x4 xa[2][2], xb[2][2];
#pragma unroll
            for (int mm = 0; mm < 2; ++mm)
#pragma unroll
                for (int bj = 0; bj < 2; ++bj) { const size_t off = (size_t)(row0 + ai * 128 + (2 * mh + mm) * 16) * 1024 + col0 + bj * 128; xa[mm][bj] = *(const f32x4*)(x + off); xb[mm][bj] = *(const f32x4*)(x + off + 4); }
#pragma unroll
            for (int mm = 0; mm < 2; ++mm) { const int m = 2 * mh + mm; const size_t row = row0 + ai * 128 + m * 16; float ss = 0.f;
#pragma unroll
                for (int bj = 0; bj < 2; ++bj) { const size_t off = row * 1024 + col0 + bj * 128;
                    const f32x4 v0 = acc[ai][bj][m][0] + xa[mm][bj], v1 = acc[ai][bj][m][1] + xb[mm][bj];
                    u32x4 w; w.x = cvt_pk_bf16(v0[0], v0[1]); w.y = cvt_pk_bf16(v0[2], v0[3]); w.z = cvt_pk_bf16(v1[0], v1[1]); w.w = cvt_pk_bf16(v1[2], v1[3]);
                    *(u32x4*)(x1b + off) = w;
                    ss += (v0[0] * v0[0] + v0[1] * v0[1]) + (v0[2] * v0[2] + v0[3] * v0[3]) + (v1[0] * v1[0] + v1[1] * v1[1]) + (v1[2] * v1[2] + v1[3] * v1[3]); }
                ss += __shfl_xor(ss, 16); ss += __shfl_xor(ss, 32);
                if (fq == 0) atomicAdd(rss + row, ss); }
          }
    }
};
struct EpiUp {
    static constexpr bool PERM = true, AFTER_DRAIN = false;
    const float* rss; bf16_t* A; bf16_t* U;
    __device__ __forceinline__ void operator()(const f32x4 (&acc)[2][2][4][2], const pg8::Unit& u, int wr, int wc, int fr, int fq) const {
        const int row0 = u.pm * 256 + wr * 64 + fr; const int pn = u.pn;
        bf16_t* O = pn < 11 ? A : U; const int col0 = (pn < 11 ? pn : pn - 11) * 256 + wc * 32 + 8 * fq;
#pragma unroll
        for (int ai = 0; ai < 2; ++ai)
#pragma unroll
            for (int m = 0; m < 4; ++m) { const size_t row = row0 + ai * 128 + m * 16; const float rstd = rsqrtf(rss[row] * (1.0f / 1024.0f) + EPS);
#pragma unroll
                for (int bj = 0; bj < 2; ++bj) { const f32x4 v0 = acc[ai][bj][m][0] * rstd, v1 = acc[ai][bj][m][1] * rstd;
                    u32x4 w; w.x = cvt_pk_bf16(v0[0], v0[1]); w.y = cvt_pk_bf16(v0[2], v0[3]); w.z = cvt_pk_bf16(v1[0], v1[1]); w.w = cvt_pk_bf16(v1[2], v1[3]);
                    *(u32x4*)(O + row * 2816 + col0 + bj * 128) = w; } }
    }
};
struct EpiUpGlu {
    static constexpr bool PERM = true, AFTER_DRAIN = false;
    const float* rss; const bf16_t* A; bf16_t* Gout; const float* cw; const float* cb;
    __device__ __forceinline__ void operator()(const f32x4 (&acc)[2][2][4][2], const pg8::Unit& u, int wr, int wc, int fr, int fq) const {
        const int row0 = u.pm * 256 + wr * 64 + fr;
#pragma unroll
        for (int bj = 0; bj < 2; ++bj) {
            const int ch0 = u.pn * 256 + bj * 128 + wc * 32 + 8 * fq;
            float w0[8], w1[8], w2[8], bb[8];
#pragma unroll
            for (int q = 0; q < 2; ++q) { const f32x4 t0 = *(const f32x4*)(cw + ch0 + 4 * q), t1 = *(const f32x4*)(cw + 2816 + ch0 + 4 * q), t2 = *(const f32x4*)(cw + 5632 + ch0 + 4 * q), t3 = *(const f32x4*)(cb + ch0 + 4 * q);
#pragma unroll
                for (int i = 0; i < 4; ++i) { w0[4 * q + i] = t0[i]; w1[4 * q + i] = t1[i]; w2[4 * q + i] = t2[i]; bb[4 * q + i] = t3[i]; } }
#pragma unroll
            for (int ai = 0; ai < 2; ++ai)
#pragma unroll
              for (int mh = 0; mh < 2; ++mh) {
                u32x4 am[2], ac[2], an[2]; float rs[2];
#pragma unroll
                for (int mm = 0; mm < 2; ++mm) { const int m = 2 * mh + mm; const size_t row = row0 + ai * 128 + m * 16; const int sp = (int)(row & 2047);
                    const bf16_t* ap = A + row * 2816 + ch0; const u32x4 zc = {0u, 0u, 0u, 0u};
                    ac[mm] = *(const u32x4*)ap; am[mm] = sp > 0 ? *(const u32x4*)(ap - 2816) : zc; an[mm] = sp < 2047 ? *(const u32x4*)(ap + 2816) : zc; rs[mm] = rss[row]; }
#pragma unroll
                for (int mm = 0; mm < 2; ++mm) { const int m = 2 * mh + mm; const size_t row = row0 + ai * 128 + m * 16;
                    const float rstd = rsqrtf(rs[mm] * (1.0f / 1024.0f) + EPS);
                    const float pv[8] = {bf_lo(am[mm].x), bf_hi(am[mm].x), bf_lo(am[mm].y), bf_hi(am[mm].y), bf_lo(am[mm].z), bf_hi(am[mm].z), bf_lo(am[mm].w), bf_hi(am[mm].w)};
                    const float cv[8] = {bf_lo(ac[mm].x), bf_hi(ac[mm].x), bf_lo(ac[mm].y), bf_hi(ac[mm].y), bf_lo(ac[mm].z), bf_hi(ac[mm].z), bf_lo(ac[mm].w), bf_hi(ac[mm].w)};
                    const float nv[8] = {bf_lo(an[mm].x), bf_hi(an[mm].x), bf_lo(an[mm].y), bf_hi(an[mm].y), bf_lo(an[mm].z), bf_hi(an[mm].z), bf_lo(an[mm].w), bf_hi(an[mm].w)};
                    const f32x4 u0 = acc[ai][bj][m][0] * rstd, u1 = acc[ai][bj][m][1] * rstd;
                    float o[8];
#pragma unroll
                    for (int q = 0; q < 8; ++q) { const float y = w0[q] * pv[q] + w1[q] * cv[q] + w2[q] * nv[q] + bb[q];
                        const float z = 1.5957691216057308f * (y + 0.044715f * y * y * y);
                        o[q] = y * sigmoidf_(z) * (q < 4 ? u0[q] : u1[q - 4]); }
                    u32x4 w; w.x = cvt_pk_bf16(o[0], o[1]); w.y = cvt_pk_bf16(o[2], o[3]); w.z = cvt_pk_bf16(o[4], o[5]); w.w = cvt_pk_bf16(o[6], o[7]);
                    *(u32x4*)(Gout + row * 2816 + ch0) = w; }
              }
        }
    }
};
struct EpiDown {
    static constexpr bool PERM = true, AFTER_DRAIN = false;
    const bf16_t* x1; float* outp;
    __device__ __forceinline__ void operator()(const f32x4 (&acc)[2][2][4][2], const pg8::Unit& u, int wr, int wc, int fr, int fq) const {
        const int row0 = u.pm * 256 + wr * 64 + fr; const int col0 = u.pn * 256 + wc * 32 + 8 * fq;
#pragma unroll
        for (int ai = 0; ai < 2; ++ai)
#pragma unroll
            for (int m = 0; m < 4; ++m) { const size_t row = row0 + ai * 128 + m * 16;
#pragma unroll
                for (int bj = 0; bj < 2; ++bj) { const size_t off = row * 1024 + col0 + bj * 128; const u32x4 xw = *(const u32x4*)(x1 + off); float* p = outp + off;
                    const f32x4 v0 = acc[ai][bj][m][0] + (f32x4){bf_lo(xw.x), bf_hi(xw.x), bf_lo(xw.y), bf_hi(xw.y)}, v1 = acc[ai][bj][m][1] + (f32x4){bf_lo(xw.z), bf_hi(xw.z), bf_lo(xw.w), bf_hi(xw.w)};
                    *(f32x4*)p = v0; *(f32x4*)(p + 4) = v1; } }
    }
};

struct EpiDownNorm {
    static constexpr bool PERM = true, AFTER_DRAIN = true;
    const bf16_t* x1; const float* gfin; float* slots; unsigned* cnt; float* outp;
    __device__ __forceinline__ void operator()(const f32x4 (&)[2][2][4][2], const pg8::Unit&, int, int, int, int) const {}
    __device__ __forceinline__ void fused(f32x4 (&acc)[2][2][4][2], const pg8::Unit& u, int wr, int wc, int fr, int fq, PG8_LAS unsigned char* lds, int wid, int lane) const {
        PG8_LAS float* Pt = (PG8_LAS float*)lds;
        PG8_LAS float* St = (PG8_LAS float*)(lds + 4096);
        const int row0 = u.pm * 256 + wr * 64 + fr; const int col0 = u.pn * 256 + wc * 32 + 8 * fq;
#pragma unroll
        for (int ai = 0; ai < 2; ++ai) {
            u32x4 xq[4][2];
#pragma unroll
            for (int m = 0; m < 4; ++m)
#pragma unroll
                for (int bj = 0; bj < 2; ++bj) xq[m][bj] = *(const u32x4*)(x1 + (size_t)(row0 + ai * 128 + m * 16) * 1024 + col0 + bj * 128);
#pragma unroll
            for (int m = 0; m < 4; ++m) { const size_t row = row0 + ai * 128 + m * 16; float ss = 0.f;
#pragma unroll
                for (int bj = 0; bj < 2; ++bj) { const u32x4 xw = xq[m][bj];
                    const f32x4 v0 = acc[ai][bj][m][0] + (f32x4){bf_lo(xw.x), bf_hi(xw.x), bf_lo(xw.y), bf_hi(xw.y)}, v1 = acc[ai][bj][m][1] + (f32x4){bf_lo(xw.z), bf_hi(xw.z), bf_lo(xw.w), bf_hi(xw.w)};
                    acc[ai][bj][m][0] = v0; acc[ai][bj][m][1] = v1;
                    ss += (v0[0] * v0[0] + v0[1] * v0[1]) + (v0[2] * v0[2] + v0[3] * v0[3]) + (v1[0] * v1[0] + v1[1] * v1[1]) + (v1[2] * v1[2] + v1[3] * v1[3]); }
                ss += __shfl_xor(ss, 16); ss += __shfl_xor(ss, 32);
                if (fq == 0) Pt[(ai * 128 + wr * 64 + m * 16 + fr) * 4 + wc] = ss; }
        }
        asm volatile("s_waitcnt lgkmcnt(0)" ::: "memory"); __builtin_amdgcn_s_barrier(); asm volatile("" ::: "memory");
        const int t = wid * 64 + lane;
        if (t < 256) { const float tot = (Pt[t * 4] + Pt[t * 4 + 1]) + (Pt[t * 4 + 2] + Pt[t * 4 + 3]);
            __hip_atomic_store(slots + ((size_t)(u.pm * 256 + t) * 4 + u.pn), tot, __ATOMIC_RELAXED, __HIP_MEMORY_SCOPE_AGENT); }
        asm volatile("s_waitcnt vmcnt(0)" ::: "memory"); __builtin_amdgcn_s_barrier(); asm volatile("" ::: "memory");
        if (t == 0) { __hip_atomic_fetch_add(cnt + 64 * u.pm, 1u, __ATOMIC_RELAXED, __HIP_MEMORY_SCOPE_AGENT);
            unsigned sp = 0; while (__hip_atomic_load(cnt + 64 * u.pm, __ATOMIC_RELAXED, __HIP_MEMORY_SCOPE_AGENT) < 4u) { __builtin_amdgcn_s_sleep(2); if (++sp > (1u << 22)) break; }
            __builtin_amdgcn_fence(__ATOMIC_ACQUIRE, "agent"); asm volatile("s_waitcnt vmcnt(0)" ::: "memory"); }
        __builtin_amdgcn_s_barrier(); asm volatile("" ::: "memory");
        if (t < 256) { const float* sl = slots + (size_t)(u.pm * 256 + t) * 4;
            const float tot = (__hip_atomic_load(sl, __ATOMIC_RELAXED, __HIP_MEMORY_SCOPE_AGENT) + __hip_atomic_load(sl + 1, __ATOMIC_RELAXED, __HIP_MEMORY_SCOPE_AGENT))
                            + (__hip_atomic_load(sl + 2, __ATOMIC_RELAXED, __HIP_MEMORY_SCOPE_AGENT) + __hip_atomic_load(sl + 3, __ATOMIC_RELAXED, __HIP_MEMORY_SCOPE_AGENT));
            St[t] = rsqrtf(tot * (1.0f / 1024.0f) + EPS); }
        asm volatile("s_waitcnt lgkmcnt(0)" ::: "memory"); __builtin_amdgcn_s_barrier(); asm volatile("" ::: "memory");
        f32x4 gv[2][2];
#pragma unroll
        for (int bj = 0; bj < 2; ++bj) { gv[bj][0] = *(const f32x4*)(gfin + col0 + bj * 128); gv[bj][1] = *(const f32x4*)(gfin + col0 + bj * 128 + 4); }
#pragma unroll
        for (int ai = 0; ai < 2; ++ai)
#pragma unroll
            for (int m = 0; m < 4; ++m) { const int rl = ai * 128 + wr * 64 + m * 16 + fr; const float rstd = St[rl]; const size_t row = (size_t)u.pm * 256 + rl;
#pragma unroll
                for (int bj = 0; bj < 2; ++bj) { float* p = outp + row * 1024 + col0 + bj * 128;
                    *(f32x4*)p = acc[ai][bj][m][0] * rstd * gv[bj][0]; *(f32x4*)(p + 4) = acc[ai][bj][m][1] * rstd * gv[bj][1]; } }
    }
};

__device__ __forceinline__ float wave_sum(float v) {
#pragma unroll
    for (int o = 1; o < 64; o <<= 1) v += __shfl_xor(v, o);
    return v;
}
__device__ __forceinline__ void transpose_item(const float* W, int ldw, int col0, int k0, bf16_t* WT, int K, int row_dst0, const float* kscale, LAS float* scr, int lane) {
    f32x4 v[8];
#pragma unroll
    for (int i = 0; i < 8; ++i) { const int kk = 8 * i + (lane >> 3); v[i] = *(const f32x4*)(W + (size_t)(k0 + kk) * ldw + col0 + (lane & 7) * 4); }
#pragma unroll
    for (int i = 0; i < 8; ++i) { const int kk = 8 * i + (lane >> 3); f32x4 t = v[i]; if (kscale) t = t * kscale[k0 + kk];
        LAS float* d = scr + kk * 33 + (lane & 7) * 4; d[0] = t[0]; d[1] = t[1]; d[2] = t[2]; d[3] = t[3]; }
    LDS_WAIT(); asm volatile("" ::: "memory");
    const int c = lane & 7;
#pragma unroll
    for (int j = 0; j < 4; ++j) { const int n = (lane >> 3) + 8 * j; const LAS float* s = scr + (8 * c) * 33 + n;
        u32x4 o; o.x = cvt_pk_bf16(s[0 * 33], s[1 * 33]); o.y = cvt_pk_bf16(s[2 * 33], s[3 * 33]); o.z = cvt_pk_bf16(s[4 * 33], s[5 * 33]); o.w = cvt_pk_bf16(s[6 * 33], s[7 * 33]);
        *(u32x4*)(WT + (size_t)(row_dst0 + n) * K + k0 + 8 * c) = o; }
    LDS_WAIT(); asm volatile("" ::: "memory");
}
constexpr int WI_IN = 16 * 224, WI_MKV = 16 * 32, WI_BR = 8 * 32, WI_OUT = 16 * 32, WI_UP = 16 * 176, WI_DN = 44 * 32;
constexpr int WI_EARLY = WI_IN + WI_MKV, WI_ALL = WI_IN + WI_MKV + 3 * WI_BR + WI_OUT + WI_UP + WI_DN;
__device__ __forceinline__ void weight_items(LAS unsigned char* lds, const Params& P, int it_begin, int it_end, int gw, int NGW, int wave, int lane) {
    unsigned char* ws = P.ws; unsigned char* dob = (unsigned char*)P.out;
    LAS float* scr = (LAS float*)(lds + wave * 8448);
    constexpr int I_IN = WI_IN, I_MKV = WI_MKV, I_BR = WI_BR, I_OUT = WI_OUT, I_UP = WI_UP;
    for (int it = it_begin + gw; it < it_end; it += NGW) {
        int r = it;
        if (r < I_IN) { const int kb = r / 224, nb = r % 224, n0 = 32 * nb; transpose_item(P.in[3], INW, n0 + (n0 >= 2048 ? 16 : 0), 64 * kb, (bf16_t*)(dob + DO_WINT), 1024, n0, nullptr, scr, lane); continue; } r -= I_IN;
        if (r < I_MKV) { const int kb = r / 32, nb = r % 32; transpose_item(P.in[11], 1024, 32 * nb, 64 * kb, (bf16_t*)(dob + DO_WMEMKVT), 1024, 32 * nb, nullptr, scr, lane); continue; } r -= I_MKV;
        if (r < 3 * I_BR) { const int br = r / I_BR; r -= br * I_BR; const int kb = r / 32, nb = r % 32; transpose_item(P.in[13 + br], 1024, 32 * nb, 64 * kb, (bf16_t*)(ws + WS_WBR + br * MiB), 512, 32 * nb, nullptr, scr, lane); continue; } r -= 3 * I_BR;
        if (r < I_OUT) { const int kb = r / 32, nb = r % 32; transpose_item(P.in[16], 1024, 32 * nb, 64 * kb, (bf16_t*)(ws + WS_WOUT), 1024, 32 * nb, nullptr, scr, lane); continue; } r -= I_OUT;
        if (r < I_UP) { const int kb = r / 176, nb = r % 176; transpose_item(P.in[18], 5632, 32 * nb, 64 * kb, (bf16_t*)(ws + WS_WUP), 1024, 32 * nb, P.in[17], scr, lane); continue; } r -= I_UP;
        { const int kb = r / 32, nb = r % 32; transpose_item(P.in[21], 1024, 32 * nb, 64 * kb, (bf16_t*)(ws + WS_WDOWN), 2816, 32 * nb, nullptr, scr, lane); }
    }
}
__device__ __forceinline__ void p0_prologue(LAS unsigned char* lds, const Params& P, int G) {
    int tid_ = threadIdx.x; asm volatile("" : "+v"(tid_)); const int tid = tid_, lane = tid & 63, wave = tid >> 6;
    const int gw = blockIdx.x * 8 + wave, NGW = G * 8;
    unsigned char* ws = P.ws; unsigned char* dob = (unsigned char*)P.out;
    LAS float* scr = (LAS float*)(lds + wave * 8448);
    LAS float* tab = (LAS float*)(lds + 8 * 8448);
    { const float* win = P.in[3];
      for (int k = tid; k < 1024; k += 512) {
          const f32x4* src = (const f32x4*)(win + (size_t)k * INW + 2048);
#pragma unroll
          for (int q = 0; q < 4; ++q) { const f32x4 v = src[q]; tab[(4 * q + 0) * 1024 + k] = v[0]; tab[(4 * q + 1) * 1024 + k] = v[1]; tab[(4 * q + 2) * 1024 + k] = v[2]; tab[(4 * q + 3) * 1024 + k] = v[3]; } } }
    { float* rss = (float*)(ws + WS_RSS1); for (int i = blockIdx.x * 512 + tid; i < NTOK; i += G * 512) rss[i] = 0.f; }
    weight_items(lds, P, 0, G >= 128 ? WI_EARLY : WI_ALL, gw, NGW, wave, lane);
    __syncthreads();
    {
        const int NR = NTOK + NMEM;
        f32x4 gx[4], gm[4];
#pragma unroll
        for (int j = 0; j < 4; ++j) { gx[j] = ((const f32x4*)P.in[2])[64 * j + lane]; gm[j] = ((const f32x4*)P.in[10])[64 * j + lane]; }
        for (int m0 = gw; m0 < NR; m0 += 2 * NGW) {
            const int m1 = m0 + NGW; const bool has1 = m1 < NR;
            f32x4 va[4], vb[4];
            { const float* xr = m0 < NTOK ? P.in[0] + (size_t)m0 * 1024 : P.in[1] + (size_t)(m0 - NTOK) * 1024;
#pragma unroll
              for (int j = 0; j < 4; ++j) va[j] = ((const f32x4*)xr)[64 * j + lane]; }
            { const int mm = has1 ? m1 : m0; const float* xr = mm < NTOK ? P.in[0] + (size_t)mm * 1024 : P.in[1] + (size_t)(mm - NTOK) * 1024;
#pragma unroll
              for (int j = 0; j < 4; ++j) vb[j] = ((const f32x4*)xr)[64 * j + lane]; }
#pragma unroll
            for (int rr = 0; rr < 2; ++rr) {
                if (rr == 1 && !has1) break;
                const int m = rr ? m1 : m0; const bool is_x = m < NTOK;
                f32x4 v[4];
#pragma unroll
                for (int j = 0; j < 4; ++j) v[j] = rr ? vb[j] : va[j];
                bf16_t* orow = is_x ? (bf16_t*)(dob + DO_H) + (size_t)m * 1024 : (bf16_t*)(dob + DO_MEMN) + (size_t)(m - NTOK) * 1024;
                float s = 0.f;
#pragma unroll
                for (int j = 0; j < 4; ++j) s += (v[j][0] * v[j][0] + v[j][1] * v[j][1]) + (v[j][2] * v[j][2] + v[j][3] * v[j][3]);
                const float rstd = rsqrtf(wave_sum(s) * (1.0f / 1024.0f) + EPS);
#pragma unroll
                for (int j = 0; j < 4; ++j) { v[j] = v[j] * rstd * (is_x ? gx[j] : gm[j]);
                    u32x2 w; w.x = cvt_pk_bf16(v[j][0], v[j][1]); w.y = cvt_pk_bf16(v[j][2], v[j][3]); ((u32x2*)orow)[64 * j + lane] = w; }
                if (is_x) {
                    float a[16];
#pragma unroll
                    for (int gi = 0; gi < 16; ++gi) { float acc = 0.f;
#pragma unroll
                        for (int j = 0; j < 4; ++j) { const f32x4 t = *(const LAS f32x4*)(tab + gi * 1024 + 256 * j + 4 * lane); acc += (v[j][0] * t[0] + v[j][1] * t[1]) + (v[j][2] * t[2] + v[j][3] * t[3]); }
                        a[gi] = acc; }
                    const bool u32_ = (lane & 32) != 0, u16_ = (lane & 16) != 0, u8_ = (lane & 8) != 0, u4_ = (lane & 4) != 0;
                    float b8[8], c4[4], d2[2];
#pragma unroll
                    for (int i = 0; i < 8; ++i) { const float mine = u32_ ? a[i + 8] : a[i], oth = u32_ ? a[i] : a[i + 8]; b8[i] = mine + __shfl_xor(oth, 32); }
#pragma unroll
                    for (int i = 0; i < 4; ++i) { const float mine = u16_ ? b8[i + 4] : b8[i], oth = u16_ ? b8[i] : b8[i + 4]; c4[i] = mine + __shfl_xor(oth, 16); }
#pragma unroll
                    for (int i = 0; i < 2; ++i) { const float mine = u8_ ? c4[i + 2] : c4[i], oth = u8_ ? c4[i] : c4[i + 2]; d2[i] = mine + __shfl_xor(oth, 8); }
                    float e = (u4_ ? d2[1] : d2[0]) + __shfl_xor(u4_ ? d2[0] : d2[1], 4);
                    e += __shfl_xor(e, 2); e += __shfl_xor(e, 1);
                    if ((lane & 3) == 0) ((float*)(ws + WS_GATES))[(size_t)m * 16 + (lane >> 2)] = e;
                }
            }
        }
    }
}

__device__ __forceinline__ void xa_unit(LAS unsigned char* lds, unsigned char* ws, int unit) {
    const int b = unit >> 5, h = (unit >> 3) & 3, qb = unit & 7;
    int tid_ = threadIdx.x; asm volatile("" : "+v"(tid_)); const int tid = tid_, lane = tid & 63, wid = tid >> 6, r32 = lane & 31, hi = lane >> 5;
    const bf16_t* Kg = (const bf16_t*)(ws + WS_MEMK) + (size_t)(b * 256) * 512 + h * 128;
    const bf16_t* Vg = (const bf16_t*)(ws + WS_MEMVT) + (size_t)(b * 512 + h * 128) * 256;
#ifdef XA_TEST_OUT
    bf16_t* XA_OUT = (bf16_t*)(ws + WS_MLO);
#else
    bf16_t* XA_OUT = (bf16_t*)(ws + WS_XAQ);
#endif
    bf16_t* Q = (bf16_t*)(ws + WS_XAQ);
#pragma unroll
    for (int i = 0; i < 8; ++i) { const int idx = tid + 512 * i; const int row = idx >> 4, ch = idx & 15;
        const u32x4 v = *(const u32x4*)(Kg + (size_t)row * 512 + ch * 8); *(LAS u32x4*)(lds + row * XA_K_PITCH + ch * 16) = v; }
#pragma unroll
    for (int i = 0; i < 8; ++i) { const int idx = tid + 512 * i; const int d = idx >> 5, ch = idx & 31;
        const u32x4 v = *(const u32x4*)(Vg + (size_t)d * 256 + ch * 8); *(LAS u32x4*)(lds + XA_VT_OFF + d * XA_VT_PITCH + ch * 16) = v; }
    const size_t qrow = (size_t)b * 2048 + qb * 256 + wid * 32 + r32;
    bf16x8 qf[8];
#pragma unroll
    for (int s = 0; s < 8; ++s) qf[s] = *(const bf16x8*)(Q + qrow * 512 + h * 128 + 16 * s + 8 * hi);
    __syncthreads();
    const float sc = 0.08838834764831845f * LOG2E;
    f32x16 o[4];
#pragma unroll
    for (int d = 0; d < 4; ++d)
#pragma unroll
        for (int r = 0; r < 16; ++r) o[d][r] = 0.f;
    float mrun = -INFINITY, lsum = 0.f;
    for (int kt = 0; kt < 4; ++kt) {
        f32x16 p[2];
#pragma unroll
        for (int blk = 0; blk < 2; ++blk) {
#pragma unroll
            for (int r = 0; r < 16; ++r) p[blk][r] = 0.f;
            const LAS unsigned char* kp = lds + (64 * kt + 32 * blk + r32) * XA_K_PITCH + hi * 16;
#pragma unroll
            for (int s = 0; s < 8; ++s) { const bf16x8 kf = *(const LAS bf16x8*)(kp + s * 32); p[blk] = __builtin_amdgcn_mfma_f32_32x32x16_bf16(kf, qf[s], p[blk], 0, 0, 0); }
        }
        float tmax = p[0][0];
#pragma unroll
        for (int r = 0; r < 16; ++r) { tmax = fmaxf(tmax, p[0][r]); tmax = fmaxf(tmax, p[1][r]); }
        tmax = fmaxf(tmax, __shfl_xor(tmax, 32));
        const float mnew = fmaxf(mrun, tmax * sc);
        const float alpha = fast_exp2(mrun - mnew);
        mrun = mnew;
        float ps = 0.f;
#pragma unroll
        for (int blk = 0; blk < 2; ++blk)
#pragma unroll
            for (int r = 0; r < 16; ++r) { const float e = fast_exp2(p[blk][r] * sc - mnew); p[blk][r] = e; ps += e; }
        lsum = lsum * alpha + ps;
#pragma unroll
        for (int d = 0; d < 4; ++d)
#pragma unroll
            for (int r = 0; r < 16; ++r) o[d][r] *= alpha;
#pragma unroll
        for (int blk = 0; blk < 2; ++blk)
#pragma unroll
            for (int st = 0; st < 2; ++st) {
                union { bf16x8 v; unsigned u[4]; } pb;
#pragma unroll
                for (int q = 0; q < 4; ++q) pb.u[q] = cvt_pk_bf16(p[blk][8 * st + 2 * q], p[blk][8 * st + 2 * q + 1]);
                const int kbase = 64 * kt + 32 * blk + 16 * st;
#pragma unroll
                for (int d = 0; d < 4; ++d) {
                    const LAS unsigned char* vp = lds + XA_VT_OFF + (32 * d + r32) * XA_VT_PITCH + (kbase + 4 * hi) * 2;
                    union { bf16x8 v; s16x4 h[2]; } va; va.h[0] = *(const LAS s16x4*)vp; va.h[1] = *(const LAS s16x4*)(vp + 16);
                    o[d] = __builtin_amdgcn_mfma_f32_32x32x16_bf16(va.v, pb.v, o[d], 0, 0, 0);
                }
            }
    }
    lsum += __shfl_xor(lsum, 32);
    const float inv = 1.0f / lsum;
#ifdef XA_COPY
    {
#pragma unroll
    for (int d = 0; d < 4; ++d)
#pragma unroll
        for (int g = 0; g < 4; ++g) { u32x2 w;
            if (XA_COPY == 1) { union { bf16x8 v; unsigned u[4]; } t; t.v = qf[(d * 4 + g) >> 1]; w.x = t.u[((d * 4 + g) & 1) * 2]; w.y = t.u[((d * 4 + g) & 1) * 2 + 1]; }
            else if (XA_COPY == 2) { w = *(const LAS u32x2*)(lds + (wid * 32 + r32) * XA_K_PITCH + hi * 128 + (d * 4 + g) * 8); }
            else { const int L = wid * 64 + lane; w = *(const LAS u32x2*)(lds + XA_VT_OFF + (L >> 2) * XA_VT_PITCH + (L & 3) * 128 + (d * 4 + g) * 8); }
            *(u32x2*)(XA_OUT + qrow * 512 + h * 128 + 32 * d + 8 * g + 4 * hi) = w; }
    __syncthreads(); return;
    }
#endif
#pragma unroll
    for (int d = 0; d < 4; ++d)
#pragma unroll
        for (int g = 0; g < 4; ++g) { u32x2 w; w.x = cvt_pk_bf16(o[d][4 * g] * inv, o[d][4 * g + 1] * inv); w.y = cvt_pk_bf16(o[d][4 * g + 2] * inv, o[d][4 * g + 3] * inv);
            *(u32x2*)(XA_OUT + qrow * 512 + h * 128 + 32 * d + 8 * g + 4 * hi) = w; }
    __syncthreads();
}

#define LDS_BARRIER() asm volatile("s_waitcnt lgkmcnt(0)\n\ts_barrier" ::: "memory")
constexpr int NA_VT_OFF = 576 * 128, NA_VT_PITCH = 1168, NA2_RPB_OFF = NA_VT_OFF + 64 * NA_VT_PITCH;
__device__ __forceinline__ void na_unit(LAS unsigned char* lds, unsigned char* ws, const float* rpb_g, int unit) {
    const int b = unit >> 7, h = (unit >> 4) & 7, rp = unit & 15;
    int tid_ = threadIdx.x; asm volatile("" : "+v"(tid_)); const int tid = tid_, lane = tid & 63, wid = tid >> 6, l15 = lane & 15, quad = lane >> 4;
    bf16_t* Q = (bf16_t*)(ws + WS_NAQ); const bf16_t* K = (const bf16_t*)(ws + WS_NAK); const bf16_t* VT = (const bf16_t*)(ws + WS_NAVT);
    const int r0 = 2 * rp, rsA = min(max(r0 - 4, 0), 24);
    const int r = r0 + (wid >> 2), j = wid & 3;
    const int c = 16 * j + l15, kc0 = min(max(16 * j - 8, 0), 32), cs = min(max(c - 8, 0), 48);
    const int rs = min(max(r - 4, 0), 24), dr = rs - rsA;
    const size_t qrow = (size_t)b * 2048 + r * 64 + c;
    bf16x8 qf[2];
    qf[0] = *(const bf16x8*)(Q + qrow * 512 + h * 64 + 8 * quad); qf[1] = *(const bf16x8*)(Q + qrow * 512 + h * 64 + 32 + 8 * quad);
#pragma unroll
    for (int i = 0; i < 9; ++i) { const int p = tid + 512 * i; const int tl = p >> 3, ch = p & 7; const int row = min(rsA + (tl >> 6), 31);
        const u32x4 v = *(const u32x4*)(K + ((size_t)b * 2048 + row * 64 + (tl & 63)) * 512 + h * 64 + ch * 8);
        *(LAS u32x4*)(lds + tl * 128 + ((ch ^ (tl & 7)) << 4)) = v; }
#pragma unroll
    for (int i = 0; i < 9; ++i) { const int p = tid + 512 * i; const int d = p / 72, ch = p - d * 72;
        const u32x4 v = *(const u32x4*)(VT + ((size_t)(b * 512 + h * 64 + d)) * 2048 + rsA * 64 + ch * 8);
        *(LAS u32x4*)(lds + NA_VT_OFF + d * NA_VT_PITCH + ch * 16) = v; }
    if (tid < 465) ((LAS float*)(lds + NA2_RPB_OFF))[tid] = rpb_g[h * 465 + tid];
    LDS_BARRIER();
    const LAS float* rpb = (const LAS float*)(lds + NA2_RPB_OFF);
    f32x4 s[8][2];
#pragma unroll
    for (int kr = 0; kr < 8; ++kr)
#pragma unroll
        for (int hf = 0; hf < 2; ++hf) {
            const int tl = (dr + kr) * 64 + kc0 + 16 * hf + l15;
            const bf16x8 k0 = *(const LAS bf16x8*)(lds + tl * 128 + ((quad ^ (tl & 7)) << 4)), k1 = *(const LAS bf16x8*)(lds + tl * 128 + (((4 + quad) ^ (tl & 7)) << 4));
            f32x4 a = {0.f, 0.f, 0.f, 0.f};
            a = __builtin_amdgcn_mfma_f32_16x16x32_bf16(k0, qf[0], a, 0, 0, 0);
            a = __builtin_amdgcn_mfma_f32_16x16x32_bf16(k1, qf[1], a, 0, 0, 0);
            s[kr][hf] = a;
        }
    float mx = -INFINITY;
#pragma unroll
    for (int kr = 0; kr < 8; ++kr)
#pragma unroll
        for (int hf = 0; hf < 2; ++hf)
#pragma unroll
            for (int i = 0; i < 4; ++i) { const int kc = kc0 + 16 * hf + 4 * quad + i; const bool valid = (kc >= cs) && (kc < cs + 16);
                const int bidx = valid ? ((rs + kr - r + 7) * 31 + (kc - c + 15)) : 0;
                const float t = valid ? (s[kr][hf][i] * 0.125f + rpb[bidx]) * LOG2E : -INFINITY;
                s[kr][hf][i] = t; mx = fmaxf(mx, t); }
    mx = fmaxf(mx, __shfl_xor(mx, 16)); mx = fmaxf(mx, __shfl_xor(mx, 32));
    float sum = 0.f;
#pragma unroll
    for (int kr = 0; kr < 8; ++kr)
#pragma unroll
        for (int hf = 0; hf < 2; ++hf)
#pragma unroll
            for (int i = 0; i < 4; ++i) { const float e = fast_exp2(s[kr][hf][i] - mx); s[kr][hf][i] = e; sum += e; }
    sum += __shfl_xor(sum, 16); sum += __shfl_xor(sum, 32);
    const float inv = 1.0f / sum;
    f32x4 o[4];
#pragma unroll
    for (int db = 0; db < 4; ++db) o[db] = (f32x4){0.f, 0.f, 0.f, 0.f};
#pragma unroll
    for (int kr = 0; kr < 8; ++kr) {
        union { bf16x8 v; unsigned u[4]; } pb;
        pb.u[0] = cvt_pk_bf16(s[kr][0][0], s[kr][0][1]); pb.u[1] = cvt_pk_bf16(s[kr][0][2], s[kr][0][3]);
        pb.u[2] = cvt_pk_bf16(s[kr][1][0], s[kr][1][1]); pb.u[3] = cvt_pk_bf16(s[kr][1][2], s[kr][1][3]);
#pragma unroll
        for (int db = 0; db < 4; ++db) {
            const LAS unsigned char* vp = lds + NA_VT_OFF + (16 * db + l15) * NA_VT_PITCH + ((dr + kr) * 64 + kc0 + 4 * quad) * 2;
            union { bf16x8 v; s16x4 hh[2]; } va; va.hh[0] = *(const LAS s16x4*)vp; va.hh[1] = *(const LAS s16x4*)(vp + 32);
            o[db] = __builtin_amdgcn_mfma_f32_16x16x32_bf16(va.v, pb.v, o[db], 0, 0, 0);
        }
    }
#pragma unroll
    for (int db = 0; db < 4; ++db) { u32x2 w; w.x = cvt_pk_bf16(o[db][0] * inv, o[db][1] * inv); w.y = cvt_pk_bf16(o[db][2] * inv, o[db][3] * inv);
        *(u32x2*)(Q + qrow * 512 + h * 64 + 16 * db + 4 * quad) = w; }
    LDS_BARRIER();
}

__device__ __forceinline__ unsigned pack2(float a, float b) { return cvt_pk_bf16(a, b); }
__device__ __forceinline__ int tsw(int row, int pos) { return row * ML_TP + ((((pos >> 3) ^ (row >> 3)) & 7) << 4) + ((pos & 7) << 1); }
#ifndef TIME_PHASE
#define TIME_PHASE -1
#endif
template <int CTRL, int RM, int BMK> __device__ __forceinline__ float dppf(float old, float src) { return __int_as_float(__builtin_amdgcn_update_dpp(__float_as_int(old), __float_as_int(src), CTRL, RM, BMK, false)); }
__device__ __forceinline__ float wave_scan_add(float v) {
    v += dppf<0x111, 0xf, 0xf>(0.f, v); v += dppf<0x112, 0xf, 0xf>(0.f, v); v += dppf<0x114, 0xf, 0xf>(0.f, v); v += dppf<0x118, 0xf, 0xf>(0.f, v);
    v += dppf<0x142, 0xa, 0xf>(0.f, v); v += dppf<0x143, 0xc, 0xf>(0.f, v); return v; }
__device__ __forceinline__ float wave_scan_max(float v) {
    v = fmaxf(v, dppf<0x111, 0xf, 0xf>(-INFINITY, v)); v = fmaxf(v, dppf<0x112, 0xf, 0xf>(-INFINITY, v)); v = fmaxf(v, dppf<0x114, 0xf, 0xf>(-INFINITY, v)); v = fmaxf(v, dppf<0x118, 0xf, 0xf>(-INFINITY, v));
    v = fmaxf(v, dppf<0x142, 0xa, 0xf>(-INFINITY, v)); v = fmaxf(v, dppf<0x143, 0xc, 0xf>(-INFINITY, v)); return v; }
__device__ __forceinline__ float lane63(float v) { return __int_as_float(__builtin_amdgcn_readlane(__float_as_int(v), 63)); }
#define MLT(k) if (TIME_PHASE == 20 + (k)) { const unsigned long long n_ = __builtin_amdgcn_s_memrealtime(); tacc += n_ - tlast; tlast = n_; } else if (TIME_PHASE >= 20 && TIME_PHASE < 24) { tlast = __builtin_amdgcn_s_memrealtime(); }
__device__ __forceinline__ unsigned long long ml_chain(LAS unsigned char* lds, const Params& P, int chain) {
    unsigned long long tacc = 0, tlast = 0;
    const int b = chain >> 3, h = (chain >> 1) & 3, dir = chain & 1;
    int tid_ = threadIdx.x; asm volatile("" : "+v"(tid_)); const int tid = tid_, lane = tid & 63, w = __builtin_amdgcn_readfirstlane(tid >> 6), l15 = lane & 15, quad = lane >> 4;
    unsigned char* ws = P.ws;
    const bf16_t* MLV = (const bf16_t*)(ws + WS_MLV);
    const float* GATES = (const float*)(ws + WS_GATES);
    bf16_t* HDIR = (bf16_t*)((unsigned char*)P.out + (dir ? DO_HBW : DO_HFW));
    LAS float* NV = (LAS float*)(lds + ML_NV); LAS float* NVP = (LAS float*)(lds + ML_CW); LAS float* ROWSUM = (LAS float*)(lds + ML_ROWSUM);
    LAS float* DENI = (LAS float*)(lds + ML_DENI); LAS float* WTS = (LAS float*)(lds + ML_WTS);
    if (tid < 256) NV[tid] = 0.f;
    f32x4 C[8];
#pragma unroll
    for (int e = 0; e < 8; ++e) C[e] = (f32x4){0.f, 0.f, 0.f, 0.f};
    float m_run = -1e30f;
    const float big = P.in[4][dir * 4 + h], bfg = P.in[5][dir * 4 + h];
    const int cgp = tid & 31, rg = tid >> 5; const bool isk = cgp >= 16; const int c8 = (cgp & 15) * 8;
    const bf16_t* qksrc = (const bf16_t*)((const unsigned char*)P.out + (isk ? DO_KC : DO_QC)) + h * 128 + c8;
    const int vcg = tid & 15, vrg = tid >> 4;
    const size_t brow = (size_t)b * 2048;
    struct MLPF { u32x4 raw[4]; u32x4 vraw[2]; float gi, gf; };
    MLPF pfA;
#define ML_ISSUE(pf, cc) do { const int tb_ = dir ? 2048 - 64 * ((cc) + 1) : 64 * (cc); \
        _Pragma("unroll") for (int i_ = 0; i_ < 4; ++i_) { const int t_ = tb_ + 4 * rg + i_; (pf).raw[i_] = *(const u32x4*)(qksrc + (brow + t_) * 512); } \
        _Pragma("unroll") for (int i_ = 0; i_ < 2; ++i_) { const int t_ = tb_ + 2 * vrg + i_; (pf).vraw[i_] = *(const u32x4*)(MLV + (brow + t_) * 512 + h * 128 + vcg * 8); } \
        { const int t_ = dir ? tb_ + 63 - lane : tb_ + lane; (pf).gi = GATES[(brow + t_) * 16 + (dir * 2) * 4 + h]; (pf).gf = GATES[(brow + t_) * 16 + (dir * 2 + 1) * 4 + h]; } } while (0)
    ML_ISSUE(pfA, 0);
    __syncthreads();
    {
      for (int c = 0; c < 32; ++c) {
        MLPF& pf = pfA;
        u32x4 raw[4], vraw[2];
#pragma unroll
        for (int i_ = 0; i_ < 4; ++i_) raw[i_] = pf.raw[i_];
        vraw[0] = pf.vraw[0]; vraw[1] = pf.vraw[1];
        const float gi_raw = pf.gi, gf_raw = pf.gf;
        const int tb = dir ? 2048 - 64 * (c + 1) : 64 * c; const int par = c & 1;
        MLT(3)
        const float gi = gi_raw + big, gf = gf_raw + bfg;
        const float lf = fminf(gf, 0.f) - __logf(1.0f + fast_exp(-fabsf(gf)));
        const float a = wave_scan_add(lf);
        const float g = lane63(a);
        const float u = gi - a; const float pm = wave_scan_max(u);
        const float mj = a + fmaxf(m_run, pm);
        const float inter_w = fast_exp(a + m_run - mj);
        const float pm63 = lane63(pm); const float m_new = fmaxf(g + m_run, g + pm63);
        const float decay = fast_exp(g + m_run - m_new);
        const float wt = fast_exp(g + u - m_new);
        const float emj = fast_exp(-mj);
        MLT(0)
        if (w == 0) { WTS[lane] = wt; }
        {
            LAS unsigned char* rm = lds + (isk ? ML_KS : ML_QS);
#pragma unroll
            for (int i = 0; i < 4; ++i) { const int p = dir ? 63 - (4 * rg + i) : 4 * rg + i; *(LAS u32x4*)(rm + p * ML_QP + c8 * 2) = raw[i]; }
            if (isk) {
#pragma unroll
                for (int cp = 0; cp < 4; ++cp) {
                    const unsigned t0 = cp == 0 ? raw[0].x : cp == 1 ? raw[0].y : cp == 2 ? raw[0].z : raw[0].w, t1 = cp == 0 ? raw[1].x : cp == 1 ? raw[1].y : cp == 2 ? raw[1].z : raw[1].w;
                    const unsigned t2 = cp == 0 ? raw[2].x : cp == 1 ? raw[2].y : cp == 2 ? raw[2].z : raw[2].w, t3 = cp == 0 ? raw[3].x : cp == 1 ? raw[3].y : cp == 2 ? raw[3].z : raw[3].w;
                    u32x2 lo, hi;
                    if (dir) { lo.x = (t3 & 0xffffu) | (t2 << 16); lo.y = (t1 & 0xffffu) | (t0 << 16); hi.x = (t3 >> 16) | (t2 & 0xffff0000u); hi.y = (t1 >> 16) | (t0 & 0xffff0000u); }
                    else { lo.x = (t0 & 0xffffu) | (t1 << 16); lo.y = (t2 & 0xffffu) | (t3 << 16); hi.x = (t0 >> 16) | (t1 & 0xffff0000u); hi.y = (t2 >> 16) | (t3 & 0xffff0000u); }
                    const int ppos = dir ? 60 - 4 * rg : 4 * rg;
                    *(LAS u32x2*)(lds + ML_KT + tsw(c8 + 2 * cp, ppos)) = lo; *(LAS u32x2*)(lds + ML_KT + tsw(c8 + 2 * cp + 1, ppos)) = hi; }
            }
        }
        {
            const int p0 = dir ? 63 - 2 * vrg : 2 * vrg, p1 = dir ? 62 - 2 * vrg : 2 * vrg + 1;
            const float wt0 = __shfl(wt, p0), wt1 = __shfl(wt, p1);
            float v0[8], v1[8];
            v0[0] = bf_lo(vraw[0].x); v0[1] = bf_hi(vraw[0].x); v0[2] = bf_lo(vraw[0].y); v0[3] = bf_hi(vraw[0].y); v0[4] = bf_lo(vraw[0].z); v0[5] = bf_hi(vraw[0].z); v0[6] = bf_lo(vraw[0].w); v0[7] = bf_hi(vraw[0].w);
            v1[0] = bf_lo(vraw[1].x); v1[1] = bf_hi(vraw[1].x); v1[2] = bf_lo(vraw[1].y); v1[3] = bf_hi(vraw[1].y); v1[4] = bf_lo(vraw[1].z); v1[5] = bf_hi(vraw[1].z); v1[6] = bf_lo(vraw[1].w); v1[7] = bf_hi(vraw[1].w);
            const int pw = dir ? p1 : p0;
#pragma unroll
            for (int ch = 0; ch < 8; ++ch) { const int d = vcg * 8 + ch;
                const unsigned a_ = dir ? pack2(v1[ch], v0[ch]) : pack2(v0[ch], v1[ch]);
                const unsigned b_ = dir ? pack2(v1[ch] * wt1, v0[ch] * wt0) : pack2(v0[ch] * wt0, v1[ch] * wt1);
                *(LAS unsigned*)(lds + ML_VT + tsw(d, pw)) = a_; *(LAS unsigned*)(lds + ML_WVT + tsw(d, pw)) = b_; }
        }
        if (c + 1 < 32) ML_ISSUE(pf, c + 1);
        LDS_BARRIER();
        MLT(1)
#pragma unroll
        for (int bb2 = 0; bb2 < 2; ++bb2) {
            const int id = 2 * w + bb2, jb = id >> 2, sb = id & 3; const int j = 16 * jb + l15;
            if (sb <= jb) {
                f32x4 sacc = {0.f, 0.f, 0.f, 0.f};
#pragma unroll
                for (int st = 0; st < 4; ++st) { const bf16x8 kf = *(const LAS bf16x8*)(lds + ML_KS + (16 * sb + l15) * ML_QP + (32 * st + 8 * quad) * 2);
                    const bf16x8 qf = *(const LAS bf16x8*)(lds + ML_QS + j * ML_QP + (32 * st + 8 * quad) * 2);
                    sacc = __builtin_amdgcn_mfma_f32_16x16x32_bf16(kf, qf, sacc, 0, 0, 0); }
                const float aj = __shfl(a, j), mjj = __shfl(mj, j);
                float pv[4]; float rsum = 0.f;
#pragma unroll
                for (int i = 0; i < 4; ++i) { const int sidx = 16 * sb + 4 * quad + i; const float us = __shfl(u, sidx);
                    const float e = fast_exp(fminf(aj + us - mjj, 0.f)) * sacc[i]; pv[i] = (sidx <= j) ? e : 0.f; rsum += pv[i]; }
                rsum += __shfl_xor(rsum, 16); rsum += __shfl_xor(rsum, 32);
                if (quad == 0) ROWSUM[sb * 64 + j] = rsum;
                u32x2 wv; wv.x = pack2(pv[0], pv[1]); wv.y = pack2(pv[2], pv[3]);
                *(LAS u32x2*)(lds + ML_PS + j * ML_TP + (16 * sb + 4 * quad) * 2) = wv;
            } else {
                *(LAS u32x2*)(lds + ML_PS + j * ML_TP + (16 * sb + 4 * quad) * 2) = (u32x2){0u, 0u}; if (quad == 0) ROWSUM[sb * 64 + j] = 0.f;
            }
        }
        {
            const int j = tid >> 3, eo = (tid & 7) * 16;
            const u32x4 q0 = *(const LAS u32x4*)(lds + ML_QS + j * ML_QP + eo * 2), q1 = *(const LAS u32x4*)(lds + ML_QS + j * ML_QP + eo * 2 + 16);
            const LAS float* nv = NV + par * 128 + eo;
            const f32x4 n0 = *(const LAS f32x4*)(nv), n1 = *(const LAS f32x4*)(nv + 4), n2 = *(const LAS f32x4*)(nv + 8), n3 = *(const LAS f32x4*)(nv + 12);
            float s = bf_lo(q0.x) * n0[0] + bf_hi(q0.x) * n0[1] + bf_lo(q0.y) * n0[2] + bf_hi(q0.y) * n0[3] + bf_lo(q0.z) * n1[0] + bf_hi(q0.z) * n1[1] + bf_lo(q0.w) * n1[2] + bf_hi(q0.w) * n1[3]
                    + bf_lo(q1.x) * n2[0] + bf_hi(q1.x) * n2[1] + bf_lo(q1.y) * n2[2] + bf_hi(q1.y) * n2[3] + bf_lo(q1.z) * n3[0] + bf_hi(q1.z) * n3[1] + bf_lo(q1.w) * n3[2] + bf_hi(q1.w) * n3[3];
            s += __shfl_xor(s, 1); s += __shfl_xor(s, 2); s += __shfl_xor(s, 4);
            if ((tid & 7) == 0) DENI[j] = s;
        }
        f32x4 acc[4];
#pragma unroll
        for (int t4 = 0; t4 < 4; ++t4) acc[t4] = (f32x4){0.f, 0.f, 0.f, 0.f};
#pragma unroll
        for (int st = 0; st < 4; ++st) {
            union { bf16x8 v; unsigned uu[4]; } ca;
            ca.uu[0] = pack2(C[2 * st][0], C[2 * st][1]); ca.uu[1] = pack2(C[2 * st][2], C[2 * st][3]); ca.uu[2] = pack2(C[2 * st + 1][0], C[2 * st + 1][1]); ca.uu[3] = pack2(C[2 * st + 1][2], C[2 * st + 1][3]);
#pragma unroll
            for (int t4 = 0; t4 < 4; ++t4) { const LAS unsigned char* qp = lds + ML_QS + (16 * t4 + l15) * ML_QP + (32 * st + 4 * quad) * 2;
                union { bf16x8 v; s16x4 hh[2]; } qb; qb.hh[0] = *(const LAS s16x4*)qp; qb.hh[1] = *(const LAS s16x4*)(qp + 32);
                acc[t4] = __builtin_amdgcn_mfma_f32_16x16x32_bf16(ca.v, qb.v, acc[t4], 0, 0, 0); }
        }
        { const int e = tid & 127, qq = tid >> 7; float s = 0.f;
#pragma unroll
            for (int q = 0; q < 2; ++q) { const int pos = 16 * qq + 8 * q; const u32x4 kv = *(const LAS u32x4*)(lds + ML_KT + tsw(e, pos)); const f32x4 wa = *(const LAS f32x4*)(WTS + pos), wb = *(const LAS f32x4*)(WTS + pos + 4);
                s += bf_lo(kv.x) * wa[0] + bf_hi(kv.x) * wa[1] + bf_lo(kv.y) * wa[2] + bf_hi(kv.y) * wa[3] + bf_lo(kv.z) * wb[0] + bf_hi(kv.z) * wb[1] + bf_lo(kv.w) * wb[2] + bf_hi(kv.w) * wb[3]; }
            NVP[qq * 128 + e] = s; }
#pragma unroll
        for (int eb = 0; eb < 8; ++eb) { C[eb] = C[eb] * decay;
#pragma unroll
            for (int ks = 0; ks < 2; ++ks) { const bf16x8 ka = *(const LAS bf16x8*)(lds + ML_KT + tsw(16 * eb + l15, 32 * ks + 8 * quad));
                const bf16x8 vb = *(const LAS bf16x8*)(lds + ML_WVT + tsw(16 * w + l15, 32 * ks + 8 * quad));
                C[eb] = __builtin_amdgcn_mfma_f32_16x16x32_bf16(ka, vb, C[eb], 0, 0, 0); } }
        LDS_BARRIER();
        MLT(2)
        if (tid < 128) NV[(par ^ 1) * 128 + tid] = decay * NV[par * 128 + tid] + ((NVP[tid] + NVP[128 + tid]) + (NVP[256 + tid] + NVP[384 + tid]));
#pragma unroll
        for (int t4 = 0; t4 < 4; ++t4) { const int tp = 16 * t4 + l15; const float iw = __shfl(inter_w, tp); const float em = __shfl(emj, tp);
            f32x4 r = acc[t4] * iw;
#pragma unroll
            for (int ks = 0; ks < 2; ++ks) { const bf16x8 va = *(const LAS bf16x8*)(lds + ML_VT + tsw(16 * w + l15, 32 * ks + 8 * quad));
                const bf16x8 pb = *(const LAS bf16x8*)(lds + ML_PS + tp * ML_TP + (32 * ks + 8 * quad) * 2);
                r = __builtin_amdgcn_mfma_f32_16x16x32_bf16(va, pb, r, 0, 0, 0); }
            const float den = ((ROWSUM[tp] + ROWSUM[64 + tp]) + (ROWSUM[128 + tp] + ROWSUM[192 + tp])) + iw * DENI[tp]; const float inv = 1.0f / fmaxf(fabsf(den), em);
            const int t = dir ? tb + 63 - tp : tb + tp;
            { const f32x4 rr = r * inv; u32x2 ov; ov.x = pack2(rr[0], rr[1]); ov.y = pack2(rr[2], rr[3]); *(u32x2*)(HDIR + (brow + t) * 512 + h * 128 + 16 * w + 4 * quad) = ov; } }
        m_run = m_new;
        LDS_BARRIER();
      }
    }
#undef ML_ISSUE
    return tacc;
}

__device__ __forceinline__ void unpack8(const u32x4 v, float* f) { f[0] = bf_lo(v.x); f[1] = bf_hi(v.x); f[2] = bf_lo(v.y); f[3] = bf_hi(v.y); f[4] = bf_lo(v.z); f[5] = bf_hi(v.z); f[6] = bf_lo(v.w); f[7] = bf_hi(v.w); }
__device__ __forceinline__ void p2b_combine(const Params& P, int G) {
    int tid_ = threadIdx.x; asm volatile("" : "+v"(tid_)); const int tid = tid_, lane = tid & 63, wave = tid >> 6; const int gw = blockIdx.x * 8 + wave, NGW = G * 8;
    const bf16_t* HF = (const bf16_t*)((unsigned char*)P.out + DO_HFW); const bf16_t* HB = (const bf16_t*)((unsigned char*)P.out + DO_HBW);
    bf16_t* O = (bf16_t*)(P.ws + WS_MLO); const float* ng = P.in[8];
    float gg[8]; { const f32x4 g0 = *(const f32x4*)(ng + 8 * lane), g1 = *(const f32x4*)(ng + 8 * lane + 4); gg[0] = g0[0]; gg[1] = g0[1]; gg[2] = g0[2]; gg[3] = g0[3]; gg[4] = g1[0]; gg[5] = g1[1]; gg[6] = g1[2]; gg[7] = g1[3]; }
    for (int row = gw; row < NTOK; row += 2 * NGW) {
        const int row2 = row + NGW; const bool has2 = row2 < NTOK;
        const size_t off = (size_t)row * 512 + 8 * lane, off2 = (size_t)(has2 ? row2 : row) * 512 + 8 * lane;
        const u32x4 fa = *(const u32x4*)(HF + off), fb = *(const u32x4*)(HB + off), fo = *(const u32x4*)(O + off);
        const u32x4 fa2 = *(const u32x4*)(HF + off2), fb2 = *(const u32x4*)(HB + off2), fo2 = *(const u32x4*)(O + off2);
#pragma unroll
        for (int rr = 0; rr < 2; ++rr) {
            float a[8], bb[8], o[8]; unpack8(rr ? fa2 : fa, a); unpack8(rr ? fb2 : fb, bb); unpack8(rr ? fo2 : fo, o);
            float ss = 0.f;
#pragma unroll
            for (int i = 0; i < 8; ++i) { a[i] += bb[i]; ss += a[i] * a[i]; }
            ss += __shfl_xor(ss, 1); ss += __shfl_xor(ss, 2); ss += __shfl_xor(ss, 4); ss += __shfl_xor(ss, 8);
            const float rstd = rsqrtf(ss * (1.0f / 128.0f) + EPS);
#pragma unroll
            for (int i = 0; i < 8; ++i) a[i] = a[i] * rstd * gg[i] * sigmoidf_(o[i]);
            u32x4 wv; wv.x = pack2(a[0], a[1]); wv.y = pack2(a[2], a[3]); wv.z = pack2(a[4], a[5]); wv.w = pack2(a[6], a[7]);
            if (rr == 0 || has2) *(u32x4*)(O + (rr ? off2 : off)) = wv;
        }
    }
}
__device__ __forceinline__ void p1b_conv(const Params& P, int G) {
    const bf16_t* MQ = (const bf16_t*)(P.ws + WS_MLQ); const bf16_t* MK = (const bf16_t*)(P.ws + WS_MLK);
    bf16_t* QC = (bf16_t*)((unsigned char*)P.out + DO_QC); bf16_t* KC = (bf16_t*)((unsigned char*)P.out + DO_KC);
    const float* cw = P.in[6]; const float* cb = P.in[7];
    const int nb0 = G >= 64 ? 32 : 0; if ((int)blockIdx.x < nb0) return;
    const int nth = (G - nb0) * 512;
    for (int task = ((int)blockIdx.x - nb0) * 512 + threadIdx.x; task < 2048 * 128; task += nth) {
        const int rgid = task >> 7, cgid = task & 127; const int row0 = 8 * rgid, ch0 = 8 * cgid; const int sp0 = row0 & 2047;
        const bool isk = ch0 >= 512; const float qs = isk ? 1.0f : 0.08838834764831845f;
        float w0[8], w1[8], w2[8], bb[8];
#pragma unroll
        for (int q = 0; q < 2; ++q) { const f32x4 t0 = *(const f32x4*)(cw + ch0 + 4 * q), t1 = *(const f32x4*)(cw + 1024 + ch0 + 4 * q), t2 = *(const f32x4*)(cw + 2048 + ch0 + 4 * q), t3 = *(const f32x4*)(cb + ch0 + 4 * q);
#pragma unroll
            for (int i = 0; i < 4; ++i) { w0[4 * q + i] = t0[i]; w1[4 * q + i] = t1[i]; w2[4 * q + i] = t2[i]; bb[4 * q + i] = t3[i]; } }
        const bf16_t* ap = (isk ? MK + (ch0 - 512) : MQ + ch0) + (size_t)row0 * 512; bf16_t* op = (isk ? KC + (ch0 - 512) : QC + ch0) + (size_t)row0 * 512;
        u32x4 rw[10];
#pragma unroll
        for (int i = 0; i < 10; ++i) { const int sp = sp0 - 1 + i; rw[i] = (sp >= 0 && sp < 2048) ? *(const u32x4*)(ap + (ptrdiff_t)(i - 1) * 512) : (u32x4){0u, 0u, 0u, 0u}; }
        float prev[8], cur[8], nxt[8]; unpack8(rw[0], prev); unpack8(rw[1], cur);
#pragma unroll
        for (int i = 0; i < 8; ++i) {
            unpack8(rw[i + 2], nxt);
            float o[8];
#pragma unroll
            for (int q = 0; q < 8; ++q) { const float y = w0[q] * prev[q] + w1[q] * cur[q] + w2[q] * nxt[q] + bb[q]; o[q] = y * sigmoidf_(y) * qs; prev[q] = cur[q]; cur[q] = nxt[q]; }
            u32x4 wv; wv.x = pack2(o[0], o[1]); wv.y = pack2(o[2], o[3]); wv.z = pack2(o[4], o[5]); wv.w = pack2(o[6], o[7]);
            *(u32x4*)(op + (size_t)i * 512) = wv;
        }
    }
}
__device__ __forceinline__ void p5b_glu(const Params& P, int G) {
    const bf16_t* A = (const bf16_t*)(P.ws + WS_ABUF); bf16_t* U = (bf16_t*)(P.ws + WS_UBUF);
    const float* cw = P.in[19]; const float* cb = P.in[20];
    const int nth = G * 512;
    for (int task = blockIdx.x * 512 + threadIdx.x; task < 2048 * 352; task += nth) {
        const int rgid = task / 352, cgid = task - rgid * 352; const int row0 = 8 * rgid, ch0 = 8 * cgid; const int sp0 = row0 & 2047;
        float w0[8], w1[8], w2[8], bb[8];
#pragma unroll
        for (int q = 0; q < 2; ++q) { const f32x4 t0 = *(const f32x4*)(cw + ch0 + 4 * q), t1 = *(const f32x4*)(cw + 2816 + ch0 + 4 * q), t2 = *(const f32x4*)(cw + 5632 + ch0 + 4 * q), t3 = *(const f32x4*)(cb + ch0 + 4 * q);
#pragma unroll
            for (int i = 0; i < 4; ++i) { w0[4 * q + i] = t0[i]; w1[4 * q + i] = t1[i]; w2[4 * q + i] = t2[i]; bb[4 * q + i] = t3[i]; } }
        const bf16_t* ap = A + (size_t)row0 * 2816 + ch0; bf16_t* up = U + (size_t)row0 * 2816 + ch0;
        u32x4 ra[10], ru[8];
#pragma unroll
        for (int i = 0; i < 10; ++i) { const int sp = sp0 - 1 + i; ra[i] = (sp >= 0 && sp < 2048) ? *(const u32x4*)(ap + (ptrdiff_t)(i - 1) * 2816) : (u32x4){0u, 0u, 0u, 0u}; }
#pragma unroll
        for (int i = 0; i < 8; ++i) ru[i] = *(const u32x4*)(up + (size_t)i * 2816);
        float prev[8], cur[8], nxt[8]; unpack8(ra[0], prev); unpack8(ra[1], cur);
#pragma unroll
        for (int i = 0; i < 8; ++i) {
            unpack8(ra[i + 2], nxt);
            float uu[8]; unpack8(ru[i], uu);
            float o[8];
#pragma unroll
            for (int q = 0; q < 8; ++q) { const float y = w0[q] * prev[q] + w1[q] * cur[q] + w2[q] * nxt[q] + bb[q];
                const float z = 1.5957691216057308f * (y + 0.044715f * y * y * y);
                o[q] = y * sigmoidf_(z) * uu[q]; prev[q] = cur[q]; cur[q] = nxt[q]; }
            u32x4 wv; wv.x = pack2(o[0], o[1]); wv.y = pack2(o[2], o[3]); wv.z = pack2(o[4], o[5]); wv.w = pack2(o[6], o[7]);
            *(u32x4*)(up + (size_t)i * 2816) = wv;
        }
    }
}
__device__ __forceinline__ void p7_final(const Params& P, int G) {
    int tid_ = threadIdx.x; asm volatile("" : "+v"(tid_)); const int tid = tid_, lane = tid & 63, wave = tid >> 6; const int gw = blockIdx.x * 8 + wave, NGW = G * 8;
    const float* gv = P.in[22];
    for (int m = gw; m < NTOK; m += NGW) {
        f32x4* row = (f32x4*)(P.out + (size_t)m * 1024);
        f32x4 v[4]; float s = 0.f;
#pragma unroll
        for (int j = 0; j < 4; ++j) { v[j] = row[64 * j + lane]; s += (v[j][0] * v[j][0] + v[j][1] * v[j][1]) + (v[j][2] * v[j][2] + v[j][3] * v[j][3]); }
        const float rstd = rsqrtf(wave_sum(s) * (1.0f / 1024.0f) + EPS);
#pragma unroll
        for (int j = 0; j < 4; ++j) { const f32x4 g4 = ((const f32x4*)gv)[64 * j + lane]; row[64 * j + lane] = v[j] * rstd * g4; }
    }
}


#define XB_TMO      128
#define XB_XCNT(j)  (256  + 64 * (j))
#define XB_XSUB(j)  (1280 + 64 * (j))
#define XB_XGEN(j)  (2304 + 64 * (j))
#define XB_TOP      3328
#define XB_TOPGEN   3392
#define XCD_BAR_WORDS 3456
#define XB_SPIN_CAP (1u << 18)

__device__ __forceinline__ unsigned xb_ld(unsigned* p)              { return __hip_atomic_load(p, __ATOMIC_RELAXED, __HIP_MEMORY_SCOPE_AGENT); }
__device__ __forceinline__ unsigned xb_add(unsigned* p, unsigned v) { return __hip_atomic_fetch_add(p, v, __ATOMIC_RELAXED, __HIP_MEMORY_SCOPE_AGENT); }
__device__ __forceinline__ unsigned xb_xcc_id() { return (unsigned)__builtin_amdgcn_s_getreg((3 << 11) | 20) & 0xFu; }
#define XB_SPIN(cond, bar) do { unsigned _sp = 0; while (cond) { __builtin_amdgcn_s_sleep(1); \
    if ((++_sp & 255u) == 0u) { if (xb_ld(&(bar)[XB_TMO])) break; if (_sp > XB_SPIN_CAP) { atomicAdd(&(bar)[XB_TMO], 1u); break; } } } } while (0)

struct XcdBarrier {
    unsigned* bar; unsigned x;
    volatile LAS unsigned* st;
};

__device__ __forceinline__ XcdBarrier xcd_barrier_post(unsigned* bar, volatile LAS unsigned* st) {
    XcdBarrier b; b.bar = bar; b.x = xb_xcc_id(); b.st = st;
    if (threadIdx.x == 0) (void)xb_add(&bar[XB_XCNT(b.x)], 1u);
    return b;
}
__device__ __forceinline__ void xcd_barrier_complete(unsigned* bar, unsigned x, unsigned& nloc, unsigned& nx) {
    const unsigned G = gridDim.x * gridDim.y * gridDim.z;
    unsigned sum, cnt, mine, sp = 0u;
    for (;;) {
        sum = 0u; cnt = 0u; mine = 0u;
#pragma unroll
        for (unsigned j = 0; j < 16; ++j) { const unsigned c = xb_ld(&bar[XB_XCNT(j)]); sum += c; cnt += (c > 0u) ? 1u : 0u; mine = (j == x) ? c : mine; }
        if (sum == G) break;
        __builtin_amdgcn_s_sleep(1);
        if ((++sp & 255u) == 0u) { if (xb_ld(&bar[XB_TMO])) break; if (sp > XB_SPIN_CAP) { atomicAdd(&bar[XB_TMO], 1u); break; } }
    }
    nloc = mine > 0u ? mine : 1u; nx = cnt > 0u ? cnt : 1u;
}

__device__ __forceinline__ void xcd_barrier(const XcdBarrier& b) {
    asm volatile("s_waitcnt vmcnt(0)" ::: "memory");
    __syncthreads();
    if (threadIdx.x == 0) {
        unsigned* bar = b.bar;
        __builtin_amdgcn_s_waitcnt(0);
        unsigned nloc = b.st[0], nx = b.st[1];
        if (nloc == 0u) { xcd_barrier_complete(bar, b.x, nloc, nx); b.st[0] = nloc; b.st[1] = nx; }
        const unsigned old = xb_add(&bar[XB_XSUB(b.x)], 1u);
        const unsigned gen = old / nloc;
        if (old + 1u == (gen + 1u) * nloc) {
            __builtin_amdgcn_fence(__ATOMIC_RELEASE, "agent");
            asm volatile("s_waitcnt vmcnt(0)" ::: "memory");
            const unsigned og = xb_add(&bar[XB_TOP], 1u);
            const unsigned tg = og / nx;
            if (og + 1u == (tg + 1u) * nx) xb_add(&bar[XB_TOPGEN], 1u);
            else XB_SPIN(xb_ld(&bar[XB_TOPGEN]) == tg, bar);
            __builtin_amdgcn_fence(__ATOMIC_ACQUIRE, "agent");
            xb_add(&bar[XB_XGEN(b.x)], 1u);
            asm volatile("s_waitcnt vmcnt(0)" ::: "memory");
        } else {
            XB_SPIN(xb_ld(&bar[XB_XGEN(b.x)]) == gen, bar);
            __builtin_amdgcn_fence(__ATOMIC_ACQUIRE, "agent");
            asm volatile("s_waitcnt vmcnt(0)" ::: "memory");
        }
    }
    __syncthreads();
}

#ifndef DBG_CUT
#define DBG_CUT 0
#endif
#ifndef DBG_NOOUT
#define DBG_NOOUT 0
#endif
__device__ __forceinline__ void dbg_dump(const Params& P, int G) {
    const unsigned short* w16 = (const unsigned short*)P.ws; unsigned* o = (unsigned*)P.out;
    for (size_t i = (size_t)blockIdx.x * 512 + threadIdx.x; i < (size_t)NTOK * 1024; i += (size_t)G * 512) {
        const unsigned ob = (DBG_CUT >= 2 && !DBG_NOOUT) ? o[i] : 0u; float s = (float)(ob & 0xffffu) + (float)(ob >> 16);
        for (int k = 0; k < 8; ++k) s += (float)w16[i + (size_t)k * NTOK * 1024];
        P.out[i] = s; }
}
#define GRID_SYNC() xcd_barrier(xbar)
#ifndef TIME_PHASE
#define TIME_PHASE -1
#endif
#define TSTART(n) if (TIME_PHASE == (n)) tt0 = __builtin_amdgcn_s_memrealtime();
#define TEND(n) if (TIME_PHASE == (n)) tt1 = __builtin_amdgcn_s_memrealtime();
#define CUT(n) if (DBG_CUT == (n)) { GRID_SYNC(); dbg_dump(P, G); return; }
__device__ __forceinline__ void sub_barrier(unsigned* cnt, unsigned n) {
    asm volatile("s_waitcnt vmcnt(0)" ::: "memory"); __syncthreads();
    if (threadIdx.x == 0) {
        asm volatile("buffer_wbl2 sc1\n\ts_waitcnt vmcnt(0)" ::: "memory");
        __hip_atomic_fetch_add(cnt, 1u, __ATOMIC_RELAXED, __HIP_MEMORY_SCOPE_AGENT);
        unsigned sp = 0; while (__hip_atomic_load(cnt, __ATOMIC_RELAXED, __HIP_MEMORY_SCOPE_AGENT) < n) { __builtin_amdgcn_s_sleep(4); if (++sp > (1u << 22)) break; }
        __builtin_amdgcn_fence(__ATOMIC_ACQUIRE, "agent"); asm volatile("s_waitcnt vmcnt(0)" ::: "memory");
    }
    __syncthreads();
}
#ifndef PH_LAST
#define PH_LAST 99
#endif
__global__ void __launch_bounds__(512, 2) mega(Params P) {
    extern __shared__ __attribute__((aligned(16))) unsigned char smem[];
    LAS unsigned char* lds = (LAS unsigned char*)smem;
    cg::grid_group grid = cg::this_grid();
    const int G = gridDim.x, bid = blockIdx.x;
    unsigned char* ws = P.ws; unsigned char* dob = (unsigned char*)P.out;
#ifndef PHMASK
#define PHMASK 0xFFFF
#endif
#define PH(n) if ((PHMASK >> (n)) & 1)
    unsigned long long tt0 = 0, tt1 = 0;
    if (threadIdx.x < 2) ((LAS unsigned*)(lds + LDS_XB_OFF))[threadIdx.x] = 0u;
    __syncthreads();
    XcdBarrier xbar = xcd_barrier_post((unsigned*)(ws + WS_XBAR), (volatile LAS unsigned*)(lds + LDS_XB_OFF));
    if (P.ws == nullptr) grid.sync();
    TSTART(0)
    PH(0) p0_prologue(lds, P, G);
    GRID_SYNC();
    TEND(0) TSTART(1)
    PH(1) { pg8::Gemm g{(const bf16_t*)(dob + DO_H), (const bf16_t*)(dob + DO_WINT), NTOK, INW_P, 1024}; pg8::StaticOrder S; S.init(NTOK, INW_P, G, bid);
      EpiProj E{ws, P.in[12], lds}; pg8::gemm_phase<EpiProj, pg8::StaticOrder, true, true>(lds, g, S, E); }
    GRID_SYNC();
    TEND(1) TSTART(2)
    CUT(1)
    PH(2) { pg8::Gemm g{(const bf16_t*)(dob + DO_MEMN), (const bf16_t*)(dob + DO_WMEMKVT), NMEM, 1024, 1024}; pg8::StaticOrder S; S.init(NMEM, 1024, G, bid);
      EpiMemKV E{ws, lds}; pg8::gemm_phase<EpiMemKV, pg8::StaticOrder, true, true>(lds, g, S, E); }
    p1b_conv(P, G);
    GRID_SYNC();
    { if (TIME_PHASE == 10 || TIME_PHASE == 11) tt0 = __builtin_amdgcn_s_memrealtime();
      if (G >= 128) {
          if (bid < 64) { PH(3) { const unsigned long long r_ = ml_chain(lds, P, bid); if (TIME_PHASE >= 20 && TIME_PHASE < 24) { tt0 = 0; tt1 = r_; } } }
          else { { const int wv_ = (int)(threadIdx.x >> 6); weight_items(lds, P, WI_EARLY, WI_ALL, (bid - 64) * 8 + wv_, (G - 64) * 8, wv_, (int)(threadIdx.x & 63)); __syncthreads(); }
              for (int u = bid - 64; u < 1280; u += G - 64) { if (u < 1024) { PH(4) na_unit(lds, ws, P.in[9], u); } else { PH(5) xa_unit(lds, ws, u - 1024); } }
              sub_barrier((unsigned*)(ws + WS_SUBCNT), (unsigned)(G - 64));
              pg8::Gemm g{(const bf16_t*)(ws + WS_MLO), (const bf16_t*)(ws + WS_WBR), 3 * NTOK, 3 * 1024, 512}; BranchOrder S; S.init(G, bid, 2, G - 64, bid - 64);
              EpiBranchAcc E{(bf16_t*)(ws + WS_G), (bf16_t*)(ws + WS_MERGED)};
              pg8::gemm_phase<EpiBranchAcc, BranchOrder, true, true>(lds, g, S, E); }
      } else {
          for (int u = bid; u < 1344; u += G) { if (u < 64) { PH(3) (void)ml_chain(lds, P, u); } else if (u < 1088) { PH(4) na_unit(lds, ws, P.in[9], u - 64); } else { PH(5) xa_unit(lds, ws, u - 1088); } }
      } }
    if ((TIME_PHASE == 10 && bid < 64) || (TIME_PHASE == 11 && bid >= 64)) tt1 = __builtin_amdgcn_s_memrealtime(); else if (TIME_PHASE == 10 || TIME_PHASE == 11) tt1 = tt0;
    GRID_SYNC();
    TEND(2) TSTART(3)
    PH(6) p2b_combine(P, G);
    GRID_SYNC();
    TEND(3) TSTART(4)
    CUT(2)
    PH(7) {
      pg8::Gemm g{(const bf16_t*)(ws + WS_MLO), (const bf16_t*)(ws + WS_WBR), 3 * NTOK, 3 * 1024, 512}; BranchOrder S; S.init(G, bid, G >= 128 ? 0 : 1, 0, 0);
      EpiBranchAcc E{(bf16_t*)(ws + WS_G), (bf16_t*)(ws + WS_MERGED)};
      pg8::gemm_phase<EpiBranchAcc, BranchOrder, true, true>(lds, g, S, E); }
    GRID_SYNC();
    TEND(4) TSTART(5)
    CUT(3)
    PH(8) { pg8::Gemm g{(const bf16_t*)(ws + WS_MERGED), (const bf16_t*)(ws + WS_WOUT), NTOK, 1024, 1024}; pg8::StaticOrder S; S.init(NTOK, 1024, G, bid);
      EpiOut E{P.in[0], P.out, (bf16_t*)(ws + WS_X1B), (float*)(ws + WS_RSS1)}; pg8::gemm_phase<EpiOut, pg8::StaticOrder, true, true>(lds, g, S, E); }
    GRID_SYNC();
    TEND(5) TSTART(6)
    CUT(4)
    PH(9) { pg8::Gemm g{(const bf16_t*)(ws + WS_X1B), (const bf16_t*)(ws + WS_WUP), NTOK, DFF, 1024}; pg8::StaticOrder S; S.init(NTOK, DFF, G, bid);
      EpiUp E{(const float*)(ws + WS_RSS1), (bf16_t*)(ws + WS_ABUF), (bf16_t*)(ws + WS_UBUF)}; pg8::gemm_phase<EpiUp, pg8::StaticOrder, true, true>(lds, g, S, E); }
    GRID_SYNC();
    TEND(6) TSTART(7)
    CUT(5)
    PH(10) { pg8::Gemm g{(const bf16_t*)(ws + WS_X1B), (const bf16_t*)(ws + WS_WUP) + (size_t)DFF * 1024, NTOK, DFF, 1024}; pg8::StaticOrder S; S.init(NTOK, DFF, G, bid);
      EpiUpGlu E{(const float*)(ws + WS_RSS1), (const bf16_t*)(ws + WS_ABUF), (bf16_t*)(ws + WS_UBUF), P.in[19], P.in[20]}; pg8::gemm_phase<EpiUpGlu, pg8::StaticOrder, true, true>(lds, g, S, E); }
    GRID_SYNC();
    TEND(7) TSTART(8)
    CUT(6)
    PH(11) { pg8::Gemm g{(const bf16_t*)(ws + WS_UBUF), (const bf16_t*)(ws + WS_WDOWN), NTOK, 1024, DFF}; pg8::StaticOrder S; S.init(NTOK, 1024, G, bid);
      if (G == 256) { EpiDownNorm E{(const bf16_t*)(ws + WS_X1B), P.in[22], (float*)(ws + WS_SLOTS), (unsigned*)(ws + WS_PCNT), P.out}; pg8::gemm_phase<EpiDownNorm, pg8::StaticOrder, false, true>(lds, g, S, E); }
      else { EpiDown E{(const bf16_t*)(ws + WS_X1B), P.out}; pg8::gemm_phase<EpiDown, pg8::StaticOrder, true, true>(lds, g, S, E); } }
    if (G != 256) { GRID_SYNC(); p7_final(P, G); }
    TEND(9)
#ifdef EXTRA_SYNCS
    for (int i_ = 0; i_ < EXTRA_SYNCS; ++i_) GRID_SYNC();
#endif
    if (TIME_PHASE >= 0) { const unsigned long long ts = __builtin_amdgcn_s_memrealtime(); while (__builtin_amdgcn_s_memrealtime() - ts < (tt1 - tt0)) __builtin_amdgcn_s_sleep(8); }
}

extern "C" void kernel_launch(void* const* d_in, const int* in_sizes, int n_in, void* d_out, int out_size, void* d_ws, size_t ws_size, hipStream_t stream) {
    static int grid = 0;
    if (grid == 0) {
        if (n_in != 23 || out_size != NTOK * DM || ws_size < WS_NEED) { fprintf(stderr, "kernel_launch: unexpected shapes (n_in %d out %d ws %zu)\n", n_in, out_size, ws_size); grid = -1; return; }
        int dev = 0, cus = 0, per_cu = 0;
        hipGetDevice(&dev); hipDeviceGetAttribute(&cus, hipDeviceAttributeMultiprocessorCount, dev);
        hipFuncSetAttribute((const void*)mega, hipFuncAttributeMaxDynamicSharedMemorySize, LDS_BYTES);
        hipOccupancyMaxActiveBlocksPerMultiprocessor(&per_cu, (const void*)mega, 512, LDS_BYTES);
        if (per_cu < 1) { fprintf(stderr, "kernel_launch: occupancy query says %d blocks per CU\n", per_cu); per_cu = 1; }
        grid = cus * 1;
        (void)hipGetLastError();
    }
    if (grid < 0) return;
    Params p{};
    for (int i = 0; i < 23; ++i) p.in[i] = (const float*)d_in[i];
    p.out = (float*)d_out; p.ws = (unsigned char*)d_ws;
    (void)hipMemsetAsync((char*)d_ws + WS_XBAR, 0, WS_CTLBYTES, stream);
    void* args[] = {&p};
    hipError_t e = hipLaunchCooperativeKernel((const void*)mega, dim3(grid), dim3(512), args, LDS_BYTES, stream);
    if (e != hipSuccess) fprintf(stderr, "cooperative launch failed: %s (grid %d)\n", hipGetErrorString(e), grid);
}
```
